# Optimizing an MI355X kernel written in HIP

```python
import jax, jax.numpy as jnp
from jax import lax
import numpy as np

D_MODEL = 1024
BATCH = 4
SEQ = 4096
DEPTH = 2

GRID_W = 64
CTX_LEN = 256
N_EVEN = (DEPTH + 1) // 2
N_ODD = DEPTH // 2
H_A = 4
DK_A = 128
DV_A = 128
H_B = 4
DK_B = 64
DV_B = 128
CONV_W = 3
CHUNK = 32
MIX_W = H_A * DV_A + H_B * DV_B
N_HEADS_C = 8
N_KV_C = 2
GROUP_C = N_HEADS_C // N_KV_C
HEAD_DIM = 128
AXIS_DIM = HEAD_DIM // 2
Q_BLOCK = 128
ROPE_THETA = 10000.0
D_QKV_C = (N_HEADS_C + 2 * N_KV_C) * HEAD_DIM
D_FF = ((8 * D_MODEL // 3 + 255) // 256) * 256
AB_SPLIT = (H_A * DK_A, H_A * DV_A, H_A * DV_A, H_A * DK_A, H_A * DK_A,
            2 * H_B * DK_B, H_B * DV_B, H_B * DV_B, 4 * H_B)
D_AB_IN = sum(AB_SPLIT)

kernel_name = "hybrid_hgrn2_mlstm_gqa_prefix_dit"


def rmsnorm(x, g, eps=1e-6):
    xf = x.astype(jnp.float32)
    y = xf * lax.rsqrt(jnp.mean(xf * xf, axis=-1, keepdims=True) + eps)
    return (y * g.astype(jnp.float32)).astype(x.dtype)


def modulate(x, g, shift, scale):
    return rmsnorm(x, g) * (1 + scale) + shift


def ada_params(cvec, w, b):
    return jnp.split(jax.nn.silu(cvec) @ w + b, 6, axis=-1)


def swiglu(h, w_in, w_out):
    g, u = jnp.split(h @ w_in, 2, axis=-1)
    return (jax.nn.silu(g) * u) @ w_out


def conv_centred(x, w):
    return lax.conv_general_dilated(x, w[:, None, :], window_strides=(1,),
                                    padding=[(CONV_W // 2, CONV_W // 2)],
                                    dimension_numbers=('NWC', 'WIO', 'NWC'),
                                    feature_group_count=x.shape[-1])


def to_chunks(a):
    Bn, T = a.shape[:2]
    return jnp.moveaxis(a.reshape(Bn, T // CHUNK, CHUNK, *a.shape[2:]), 1, 0)


def from_chunks(a):
    nc, Bn, C = a.shape[:3]
    return jnp.moveaxis(a, 0, 1).reshape(Bn, nc * C, *a.shape[3:])


def hgrn2_chunk_scan(q, k, v, logf, state0):
    f32 = jnp.float32
    mask = jnp.tril(jnp.ones((CHUNK, CHUNK), bool))

    def step(S, xs):
        qc, kc, vc, fc = xs
        b = jnp.cumsum(fc, axis=1)
        b_mid = b[:, CHUNK // 2 - 1:CHUNK // 2]
        b_last = b[:, -1:]
        A = jnp.einsum('bthd,bshd->bhts', qc * jnp.exp(b - b_mid), kc * jnp.exp(b_mid - b))
        A = jnp.where(mask, A, 0.0)
        o = (jnp.einsum('bhts,bshe->bthe', A, vc)
             + jnp.einsum('bthd,bhde->bthe', qc * jnp.exp(b), S))
        S_new = (S * jnp.exp(b_last[:, 0])[..., None]
                 + jnp.einsum('bshd,bshe->bhde', kc * jnp.exp(b_last - b), vc))
        return S_new, o

    xs = tuple(to_chunks(a.astype(f32)) for a in (q, k, v, logf))
    S_fin, o = lax.scan(step, state0, xs)
    return from_chunks(o).astype(v.dtype), S_fin


def mlstm_chunk_scan(q, k, v, ig, logf, state0):
    f32 = jnp.float32
    mask = jnp.tril(jnp.ones((CHUNK, CHUNK), bool))

    def step(carry, xs):
        C, n, m = carry
        qc, kc, vc, igc, fc = xs
        bh = jnp.swapaxes(jnp.cumsum(fc, axis=1), 1, 2)
        igh = jnp.swapaxes(igc, 1, 2)
        D = jnp.where(mask, bh[..., :, None] - bh[..., None, :] + igh[..., None, :], -jnp.inf)
        m_inter = bh + m[..., None]
        m_t = jnp.maximum(D.max(-1), m_inter)
        S = jnp.einsum('bthd,bshd->bhts', qc, kc) * jnp.exp(D - m_t[..., None])
        w_inter = jnp.exp(m_inter - m_t)
        num = (jnp.einsum('bhts,bshe->bthe', S, vc)
               + jnp.swapaxes(w_inter, 1, 2)[..., None] * jnp.einsum('bthd,bhde->bthe', qc, C))
        den = S.sum(-1) + w_inter * jnp.einsum('bthd,bhd->bht', qc, n)
        h = num / jnp.swapaxes(jnp.maximum(jnp.abs(den), jnp.exp(-m_t)), 1, 2)[..., None]
        b_last = bh[..., -1]
        g = b_last[..., None] - bh + igh
        m_new = jnp.maximum(b_last + m, g.max(-1))
        wk = jnp.exp(g - m_new[..., None])
        decay = jnp.exp(b_last + m - m_new)
        C_new = decay[..., None, None] * C + jnp.einsum('bhs,bshd,bshe->bhde', wk, kc, vc)
        n_new = decay[..., None] * n + jnp.einsum('bhs,bshd->bhd', wk, kc)
        return (C_new, n_new, m_new), h

    xs = tuple(to_chunks(a.astype(f32)) for a in (q, k, v, ig, logf))
    state_fin, h = lax.scan(step, state0, xs)
    return from_chunks(h).astype(v.dtype), state_fin


def bidirectional_prefix(scan_fn, ctx_dirs, lat_dirs, state0):
    outs_c, outs_l = [], []
    for d, reverse in enumerate((False, True)):
        flip = (lambda a: jnp.flip(a, axis=1)) if reverse else (lambda a: a)
        o_c, st = scan_fn(*[flip(a) for a in ctx_dirs[d]], state0)
        o_l, _ = scan_fn(*[flip(a) for a in lat_dirs[d]], st)
        outs_c.append(flip(o_c))
        outs_l.append(flip(o_l))
    return outs_c[0] + outs_c[1], outs_l[0] + outs_l[1]


def mixer_ab(h_ctx, h_lat, w_in, conv_w, gate_b, lb, out_g, w_out, need_ctx):
    f32 = jnp.float32
    split_idx = [int(s) for s in np.cumsum(AB_SPLIT)[:-1]]

    def prep(h):
        Bn, T = h.shape[:2]
        aq, ai, ag, aff, afb, bqk, bv, bo, bg = jnp.split(h @ w_in, split_idx, axis=-1)
        z = jnp.stack([aff, afb], 0).astype(f32).reshape(2, Bn, T, H_A, DK_A)
        lbh = lb[:, None, None]
        logf_a = jnp.log(lbh + (1 - lbh) * jax.nn.sigmoid(z))
        k_a = (1 - lbh) * jax.nn.sigmoid(-z)
        q_a = aq.reshape(Bn, T, H_A, DK_A)
        v_a = ai.reshape(Bn, T, H_A, DV_A)
        q_b, k_b = jnp.split(jax.nn.silu(conv_centred(bqk, conv_w)), 2, axis=-1)
        q_b = q_b.reshape(Bn, T, H_B, DK_B) * (DK_B ** -0.5)
        k_b = k_b.reshape(Bn, T, H_B, DK_B)
        v_b = bv.reshape(Bn, T, H_B, DV_B)
        gates = bg.astype(f32).reshape(Bn, T, 4, H_B) + gate_b.astype(f32)
        ig_b = gates[:, :, 0::2]
        logf_b = jax.nn.log_sigmoid(gates[:, :, 1::2])
        hgrn_dirs = [(q_a, k_a[d], v_a, logf_a[d]) for d in range(2)]
        mlstm_dirs = [(q_b, k_b, v_b, ig_b[:, :, d], logf_b[:, :, d]) for d in range(2)]
        gate = jnp.concatenate([jax.nn.silu(ag), jax.nn.sigmoid(bo)], axis=-1)
        return hgrn_dirs, mlstm_dirs, gate

    ha_c, hb_c, gate_c = prep(h_ctx)
    ha_l, hb_l, gate_l = prep(h_lat)
    Bn = h_lat.shape[0]
    s0_a = jnp.zeros((Bn, H_A, DK_A, DV_A), f32)
    s0_b = (jnp.zeros((Bn, H_B, DK_B, DV_B), f32), jnp.zeros((Bn, H_B, DK_B), f32),
            jnp.zeros((Bn, H_B), f32))
    oa_c, oa_l = bidirectional_prefix(hgrn2_chunk_scan, ha_c, ha_l, s0_a)
    ob_c, ob_l = bidirectional_prefix(mlstm_chunk_scan, hb_c, hb_l, s0_b)

    def out(oa, ob, gate):
        o = jnp.concatenate([oa, ob], axis=2)
        o = rmsnorm(o, out_g.reshape(H_A + H_B, DV_A)).reshape(*o.shape[:2], MIX_W)
        return (o * gate) @ w_out

    y_lat = out(oa_l, ob_l, gate_l)
    y_ctx = out(oa_c, ob_c, gate_c) if need_ctx else None
    return y_ctx, y_lat


def axial_rope_angles(T):
    rows = T // GRID_W
    r, col = jnp.meshgrid(jnp.arange(rows, dtype=jnp.float32),
                          jnp.arange(GRID_W, dtype=jnp.float32), indexing='ij')
    inv = jnp.power(ROPE_THETA, -jnp.arange(0, AXIS_DIM, 2, dtype=jnp.float32) / AXIS_DIM)
    return jnp.stack([r.reshape(-1)[:, None] * inv, col.reshape(-1)[:, None] * inv], axis=1)


def rope2d(x, ang):
    Bn, T, H, _ = x.shape
    xf = x.astype(jnp.float32).reshape(Bn, T, H, 2, AXIS_DIM)
    x1, x2 = xf[..., :AXIS_DIM // 2], xf[..., AXIS_DIM // 2:]
    cos, sin = jnp.cos(ang)[None, :, None], jnp.sin(ang)[None, :, None]
    out = jnp.concatenate([x1 * cos - x2 * sin, x2 * cos + x1 * sin], axis=-1)
    return out.reshape(Bn, T, H, HEAD_DIM).astype(x.dtype)


def attend(q, k, v):
    s = jnp.einsum('bqhgd,bkhd->bhgqk', q, k).astype(jnp.float32)
    p = jax.nn.softmax(s, axis=-1).astype(v.dtype)
    return jnp.einsum('bhgqk,bkhd->bqhgd', p, v)


def blocked_attention(q, k, v):
    Bn, T = q.shape[:2]
    qb = jnp.moveaxis(q.reshape(Bn, T // Q_BLOCK, Q_BLOCK, *q.shape[2:]), 1, 0)
    o = lax.map(lambda qi: attend(qi, k, v), qb)
    return jnp.moveaxis(o, 0, 1).reshape(Bn, T, N_HEADS_C * HEAD_DIM)


def mixer_c(h_ctx, h_lat, w_qkv, qk_g, w_out, ang, need_ctx):
    def prep(h, use_rope):
        Bn, T = h.shape[:2]
        q, k, v = jnp.split(h @ w_qkv, [N_HEADS_C * HEAD_DIM, (N_HEADS_C + N_KV_C) * HEAD_DIM], axis=-1)
        q = rmsnorm(q.reshape(Bn, T, N_HEADS_C, HEAD_DIM), qk_g[0])
        k = rmsnorm(k.reshape(Bn, T, N_KV_C, HEAD_DIM), qk_g[1])
        v = v.reshape(Bn, T, N_KV_C, HEAD_DIM)
        if use_rope:
            q, k = rope2d(q, ang), rope2d(k, ang)
        q = q.reshape(Bn, T, N_KV_C, GROUP_C, HEAD_DIM) * (HEAD_DIM ** -0.5)
        return q, k, v

    q_c, k_c, v_c = prep(h_ctx, False)
    q_l, k_l, v_l = prep(h_lat, True)
    k_all = jnp.concatenate([k_c, k_l], axis=1)
    v_all = jnp.concatenate([v_c, v_l], axis=1)
    y_lat = blocked_attention(q_l, k_all, v_all) @ w_out
    y_ctx = None
    if need_ctx:
        Bn, Tc = h_ctx.shape[:2]
        y_ctx = attend(q_c, k_c, v_c).reshape(Bn, Tc, N_HEADS_C * HEAD_DIM) @ w_out
    return y_ctx, y_lat


def setup_inputs(seed: int = 0) -> dict:
    key = jax.random.key(seed)
    ks = jax.random.split(key, 20)
    f32 = jnp.float32

    def nrm(k, shape, s):
        return jax.random.normal(k, shape, f32) * s

    ig_b = nrm(ks[11], (N_EVEN, 2, H_B), 0.01)
    fg_b = jnp.linspace(3.0, 6.0, H_B, dtype=f32) + nrm(ks[12], (N_EVEN, 2, H_B), 0.01)
    return {
        "x": nrm(ks[0], (BATCH, SEQ, D_MODEL), 1.0),
        "c": nrm(ks[1], (BATCH, D_MODEL), 1.0),
        "ctx": nrm(ks[2], (BATCH, CTX_LEN, D_MODEL), 1.0),
        "c_ctx": nrm(ks[3], (D_MODEL,), 1.0),
        "ada_w": nrm(ks[4], (DEPTH, D_MODEL, 6 * D_MODEL), 0.5 * D_MODEL ** -0.5),
        "ada_b": nrm(ks[5], (DEPTH, 6 * D_MODEL), 0.02),
        "norm_g": 1.0 + nrm(ks[6], (DEPTH, 4, D_MODEL), 0.02),
        "ffn_w_in": nrm(ks[7], (DEPTH, D_MODEL, 2 * D_FF), D_MODEL ** -0.5),
        "ffn_w_out": nrm(ks[8], (DEPTH, D_FF, D_MODEL), D_FF ** -0.5),
        "ab_w_in": nrm(ks[9], (N_EVEN, D_MODEL, D_AB_IN), D_MODEL ** -0.5),
        "ab_conv": nrm(ks[10], (N_EVEN, CONV_W, 2 * H_B * DK_B), CONV_W ** -0.5),
        "ab_gate_b": jnp.stack([ig_b, fg_b], axis=2).reshape(N_EVEN, 4, H_B),
        "hgrn_lb": nrm(ks[13], (2, DEPTH + 1, H_A * DK_A), 0.1),
        "ab_out_g": 1.0 + nrm(ks[14], (N_EVEN, MIX_W), 0.02),
        "ab_w_out": nrm(ks[15], (N_EVEN, MIX_W, D_MODEL), MIX_W ** -0.5),
        "attn_w_qkv": nrm(ks[16], (N_ODD, D_MODEL, D_QKV_C), D_MODEL ** -0.5),
        "attn_qk_g": 1.0 + nrm(ks[17], (N_ODD, 2, HEAD_DIM), 0.02),
        "attn_w_out": nrm(ks[18], (N_ODD, N_HEADS_C * HEAD_DIM, D_MODEL), (N_HEADS_C * HEAD_DIM) ** -0.5),
    }


def reference(x, c, ctx, c_ctx, ada_w, ada_b, norm_g, ffn_w_in, ffn_w_out, ab_w_in, ab_conv,
              ab_gate_b, hgrn_lb, ab_out_g, ab_w_out, attn_w_qkv, attn_qk_g, attn_w_out):
    T = x.shape[1]
    ang = axial_rope_angles(T)
    lb_all = jnp.cumsum(jax.nn.softmax(hgrn_lb.astype(jnp.float32), axis=1), axis=1)
    for l in range(DEPTH):
        need_ctx = l < DEPTH - 1
        sh1, sc1, g1, sh2, sc2, g2 = [a[:, None, :] for a in ada_params(c, ada_w[l], ada_b[l])]
        csh1, csc1, cg1, csh2, csc2, cg2 = ada_params(c_ctx, ada_w[l], ada_b[l])
        h_lat = modulate(x, norm_g[l, 0], sh1, sc1)
        h_ctx = modulate(ctx, norm_g[l, 0], csh1, csc1)
        if l % 2 == 0:
            e = l // 2
            y_ctx, y_lat = mixer_ab(h_ctx, h_lat, ab_w_in[e], ab_conv[e], ab_gate_b[e],
                                    lb_all[:, l].reshape(2, H_A, DK_A), ab_out_g[e], ab_w_out[e],
                                    need_ctx)
        else:
            o = l // 2
            y_ctx, y_lat = mixer_c(h_ctx, h_lat, attn_w_qkv[o], attn_qk_g[o], attn_w_out[o], ang,
                                   need_ctx)
        x = x + g1 * rmsnorm(y_lat, norm_g[l, 1])
        x = x + g2 * rmsnorm(swiglu(modulate(x, norm_g[l, 2], sh2, sc2), ffn_w_in[l], ffn_w_out[l]),
                             norm_g[l, 3])
        if need_ctx:
            ctx = ctx + cg1 * rmsnorm(y_ctx, norm_g[l, 1])
            ctx = ctx + cg2 * rmsnorm(swiglu(modulate(ctx, norm_g[l, 2], csh2, csc2), ffn_w_in[l],
                                             ffn_w_out[l]), norm_g[l, 3])
    return x
```

```cpp
#include <hip/hip_runtime.h>
#include <hip/hip_cooperative_groups.h>
#include <cstdio>
#include <cstdint>
namespace cg = cooperative_groups;

constexpr int DM = 1024, NB = 4, SEQ = 4096, CTX = 256, TT = SEQ + CTX, M = NB * TT;
constexpr int DFF = 2816, NAB = 4112, NABP = 4352, NQKV = 1536;
constexpr float EPS = 1e-6f;
#ifndef MK_ONE
#define MK_ONE 1
#endif

namespace pg8 {
#define PG8_LAS __attribute__((address_space(3)))
typedef unsigned short bf16_t;
typedef short bf16x8 __attribute__((ext_vector_type(8)));
typedef float f32x4 __attribute__((ext_vector_type(4)));
typedef unsigned u32x4 __attribute__((ext_vector_type(4)));
constexpr int BM = 256, BK = 64, HALF = 128, HTB = HALF * BK * 2  , STAGE_BYTES = 8 * HTB, NXCD = 8, WGM = 8;

__host__ __device__ __forceinline__ int lds_byte(int r, int c) { const int st = (r >> 4) * 2 + (c >> 5), rr = r & 15, cc = c & 31, ob = rr * 64 + cc * 2; return st * 1024 + (ob ^ (((ob >> 9) & 1) << 5)); }
__host__ __device__ __forceinline__ void stage_rc(int b, int& R, int& C) { const int st = b / 1024, sb = b % 1024, swz = sb ^ (((sb >> 9) & 1) << 5); R = (st >> 1) * 16 + swz / 64; C = (st & 1) * 32 + (swz % 64) / 2; }
__host__ __device__ __forceinline__ int perm32(int rho) { const int n = rho >> 4, i = rho & 15; return 8 * (i >> 2) + 4 * n + (i & 3); }

struct Unit { int pm, pn; };
struct Gemm { const bf16_t* A; const bf16_t* Bt; int M, N, K; };

struct TileOrder {
    int nM, nN, nwg, G, c, skip;
    __device__ void init(int nM_, int N, int G_, int c_, int skip_) { nM = nM_; nN = N / BM; nwg = nM * nN; G = G_; c = c_; skip = skip_; }
    __device__ bool next(int i, Unit& u) const {
        const long L = (long)i * G + c; if (L >= nwg) return false;
        int wgid = (int)L; { const int q = nwg / NXCD, r = nwg % NXCD, xcd = wgid % NXCD, off = wgid / NXCD; wgid = (xcd < r ? xcd * (q + 1) : r * (q + 1) + (xcd - r) * q) + off; }
        const int nig = WGM * nN, gid = wgid / nig, fm = gid * WGM, gsz = (nM - fm) < WGM ? (nM - fm) : WGM;
        int pm = fm + ((wgid % nig) % gsz); u.pn = (wgid % nig) / gsz;
        if (skip) pm = pm + (pm >> 4) + 1;
        u.pm = pm; return true;
    }
    __device__ __forceinline__ void a_ready(const Unit&) const {}
    __device__ __forceinline__ void done(const Unit&) const {}
};

__device__ __forceinline__ unsigned cvt_pk_bf16(float lo, float hi) { unsigned r; asm volatile("v_cvt_pk_bf16_f32 %0, %1, %2" : "=v"(r) : "v"(lo), "v"(hi)); return r; }
__device__ __forceinline__ u32x4 pack8(const f32x4 a, const f32x4 b) { u32x4 w; w.x = cvt_pk_bf16(a[0], a[1]); w.y = cvt_pk_bf16(a[2], a[3]); w.z = cvt_pk_bf16(b[0], b[1]); w.w = cvt_pk_bf16(b[2], b[3]); return w; }
__device__ __forceinline__ float fsigmoid(float x) { return __builtin_amdgcn_rcpf(1.0f + __expf(-x)); }
__device__ __forceinline__ f32x4 silu4(f32x4 v) { f32x4 o; o[0] = v[0] * fsigmoid(v[0]); o[1] = v[1] * fsigmoid(v[1]); o[2] = v[2] * fsigmoid(v[2]); o[3] = v[3] * fsigmoid(v[3]); return o; }
__device__ __forceinline__ f32x4 sigm4(f32x4 v) { f32x4 o; o[0] = fsigmoid(v[0]); o[1] = fsigmoid(v[1]); o[2] = fsigmoid(v[2]); o[3] = fsigmoid(v[3]); return o; }

template <class F> struct Epi8 {
    static constexpr bool PERM = true, AFTER_DRAIN = false;
    F f;
    __device__ __forceinline__ void operator()(const f32x4 (&acc)[2][2][4][2], const Unit& u, int wr, int wc, int fr, int fq) const {
        const int col = u.pn * BM + wc * 32 + 8 * fq;
#pragma unroll
        for (int ai = 0; ai < 2; ++ai)
#pragma unroll
            for (int m = 0; m < 4; ++m) { const int row = u.pm * BM + ai * HALF + wr * 64 + m * 16 + fr;
                f.apply(row, col, acc[ai][0][m][0], acc[ai][0][m][1], acc[ai][1][m][0], acc[ai][1][m][1]); }
    }
};
struct FProj {
    bf16_t* proj; float* bg;
    __device__ __forceinline__ void one(int row, int c, f32x4 v0, f32x4 v1) const {
        if (c >= 4096) { if (c < 4112) { float* p = bg + (size_t)row * 16 + (c - 4096); *(f32x4*)p = v0; *(f32x4*)(p + 4) = v1; } return; }
        const int seg = c >> 9, cs = c & 511;
        if (seg == 2) { v0 = silu4(v0); v1 = silu4(v1); }
        if (seg == 7) { v0 = sigm4(v0); v1 = sigm4(v1); }
        *(u32x4*)(proj + (size_t)seg * ((size_t)M * 512) + (size_t)row * 512 + cs) = pack8(v0, v1);
    }
    __device__ __forceinline__ void apply(int row, int col, f32x4 a0, f32x4 a1, f32x4 b0, f32x4 b1) const { one(row, col, a0, a1); one(row, col + 128, b0, b1); }
};
struct FStore {
    bf16_t* O; int ld;
    __device__ __forceinline__ void apply(int row, int col, f32x4 a0, f32x4 a1, f32x4 b0, f32x4 b1) const {
        bf16_t* p = O + (size_t)row * ld + col; *(u32x4*)p = pack8(a0, a1); *(u32x4*)(p + 128) = pack8(b0, b1); }
};
struct FSwiglu {
    bf16_t* act;
    __device__ __forceinline__ void apply(int row, int col, f32x4 a0, f32x4 a1, f32x4 b0, f32x4 b1) const {
        const int hc = (col >> 8) * 128 + (col & 255);
        *(u32x4*)(act + (size_t)row * DFF + hc) = pack8(silu4(a0) * b0, silu4(a1) * b1); }
};
struct FQkv {
    bf16_t *q, *k, *v;
    __device__ __forceinline__ void one(int row, int c, f32x4 v0, f32x4 v1) const {
        bf16_t* p = c < 1024 ? q + (size_t)row * 1024 + c : (c < 1280 ? k + (size_t)row * 256 + (c - 1024) : v + (size_t)row * 256 + (c - 1280));
        *(u32x4*)p = pack8(v0, v1); }
    __device__ __forceinline__ void apply(int row, int col, f32x4 a0, f32x4 a1, f32x4 b0, f32x4 b1) const { one(row, col, a0, a1); one(row, col + 128, b0, b1); }
};

template <class Epi, class Sched, bool ALIGN_EPI = false, bool SP2 = false>
__device__ __forceinline__ void gemm_phase(PG8_LAS unsigned char* lds, const Gemm g, const Sched& S, const Epi& E) {
    const int tid = threadIdx.x, wid = __builtin_amdgcn_readfirstlane(tid >> 6), lane = tid & 63, wr = wid >> 2, wc = wid & 3, fr = lane & 15, fq = lane >> 4;
    const int K = g.K, nt = K / BK;
    unsigned voffA[2], voffB[2];
#pragma unroll
    for (int i = 0; i < 2; ++i) { int R, C; stage_rc(tid * 16 + i * 8192, R, C); const int Rb = Epi::PERM ? ((R & ~31) + perm32(R & 31)) : R;
        voffA[i] = (unsigned)(R * K + C) * 2u; voffB[i] = (unsigned)(Rb * K + C) * 2u; }
    const size_t kstep = (size_t)(BK * 2);
    const size_t hstep = (size_t)HALF * K * 2;
    const size_t tstep = 2 * hstep;
    const unsigned ldsw = (unsigned)wid * 1024u;
    const int aoff = lds_byte(wr * 64 + fr, fq * 8), boff = lds_byte(wc * 32 + fr, fq * 8);
#define PG8_SA(b, h) (((b) * 2 + (h)) * HTB)
#define PG8_SB(b, h) ((4 + (b) * 2 + (h)) * HTB)
#define PG8_STAGE(bufoff, gbase, voff) do { _Pragma("unroll") for (int _i = 0; _i < 2; ++_i) \
        __builtin_amdgcn_global_load_lds((const unsigned*)((const char*)(gbase) + (voff)[_i]), (PG8_LAS unsigned*)(lds + (bufoff) + ldsw + _i * 8192), 16, 0, 0); } while (0)
#define PG8_LDA(dst, b, h) do { _Pragma("unroll") for (int m = 0; m < 4; ++m) _Pragma("unroll") for (int k = 0; k < 2; ++k) dst[m][k] = *(const PG8_LAS bf16x8*)(lds + PG8_SA(b, h) + aoff + m * 2048 + k * 1024); } while (0)
#define PG8_LDB(dst, b, h) do { _Pragma("unroll") for (int n = 0; n < 2; ++n) _Pragma("unroll") for (int k = 0; k < 2; ++k) dst[n][k] = *(const PG8_LAS bf16x8*)(lds + PG8_SB(b, h) + boff + n * 2048 + k * 1024); } while (0)
#define PG8_MMA(ai, bj, At, Bt) do { __builtin_amdgcn_s_setprio(1); _Pragma("unroll") for (int m = 0; m < 4; ++m) _Pragma("unroll") for (int n = 0; n < 2; ++n) _Pragma("unroll") for (int k = 0; k < 2; ++k) \
        acc[ai][bj][m][n] = __builtin_amdgcn_mfma_f32_16x16x32_bf16(Bt[n][k], At[m][k], acc[ai][bj][m][n], 0, 0, 0); __builtin_amdgcn_s_setprio(0); } while (0)
#define PG8_WAIT_V(n) asm volatile("s_waitcnt vmcnt(" #n ")" ::: "memory")
#define PG8_WAIT_L(n) asm volatile("s_waitcnt lgkmcnt(" #n ")" ::: "memory")
#define PG8_BAR __builtin_amdgcn_s_barrier()
#define PG8_SCHED __builtin_amdgcn_sched_barrier(0)
    Unit cur, nxt; int ui = 0;
    if (!S.next(0, cur)) return;
    f32x4 acc[2][2][4][2];
#pragma unroll
    for (int a = 0; a < 2; ++a)
#pragma unroll
        for (int b = 0; b < 2; ++b)
#pragma unroll
            for (int m = 0; m < 4; ++m)
#pragma unroll
                for (int n = 0; n < 2; ++n) acc[a][b][m][n] = (f32x4){0.f, 0.f, 0.f, 0.f};
    bf16x8 At[4][2], B0[2][2], B1[2][2];
    const char* cA = (const char*)g.A + (size_t)cur.pm * tstep; const char* cB = (const char*)g.Bt + (size_t)cur.pn * tstep;
    S.a_ready(cur);
    if constexpr (SP2) {
        PG8_STAGE(PG8_SB(0, 0), cB, voffB); PG8_STAGE(PG8_SB(0, 1), cB + hstep, voffB); PG8_STAGE(PG8_SA(0, 0), cA, voffA); PG8_STAGE(PG8_SA(0, 1), cA + hstep, voffA);
        if (wr == 1) PG8_BAR;
        PG8_WAIT_V(2); PG8_BAR;
        PG8_STAGE(PG8_SB(1, 0), cB + kstep, voffB); PG8_STAGE(PG8_SA(1, 0), cA + kstep, voffA); PG8_STAGE(PG8_SB(1, 1), cB + hstep + kstep, voffB);
        PG8_WAIT_V(6); PG8_BAR;
    } else {
        PG8_STAGE(PG8_SB(0, 0), cB, voffB); PG8_STAGE(PG8_SA(0, 0), cA, voffA); PG8_STAGE(PG8_SB(0, 1), cB + hstep, voffB); PG8_STAGE(PG8_SA(0, 1), cA + hstep, voffA);
        if (wr == 1) PG8_BAR;
        PG8_WAIT_V(4); PG8_BAR;
        PG8_STAGE(PG8_SB(1, 0), cB + kstep, voffB); PG8_STAGE(PG8_SA(1, 0), cA + kstep, voffA); PG8_STAGE(PG8_SB(1, 1), cB + hstep + kstep, voffB);
        PG8_WAIT_V(6); PG8_BAR;
    }
    for (;;) {
        const bool has_next = S.next(ui + 1, nxt);
        const char* nA = has_next ? (const char*)g.A + (size_t)nxt.pm * tstep : cA; const char* nB = has_next ? (const char*)g.Bt + (size_t)nxt.pn * tstep : cB;
        for (int t = 0; t < nt; t += 2) {
            const bool last = (t == nt - 2);
            const char* a1 = cA + (size_t)(t + 1) * kstep;
            const char* a2 = last ? nA : cA + (size_t)(t + 2) * kstep; const char* b2 = last ? nB : cB + (size_t)(t + 2) * kstep;
            const char* a3 = a2 + kstep; const char* b3 = b2 + kstep;
            if (last && has_next) S.a_ready(nxt);
            if constexpr (SP2) {
            PG8_LDB(B0, 0, 0); PG8_LDB(B1, 0, 1); PG8_SCHED; PG8_LDA(At, 0, 0); PG8_STAGE(PG8_SA(1, 1), a1 + hstep, voffA);
            PG8_WAIT_V(8); PG8_WAIT_L(0); PG8_BAR; PG8_MMA(0, 0, At, B0); PG8_MMA(0, 1, At, B1); PG8_BAR; PG8_SCHED;
            PG8_LDA(At, 0, 1); PG8_STAGE(PG8_SB(0, 0), b2, voffB); PG8_STAGE(PG8_SB(0, 1), b2 + hstep, voffB); PG8_STAGE(PG8_SA(0, 0), a2, voffA);
            PG8_WAIT_V(8); PG8_WAIT_L(0); PG8_BAR; PG8_MMA(1, 0, At, B0); PG8_MMA(1, 1, At, B1); PG8_BAR; PG8_SCHED;
            PG8_LDB(B0, 1, 0); PG8_LDB(B1, 1, 1); PG8_SCHED; PG8_LDA(At, 1, 0); PG8_STAGE(PG8_SA(0, 1), a2 + hstep, voffA);
            PG8_WAIT_V(8); PG8_WAIT_L(0); PG8_BAR; PG8_MMA(0, 0, At, B0); PG8_MMA(0, 1, At, B1); PG8_BAR; PG8_SCHED;
            PG8_LDA(At, 1, 1); PG8_STAGE(PG8_SB(1, 0), b3, voffB); PG8_STAGE(PG8_SB(1, 1), b3 + hstep, voffB); PG8_STAGE(PG8_SA(1, 0), a3, voffA);
            PG8_WAIT_V(8); PG8_WAIT_L(0); PG8_BAR; PG8_MMA(1, 0, At, B0); PG8_MMA(1, 1, At, B1); PG8_BAR; PG8_SCHED;
            } else {
            PG8_LDB(B0, 0, 0); PG8_SCHED; PG8_LDA(At, 0, 0); PG8_STAGE(PG8_SA(1, 1), a1 + hstep, voffA);
            PG8_WAIT_L(8); PG8_BAR; PG8_WAIT_L(0); PG8_MMA(0, 0, At, B0); PG8_BAR; PG8_SCHED;
            PG8_LDB(B1, 0, 1); PG8_STAGE(PG8_SB(0, 0), b2, voffB);
            PG8_BAR; PG8_WAIT_L(0); PG8_MMA(0, 1, At, B1); PG8_BAR;
            PG8_LDA(At, 0, 1); PG8_STAGE(PG8_SA(0, 0), a2, voffA);
            PG8_BAR; PG8_WAIT_L(0); PG8_MMA(1, 0, At, B0); PG8_BAR; PG8_SCHED;
            PG8_STAGE(PG8_SB(0, 1), b2 + hstep, voffB);
            PG8_WAIT_V(6); PG8_BAR; PG8_MMA(1, 1, At, B1); PG8_BAR;
            PG8_LDB(B0, 1, 0); PG8_SCHED; PG8_LDA(At, 1, 0); PG8_STAGE(PG8_SA(0, 1), a2 + hstep, voffA);
            PG8_WAIT_L(8); PG8_BAR; PG8_WAIT_L(0); PG8_MMA(0, 0, At, B0); PG8_BAR; PG8_SCHED;
            PG8_LDB(B1, 1, 1); PG8_STAGE(PG8_SB(1, 0), b3, voffB);
            PG8_BAR; PG8_WAIT_L(0); PG8_MMA(0, 1, At, B1); PG8_BAR;
            PG8_LDA(At, 1, 1); PG8_STAGE(PG8_SA(1, 0), a3, voffA);
            PG8_BAR; PG8_WAIT_L(0); PG8_MMA(1, 0, At, B0); PG8_BAR; PG8_SCHED;
            PG8_STAGE(PG8_SB(1, 1), b3 + hstep, voffB);
            PG8_WAIT_V(6); PG8_BAR; PG8_MMA(1, 1, At, B1); PG8_BAR;
            }
        }
        if constexpr (ALIGN_EPI) { if (wr == 0) PG8_BAR; }
        if constexpr (!Epi::AFTER_DRAIN) { E(acc, cur, wr, wc, fr, fq); S.done(cur); }
        if (!has_next) break;
#pragma unroll
        for (int a = 0; a < 2; ++a)
#pragma unroll
            for (int b = 0; b < 2; ++b)
#pragma unroll
                for (int m = 0; m < 4; ++m)
#pragma unroll
                    for (int n = 0; n < 2; ++n) acc[a][b][m][n] = (f32x4){0.f, 0.f, 0.f, 0.f};
        cur = nxt; cA = nA; cB = nB; ++ui;
        if constexpr (ALIGN_EPI) { if (wr == 1) PG8_BAR; }
    }
    PG8_WAIT_V(0);
    if constexpr (!ALIGN_EPI) { if (wr == 0) PG8_BAR; }
    PG8_BAR;
    if constexpr (Epi::AFTER_DRAIN) { E.fused(acc, cur, wr, wc, fr, fq, lds, wid, lane); S.done(cur); }
#undef PG8_SA
#undef PG8_SB
#undef PG8_STAGE
#undef PG8_LDA
#undef PG8_LDB
#undef PG8_MMA
#undef PG8_WAIT_V
#undef PG8_WAIT_L
#undef PG8_BAR
#undef PG8_SCHED
}
}

namespace attn {
typedef unsigned short bf16;
using bf16x8 = __attribute__((ext_vector_type(8))) short;
using s16x4  = __attribute__((ext_vector_type(4))) short;
using f32x16 = __attribute__((ext_vector_type(16))) float;
using u32x4  = __attribute__((ext_vector_type(4))) unsigned;
constexpr int D = 128, NW = 8, QBLK = 32, KVBLK = 64;
constexpr float SCALE = 0.088388347648318440f;
constexpr float THR = 8.f;
constexpr int LDQ = 1024, LDK = 256, LDO = 1024;
constexpr size_t SHM_V = KVBLK * D * 2, SHM_K = KVBLK * D * 2, SHM_ATTN = 2 * SHM_V + 2 * SHM_K + NW * 64 * 4;
#define KSWZ(row, colB) ((row) * 256 + ((colB) ^ (((row) & 7) << 4)))
#define SBAR() __builtin_amdgcn_sched_barrier(0)
__device__ __forceinline__ int crow(int r, int hi) { return (r & 3) + 8 * (r >> 2) + 4 * hi; }
__device__ __forceinline__ unsigned cvtpk(float lo, float hi) { unsigned r; asm volatile("v_cvt_pk_bf16_f32 %0, %1, %2" : "=v"(r) : "v"(lo), "v"(hi)); return r; }
__device__ __forceinline__ bf16x8 ld8(const bf16* p) { return *reinterpret_cast<const bf16x8*>(p); }

__device__ __forceinline__ void partialSM(f32x16& p0, f32x16& p1, float& m_reg, float& mn, float& alpha) {
  constexpr float C = SCALE * 1.4426950408889634f;
  float pmax = p0[0]; for (int r = 1; r < 16; ++r) pmax = fmaxf(pmax, p0[r]); for (int r = 0; r < 16; ++r) pmax = fmaxf(pmax, p1[r]);
  { auto rr = __builtin_amdgcn_permlane32_swap(__float_as_uint(pmax), __float_as_uint(pmax), false, false);
    pmax = fmaxf(__uint_as_float(rr[0]), __uint_as_float(rr[1])); }
  if (__builtin_expect(__all(pmax - m_reg <= THR / SCALE), 1)) { mn = m_reg; alpha = 1.f; }
  else { mn = fmaxf(m_reg, pmax); alpha = __builtin_amdgcn_exp2f((m_reg - mn) * C); m_reg = mn; }
  float mnC = -mn * C;
  for (int r = 0; r < 16; ++r) p0[r] = fmaf(p0[r], C, mnC); for (int r = 0; r < 16; ++r) p1[r] = fmaf(p1[r], C, mnC);
  for (int r = 0; r < 16; ++r) p0[r] = __builtin_amdgcn_exp2f(p0[r]);
}
__device__ __forceinline__ void finishSM(f32x16& p0, f32x16& p1, float alpha, float& l_reg, bf16x8& pa0, bf16x8& pa1, bf16x8& pa2, bf16x8& pa3) {
  for (int r = 0; r < 16; ++r) p1[r] = __builtin_amdgcn_exp2f(p1[r]);
  float ps = 0; for (int r = 0; r < 16; ++r) ps += p0[r]; for (int r = 0; r < 16; ++r) ps += p1[r];
  { auto rr = __builtin_amdgcn_permlane32_swap(__float_as_uint(ps), __float_as_uint(ps), false, false);
    ps = __uint_as_float(rr[0]) + __uint_as_float(rr[1]); }
  l_reg = l_reg * alpha + ps;
#define PK4(P, BASE, OUT) do { unsigned a0 = cvtpk(P[BASE + 0], P[BASE + 1]), a1 = cvtpk(P[BASE + 2], P[BASE + 3]);   \
    unsigned b0 = cvtpk(P[BASE + 4], P[BASE + 5]), b1 = cvtpk(P[BASE + 6], P[BASE + 7]);                              \
    auto r0 = __builtin_amdgcn_permlane32_swap(a0, b0, false, false); auto r1 = __builtin_amdgcn_permlane32_swap(a1, b1, false, false); \
    u32x4 w = {r0[0], r1[0], r0[1], r1[1]}; OUT = *reinterpret_cast<bf16x8*>(&w); } while (0)
  PK4(p0, 0, pa0); PK4(p0, 8, pa1); PK4(p1, 0, pa2); PK4(p1, 8, pa3);
#undef PK4
}
__device__ __forceinline__ void qkt(f32x16& p0, f32x16& p1, const bf16* Ks, const bf16x8* qr, int r32, int hi) {
  p0 = f32x16{}; p1 = f32x16{};
  for (int d0 = 0; d0 < 8; ++d0) { int cb = (d0 * 16 + hi * 8) * 2;
    bf16x8 b0 = *reinterpret_cast<const bf16x8*>((const char*)Ks + KSWZ(r32, cb));
    bf16x8 b1 = *reinterpret_cast<const bf16x8*>((const char*)Ks + KSWZ(32 + r32, cb));
    p0 = __builtin_amdgcn_mfma_f32_32x32x16_bf16(b0, qr[d0], p0, 0, 0, 0);
    p1 = __builtin_amdgcn_mfma_f32_32x32x16_bf16(b1, qr[d0], p1, 0, 0, 0); }
}
__device__ __forceinline__ int v_st(int k, int c) { const int kk = (k & ~0xC) | ((k & 4) << 1) | ((k & 8) >> 1); return ((kk >> 3) * 4 + (c >> 5)) * 512 + ((kk & 7) * 32 + (c & 31)) * 2; }
__device__ __forceinline__ int v_rd_base(int lane) { return ((lane & 3) << 3) | (((lane >> 2) & 3) << 6) | (((lane >> 4) & 1) << 5) | (((lane >> 5) & 1) << 8); }
constexpr int v_rd_off(int d0, int ks, int half) { return d0 * 512 + ks * 4096 + half * 2048; }
template <int OFF> __device__ __forceinline__ s16x4 tr_read(int vb) {
  s16x4 r; asm volatile("ds_read_b64_tr_b16 %0, %1 offset:%2" : "=&v"(r) : "v"(vb), "i"(OFF) : "memory"); return r;
}
template <int D0> __device__ __forceinline__ void pv_one(f32x16& od, int vb, bf16x8 pa0, bf16x8 pa1, bf16x8 pa2, bf16x8 pa3) {
  const s16x4 l0 = tr_read<v_rd_off(D0, 0, 0)>(vb), h0 = tr_read<v_rd_off(D0, 0, 1)>(vb), l1 = tr_read<v_rd_off(D0, 1, 0)>(vb), h1 = tr_read<v_rd_off(D0, 1, 1)>(vb);
  const s16x4 l2 = tr_read<v_rd_off(D0, 2, 0)>(vb), h2 = tr_read<v_rd_off(D0, 2, 1)>(vb), l3 = tr_read<v_rd_off(D0, 3, 0)>(vb), h3 = tr_read<v_rd_off(D0, 3, 1)>(vb);
  asm volatile("s_waitcnt lgkmcnt(0)" ::: "memory"); SBAR();
#define PK(L, H) (bf16x8){L[0], L[1], L[2], L[3], H[0], H[1], H[2], H[3]}
  od = __builtin_amdgcn_mfma_f32_32x32x16_bf16(pa0, PK(l0, h0), od, 0, 0, 0);
  od = __builtin_amdgcn_mfma_f32_32x32x16_bf16(pa1, PK(l1, h1), od, 0, 0, 0);
  od = __builtin_amdgcn_mfma_f32_32x32x16_bf16(pa2, PK(l2, h2), od, 0, 0, 0);
  od = __builtin_amdgcn_mfma_f32_32x32x16_bf16(pa3, PK(l3, h3), od, 0, 0, 0);
#undef PK
}
__device__ __forceinline__ void pv_d0(f32x16* o, int vb, bf16x8 pa0, bf16x8 pa1, bf16x8 pa2, bf16x8 pa3) {
  pv_one<0>(o[0], vb, pa0, pa1, pa2, pa3); pv_one<1>(o[1], vb, pa0, pa1, pa2, pa3); pv_one<2>(o[2], vb, pa0, pa1, pa2, pa3); pv_one<3>(o[3], vb, pa0, pa1, pa2, pa3);
}
__device__ __forceinline__ void attn_dense_body(const bf16* __restrict__ Qb, const bf16* __restrict__ Kh, const bf16* __restrict__ Vh,
                                                bf16* __restrict__ Ob, int seq, char* lds) {
  constexpr int SDEPTH = 2;
  const int tid = threadIdx.x, wid = tid >> 6, lane = tid & 63, r32 = lane & 31, hi = lane >> 5;
  bf16* V_lds = (bf16*)lds; bf16* K_lds = (bf16*)(lds + 2 * SHM_V);
  float* ws = (float*)(lds + 2 * SHM_V + 2 * SHM_K) + wid * 64; float* li_l = ws; float* al_l = ws + 32;
  float m_reg = -1e30f, l_reg = 0; f32x16 o[4] = {}; bf16x8 qr[8];
  const bf16* Qw = Qb + (long)(wid * QBLK + r32) * LDQ + hi * 8;
#pragma unroll
  for (int d0 = 0; d0 < 8; ++d0) qr[d0] = ld8(Qw + d0 * 16);
  const int sr = tid >> 4, sc = (tid & 15) * 8, vst0 = v_st(sr, sc), vst1 = v_st(32 + sr, sc);
  const int vb0 = (int)(uintptr_t)V_lds + v_rd_base(lane);
  struct { bf16x8 vs0, vs1, ks0, ks1; } sr_[SDEPTH];
#define SLOAD(i, k0) do { sr_[i].vs0 = ld8(&Vh[(long)((k0) + sr) * LDK + sc]); sr_[i].vs1 = ld8(&Vh[(long)((k0) + 32 + sr) * LDK + sc]); \
    sr_[i].ks0 = ld8(&Kh[(long)((k0) + sr) * LDK + sc]); sr_[i].ks1 = ld8(&Kh[(long)((k0) + 32 + sr) * LDK + sc]); } while (0)
#define SWRITE(b, i) do { *(bf16x8*)((char*)V_lds + (b) * SHM_V + vst0) = sr_[i].vs0;          \
    *(bf16x8*)((char*)V_lds + (b) * SHM_V + vst1) = sr_[i].vs1; int kc = sc * 2;               \
    *(bf16x8*)((char*)K_lds + (b) * SHM_K + KSWZ(sr, kc)) = sr_[i].ks0;                       \
    *(bf16x8*)((char*)K_lds + (b) * SHM_K + KSWZ(32 + sr, kc)) = sr_[i].ks1; } while (0)
#define SWAIT() do { asm volatile("s_waitcnt vmcnt(4)" ::: "memory"); } while (0)
#define RESC(a) do { if (__any((a) < 1.f)) { if (hi == 0) al_l[r32] = (a); asm volatile("s_waitcnt lgkmcnt(0)" ::: "memory"); \
    for (int d = 0; d < 4; ++d) for (int r = 0; r < 16; ++r) o[d][r] *= al_l[crow(r, hi)]; } } while (0)
  f32x16 pA0, pA1, pB0, pB1; float mnA, mnB, alA, alB; bf16x8 pa0, pa1, pa2, pa3; const int NT = seq / KVBLK;
  constexpr int SE = 0, SO = SDEPTH - 1;
  SLOAD(SE, 0); asm volatile("s_waitcnt vmcnt(0)" ::: "memory"); SWRITE(0, SE); __syncthreads();
  qkt(pA0, pA1, K_lds, qr, r32, hi); partialSM(pA0, pA1, m_reg, mnA, alA);
  SLOAD(SO, KVBLK); if (2 < NT) SLOAD(SE, 2 * KVBLK);
  SWAIT(); SWRITE(1, SO); __syncthreads();
  for (int j = 1; j + 1 < NT; j += 2) {
    SBAR(); qkt(pB0, pB1, (bf16*)((char*)K_lds + SHM_K), qr, r32, hi);
    finishSM(pA0, pA1, alA, l_reg, pa0, pa1, pa2, pa3); SBAR();
    SLOAD(SO, (j + SDEPTH) * KVBLK); SBAR();
    pv_d0(o, vb0, pa0, pa1, pa2, pa3); partialSM(pB0, pB1, m_reg, mnB, alB);
    __syncthreads(); SWAIT(); SWRITE(0, SE);
    RESC(alB); __syncthreads();
    SBAR(); qkt(pA0, pA1, K_lds, qr, r32, hi);
    finishSM(pB0, pB1, alB, l_reg, pa0, pa1, pa2, pa3); SBAR();
    if (j + 3 < NT) SLOAD(SE, (j + 1 + SDEPTH) * KVBLK); SBAR();
    pv_d0(o, vb0 + (int)SHM_V, pa0, pa1, pa2, pa3); partialSM(pA0, pA1, m_reg, mnA, alA);
    __syncthreads(); SWAIT(); SWRITE(1, SO);
    RESC(alA); __syncthreads();
  }
  SBAR(); qkt(pB0, pB1, (bf16*)((char*)K_lds + SHM_K), qr, r32, hi);
  finishSM(pA0, pA1, alA, l_reg, pa0, pa1, pa2, pa3); SBAR();
  pv_d0(o, vb0, pa0, pa1, pa2, pa3); partialSM(pB0, pB1, m_reg, mnB, alB);
  __syncthreads(); RESC(alB);
  finishSM(pB0, pB1, alB, l_reg, pa0, pa1, pa2, pa3); SBAR();
  pv_d0(o, vb0 + (int)SHM_V, pa0, pa1, pa2, pa3);
  if (hi == 0) li_l[r32] = l_reg; asm volatile("s_waitcnt lgkmcnt(0)" ::: "memory");
  float rli[16];
#pragma unroll
  for (int r = 0; r < 16; ++r) rli[r] = __builtin_amdgcn_rcpf(li_l[crow(r, hi)]);
  bf16* Ow = Ob + (long)(wid * QBLK) * LDO;
#pragma unroll
  for (int r = 0; r < 16; ++r) { int orow = crow(r, hi);
    for (int d0 = 0; d0 < 4; ++d0) { const float v = o[d0][r] * rli[r]; const unsigned u = __float_as_uint(v);
      Ow[(long)orow * LDO + d0 * 32 + r32] = (bf16)((u + 0x7fffu + ((u >> 16) & 1u)) >> 16); } }
#undef SLOAD
#undef SWRITE
#undef SWAIT
#undef RESC
}
#undef KSWZ
#undef SBAR
}

#define LAS __attribute__((address_space(3)))
typedef unsigned short bf16;
typedef unsigned v4u __attribute__((ext_vector_type(4)));
typedef unsigned v2u __attribute__((ext_vector_type(2)));
typedef float f32x4 __attribute__((ext_vector_type(4)));
typedef float f32x2 __attribute__((ext_vector_type(2)));

constexpr size_t HM = 1u << 19;
constexpr size_t WS_MOD = 2 * HM;
constexpr size_t WS_WAB = 4 * HM, WS_WABO = 21 * HM, WS_WFI0 = 25 * HM, WS_WFI1 = 47 * HM, WS_WFO0 = 69 * HM, WS_WFO1 = 80 * HM, WS_WQKV = 91 * HM, WS_WAO = 97 * HM;
constexpr size_t WS_XCTX = 102 * HM;
constexpr size_t WS_H = 110 * HM;
constexpr size_t WS_PROJ = 178 * HM;
constexpr size_t SEG = (size_t)M * 512;
constexpr size_t WS_ACT = 178 * HM;
constexpr size_t WS_Q = 178 * HM, WS_K = 246 * HM, WS_V = 263 * HM;
constexpr size_t WS_OG = 280 * HM;
constexpr size_t WS_Y = 382 * HM;
constexpr size_t WS_BG = 450 * HM;
constexpr size_t WS_END = 512 * HM;
static_assert(WS_BG + (size_t)M * 16 * 4 <= WS_END && WS_Y + (size_t)M * DM * 2 <= WS_BG && WS_PROJ + 8 * SEG * 2 == WS_BG, "ws map");
static_assert(WS_ACT + (size_t)M * DFF * 2 <= WS_Y && WS_V + (size_t)M * 256 * 2 <= WS_OG && WS_OG + (size_t)M * DM * 2 <= WS_Y, "ws map 2");

constexpr int LDS_BYTES = 147456;

__device__ __forceinline__ unsigned f2bf(float f) { unsigned u = __builtin_bit_cast(unsigned, f); return (u + 0x7fffu + ((u >> 16) & 1u)) >> 16; }
__device__ __forceinline__ unsigned pk2(float lo, float hi) { return f2bf(lo) | (f2bf(hi) << 16); }
__device__ __forceinline__ float bf2f(unsigned short h) { return __builtin_bit_cast(float, (unsigned)h << 16); }
__device__ __forceinline__ float bflo(unsigned w) { return __builtin_bit_cast(float, w << 16); }
__device__ __forceinline__ float bfhi(unsigned w) { return __builtin_bit_cast(float, w & 0xffff0000u); }
__device__ __forceinline__ float wave_sum(float v) {
#pragma unroll
    for (int o = 1; o < 64; o <<= 1) v += __shfl_xor(v, o);
    return v;
}
__device__ __forceinline__ float sigmoidf_(float x) { return 1.0f / (1.0f + __expf(-x)); }

struct Frame {
    LAS unsigned char* lds;
    int tid, lane, wave, G;
    const float* in[18]; float* out; unsigned char* ws;
    float* MOD; float* XCTX; bf16* H; bf16* PROJ; float* BG; bf16* OG; bf16* Y; bf16* ACT; bf16 *Q, *K, *V;
    bf16 *WAB, *WABO, *WFI0, *WFI1, *WFO0, *WFO1, *WQKV, *WAO;
};
enum { I_X = 0, I_C, I_CTX, I_CCTX, I_ADAW, I_ADAB, I_NORMG, I_FWIN, I_FWOUT, I_ABWIN, I_CONV, I_GATEB, I_LB, I_OUTG, I_ABWOUT, I_WQKV, I_QKG, I_AWOUT };

__device__ __forceinline__ int drow_of(int mode, int n0) { if (mode == 0) return n0; const int j = n0 < DFF ? n0 : n0 - DFF; return (j >> 7) * 256 + (n0 < DFF ? 0 : 128) + (j & 127); }
__device__ __forceinline__ void p0_transpose_item(const float* W, int K, int N, bf16* WT, int mode, LAS float* scr, int item, int lane) {
    const int nblk = (N + 31) / 32, kb = item / nblk, nb = item % nblk, k0 = 64 * kb, n0 = 32 * nb;
    const int n = n0 + (lane & 31); const bool ok = n < N;
#pragma unroll 8
    for (int i = 0; i < 32; ++i) { const int kk = 2 * i + (lane >> 5); scr[kk * 33 + (lane & 31)] = ok ? W[(size_t)(k0 + kk) * N + n] : 0.f; }
    asm volatile("s_waitcnt lgkmcnt(0)" ::: "memory");
    const int c = lane & 7; const int dr = drow_of(mode, n0);
#pragma unroll
    for (int j = 0; j < 4; ++j) { const int nn = (lane >> 3) + 8 * j; const LAS float* s = scr + (8 * c) * 33 + nn;
        v4u o; o.x = pk2(s[0 * 33], s[1 * 33]); o.y = pk2(s[2 * 33], s[3 * 33]); o.z = pk2(s[4 * 33], s[5 * 33]); o.w = pk2(s[6 * 33], s[7 * 33]);
        *(v4u*)(WT + (size_t)(dr + nn) * K + k0 + 8 * c) = o; }
    asm volatile("s_waitcnt lgkmcnt(0)" ::: "memory");
}
__device__ __forceinline__ void p0_prologue(Frame& F) {
    const int tid = F.tid, lane = F.lane, w = F.wave;
    if (blockIdx.x < 96) {
        LAS float* sc = (LAS float*)F.lds; LAS float* part = sc + 5120;
        for (int i = tid; i < 5120; i += 512) { const int j = i >> 10, k = i & 1023; const float v = j < 4 ? F.in[I_C][j * 1024 + k] : F.in[I_CCTX][k]; sc[i] = v * sigmoidf_(v); }
        __syncthreads();
        const int l = blockIdx.x / 48, col0 = (blockIdx.x % 48) * 128;
        const float* wp = F.in[I_ADAW] + ((size_t)l * 1024 + 128 * w) * 6144 + col0 + 2 * lane;
        float acc[5][2];
#pragma unroll
        for (int j = 0; j < 5; ++j) { acc[j][0] = 0.f; acc[j][1] = 0.f; }
#pragma unroll 8
        for (int kk = 0; kk < 128; ++kk) { const f32x2 wv = *(const f32x2*)(wp + (size_t)kk * 6144);
#pragma unroll
            for (int j = 0; j < 5; ++j) { const float s = sc[j * 1024 + 128 * w + kk]; acc[j][0] += s * wv.x; acc[j][1] += s * wv.y; } }
#pragma unroll
        for (int j = 0; j < 5; ++j) { part[(w * 5 + j) * 128 + 2 * lane] = acc[j][0]; part[(w * 5 + j) * 128 + 2 * lane + 1] = acc[j][1]; }
        __syncthreads();
        for (int i = tid; i < 640; i += 512) { const int j = i >> 7, cc = i & 127; float s = 0.f;
#pragma unroll
            for (int ww = 0; ww < 8; ++ww) s += part[(ww * 5 + j) * 128 + cc];
            F.MOD[(size_t)(l * 5 + j) * 6144 + col0 + cc] = s + F.in[I_ADAB][l * 6144 + col0 + cc]; }
        __syncthreads();
    }
    LAS float* scr = (LAS float*)(F.lds + w * 16384);
    const int gw = blockIdx.x * 8 + w, NGW = F.G * 8;
    constexpr int I_AB = 16 * 129, I_ABO = 16 * 32, I_FI = 16 * 176, I_FO = 44 * 32, I_QK = 16 * 48, I_AO = 16 * 32;
    constexpr int NITEMS = I_AB + I_ABO + 2 * I_FI + 2 * I_FO + I_QK + I_AO;
    for (int it = gw; it < NITEMS; it += NGW) {
        int r = it;
        if (r < I_AB) { p0_transpose_item(F.in[I_ABWIN], 1024, NAB, F.WAB, 0, scr, r, lane); continue; } r -= I_AB;
        if (r < I_ABO) { p0_transpose_item(F.in[I_ABWOUT], 1024, 1024, F.WABO, 0, scr, r, lane); continue; } r -= I_ABO;
        if (r < I_FI) { p0_transpose_item(F.in[I_FWIN], 1024, 2 * DFF, F.WFI0, 1, scr, r, lane); continue; } r -= I_FI;
        if (r < I_FI) { p0_transpose_item(F.in[I_FWIN] + (size_t)1024 * 2 * DFF, 1024, 2 * DFF, F.WFI1, 1, scr, r, lane); continue; } r -= I_FI;
        if (r < I_FO) { p0_transpose_item(F.in[I_FWOUT], DFF, 1024, F.WFO0, 0, scr, r, lane); continue; } r -= I_FO;
        if (r < I_FO) { p0_transpose_item(F.in[I_FWOUT] + (size_t)DFF * 1024, DFF, 1024, F.WFO1, 0, scr, r, lane); continue; } r -= I_FO;
        if (r < I_QK) { p0_transpose_item(F.in[I_WQKV], 1024, NQKV, F.WQKV, 0, scr, r, lane); continue; } r -= I_QK;
        p0_transpose_item(F.in[I_AWOUT], 1024, 1024, F.WAO, 0, scr, r, lane);
    }
    { const int gt = blockIdx.x * 512 + tid, NT_ = F.G * 512; const int n16 = (NABP - 4128) * 1024 * 2 / 16; v4u z = {0u, 0u, 0u, 0u};
      for (int i = gt; i < n16; i += NT_) *((v4u*)(F.WAB + (size_t)4128 * 1024) + i) = z; }
}

template <bool HAS_Y, bool WRITE_X, bool HAS_NEXT, bool LAT_ONLY>
__device__ __forceinline__ void rowpass(const Frame& F, const float* xs_lat, const float* xs_ctx, float* xd_lat, float* xd_ctx,
                                        const float* mod_y, int gate_off, const float* gn_y, const float* mod_n, int sh_off, int sc_off, const float* gn_n) {
    const int lane = F.lane, gw = blockIdx.x * 8 + F.wave, NGW = F.G * 8;
    for (int r = gw; r < M; r += NGW) {
        const int b = r / TT, tt = r - b * TT; const bool isctx = tt < CTX; if (LAT_ONLY && isctx) continue;
        const int j = isctx ? 4 : b;
        const size_t xo = isctx ? (size_t)(b * CTX + tt) * DM : (size_t)(b * SEQ + tt - CTX) * DM;
        const float* xs = (isctx ? xs_ctx : xs_lat) + xo;
        f32x4 x[4];
#pragma unroll
        for (int jj = 0; jj < 4; ++jj) x[jj] = *(const f32x4*)(xs + 4 * lane + 256 * jj);
        if (HAS_Y) {
            f32x4 y[4]; float ss = 0.f;
#pragma unroll
            for (int jj = 0; jj < 4; ++jj) { const v2u w = *(const v2u*)(F.Y + (size_t)r * DM + 4 * lane + 256 * jj);
                y[jj] = (f32x4){bflo(w.x), bfhi(w.x), bflo(w.y), bfhi(w.y)}; ss += (y[jj][0] * y[jj][0] + y[jj][1] * y[jj][1]) + (y[jj][2] * y[jj][2] + y[jj][3] * y[jj][3]); }
            const float rstd = rsqrtf(wave_sum(ss) * (1.f / DM) + EPS);
#pragma unroll
            for (int jj = 0; jj < 4; ++jj) { const int c = 4 * lane + 256 * jj;
                const f32x4 g = *(const f32x4*)(mod_y + (size_t)j * 6144 + gate_off + c), gn = *(const f32x4*)(gn_y + c);
                x[jj] = x[jj] + g * (y[jj] * rstd * gn); }
        }
        if (WRITE_X) { float* xd = (isctx ? xd_ctx : xd_lat) + xo;
#pragma unroll
            for (int jj = 0; jj < 4; ++jj) *(f32x4*)(xd + 4 * lane + 256 * jj) = x[jj]; }
        if (HAS_NEXT) {
            float ss = 0.f;
#pragma unroll
            for (int jj = 0; jj < 4; ++jj) ss += (x[jj][0] * x[jj][0] + x[jj][1] * x[jj][1]) + (x[jj][2] * x[jj][2] + x[jj][3] * x[jj][3]);
            const float rstd = rsqrtf(wave_sum(ss) * (1.f / DM) + EPS);
#pragma unroll
            for (int jj = 0; jj < 4; ++jj) { const int c = 4 * lane + 256 * jj;
                const f32x4 sh = *(const f32x4*)(mod_n + (size_t)j * 6144 + sh_off + c), sc = *(const f32x4*)(mod_n + (size_t)j * 6144 + sc_off + c), gn = *(const f32x4*)(gn_n + c);
                const f32x4 hv = (x[jj] * rstd * gn) * (sc + 1.0f) + sh;
                v2u o; o.x = pk2(hv[0], hv[1]); o.y = pk2(hv[2], hv[3]);
                *(v2u*)(F.H + (size_t)r * DM + c) = o; }
        }
    }
}

__device__ __forceinline__ int scan_row(int b, int dir, int n) {
    if (n < CTX) return b * TT + (dir ? CTX - 1 - n : n);
    const int i = n - CTX; return b * TT + CTX + (dir ? SEQ - 1 - i : i);
}
__device__ __forceinline__ void scan_hgrn_naive(const Frame& F, int ch, bf16* OF, bf16* OB) {
    const int tid = F.tid, e = tid & 127, dg = tid >> 7;
    const int b = ch >> 3, h = (ch >> 1) & 3, dir = ch & 1;
    const bf16* QA = F.PROJ; const bf16* VA = F.PROJ + SEG; const bf16* Z = F.PROJ + (3 + dir) * SEG;
    bf16* O = dir ? OB : OF;
    LAS float* raw = (LAS float*)F.lds;
    LAS float* fkq = raw + 2 * 6144;
    LAS float* opart = fkq + 768;
    float lb = 0.f;
    if (tid < 128) { const float* p = F.in[I_LB] + (size_t)dir * 3 * 512 + h * 128 + tid; const float a0 = p[0], a1 = p[512], a2 = p[1024];
        const float mx = fmaxf(a0, fmaxf(a1, a2)); const float e0 = __expf(a0 - mx), e1 = __expf(a1 - mx), e2 = __expf(a2 - mx); lb = e0 / (e0 + e1 + e2); }
    float S[32];
#pragma unroll
    for (int i = 0; i < 32; ++i) S[i] = 0.f;
    float pre[12];
    constexpr int NG = TT / 16;
#define HG_LOAD(g) do { _Pragma("unroll") for (int j = 0; j < 12; ++j) { const int idx = tid + 512 * j; const int tok = idx / 384, rem = idx - tok * 384, which = rem >> 7, c = rem & 127; \
        const int row = scan_row(b, dir, (g) * 16 + tok); const bf16* src = which == 0 ? Z : (which == 1 ? QA : VA); pre[j] = bf2f(src[(size_t)row * 512 + h * 128 + c]); } } while (0)
#define HG_WRITE(g) do { _Pragma("unroll") for (int j = 0; j < 12; ++j) raw[((g) & 1) * 6144 + tid + 512 * j] = pre[j]; } while (0)
#define HG_FKQ(gb, tok1, dstb) do { const float z = raw[(gb) * 6144 + (tok1) * 384 + tid], q = raw[(gb) * 6144 + (tok1) * 384 + 128 + tid]; const float sg = sigmoidf_(z); \
        fkq[(dstb) * 384 + tid] = lb + (1.f - lb) * sg; fkq[(dstb) * 384 + 128 + tid] = (1.f - lb) * (1.f - sg); fkq[(dstb) * 384 + 256 + tid] = q; } while (0)
    HG_LOAD(0); HG_WRITE(0); __syncthreads();
    if (tid < 128) HG_FKQ(0, 0, 0);
    __syncthreads();
    for (int g = 0; g < NG; ++g) {
        if (g + 1 < NG) HG_LOAD(g + 1);
        for (int tok = 0; tok < 16; ++tok) {
            const int n = g * 16 + tok, cur = n & 1;
            const float ve = raw[(g & 1) * 6144 + tok * 384 + 256 + e];
            float o = 0.f;
#pragma unroll
            for (int dd = 0; dd < 32; ++dd) { const int d = dg * 32 + dd; const float f = fkq[cur * 384 + d], k = fkq[cur * 384 + 128 + d], q = fkq[cur * 384 + 256 + d];
                S[dd] = f * S[dd] + k * ve; o += S[dd] * q; }
            opart[cur * 512 + dg * 128 + e] = o;
            if (tok == 8 && g + 1 < NG) HG_WRITE(g + 1);
            if (tid < 128 && n + 1 < TT) { const int tok1 = (tok + 1) & 15, gb = (tok == 15) ? ((g + 1) & 1) : (g & 1); HG_FKQ(gb, tok1, cur ^ 1); }
            __syncthreads();
            if (dg == 0) { const float s = (opart[cur * 512 + e] + opart[cur * 512 + 128 + e]) + (opart[cur * 512 + 256 + e] + opart[cur * 512 + 384 + e]);
                O[(size_t)scan_row(b, dir, n) * DM + h * 128 + e] = (bf16)f2bf(s); }
        }
    }
#undef HG_LOAD
#undef HG_WRITE
#undef HG_FKQ
    __syncthreads();
}
__device__ __forceinline__ void scan_mlstm_naive(const Frame& F, int ch, bf16* OF, bf16* OB) {
    const int tid = F.tid, e = tid & 127, dg = tid >> 7;
    const int b = ch >> 3, h = (ch >> 1) & 3, dir = ch & 1;
    const bf16* BQK = F.PROJ + 5 * SEG; const bf16* VB = F.PROJ + 6 * SEG;
    bf16* O = dir ? OB : OF;
    constexpr int RAWN = 4384;
    LAS float* raw = (LAS float*)F.lds;
    LAS float* qk = raw + 2 * RAWN;
    LAS float* opart = qk + 256;
    LAS float* dpart = opart + 1024;
    float w0 = 0.f, w1 = 0.f, w2 = 0.f;
    if (tid < 128) { const int col = tid < 64 ? h * 64 + tid : 256 + h * 64 + (tid - 64); w0 = F.in[I_CONV][col]; w1 = F.in[I_CONV][512 + col]; w2 = F.in[I_CONV][1024 + col]; }
    float C[16], ns[16];
#pragma unroll
    for (int i = 0; i < 16; ++i) { C[i] = 0.f; ns[i] = 0.f; }
    float m = 0.f;
    float pre[9];
    constexpr int NG = TT / 16;
#define ML_GEOM(g, L_, tlo_, rb_) const int n0_ = (g) * 16; const bool lat_ = n0_ >= CTX; const int i0_ = lat_ ? n0_ - CTX : n0_; const int L_ = lat_ ? SEQ : CTX; \
        const int tlo_ = dir ? L_ - 1 - (i0_ + 15) : i0_; const int rb_ = b * TT + (lat_ ? CTX : 0);
#define ML_LOAD(g) do { ML_GEOM(g, L, tlo, rb) _Pragma("unroll") for (int j = 0; j < 9; ++j) { const int idx = tid + 512 * j; float val = 0.f; \
        if (idx < 2304) { const int rr = idx >> 7, c = idx & 127, t = tlo - 1 + rr; const int col = c < 64 ? h * 64 + c : 256 + h * 64 + (c - 64); \
            if (t >= 0 && t < L) val = bf2f(BQK[(size_t)(rb + t) * 512 + col]); } \
        else if (idx < 4352) { const int i2 = idx - 2304, tok = i2 >> 7, c = i2 & 127; const int t = dir ? tlo + 15 - tok : tlo + tok; val = bf2f(VB[(size_t)(rb + t) * 512 + h * 128 + c]); } \
        else if (idx < RAWN) { const int i3 = idx - 4352, tok = i3 >> 1, which = i3 & 1; const int t = dir ? tlo + 15 - tok : tlo + tok; const int gi = 4 * (2 * dir + which) + h; \
            val = F.BG[(size_t)(rb + t) * 16 + gi] + F.in[I_GATEB][gi]; } \
        pre[j] = val; } } while (0)
#define ML_WRITE(g) do { _Pragma("unroll") for (int j = 0; j < 9; ++j) { const int idx = tid + 512 * j; if (idx < RAWN) raw[((g) & 1) * RAWN + idx] = pre[j]; } } while (0)
#define ML_QK(gb, tok1, dstb) do { const int rr = (dir ? 15 - (tok1) : (tok1)) + 1; const LAS float* rp = raw + (gb) * RAWN + rr * 128 + tid; \
        const float cv = w0 * rp[-128] + w1 * rp[0] + w2 * rp[128]; const float s = cv * sigmoidf_(cv); qk[(dstb) * 128 + tid] = tid < 64 ? s * 0.125f : s; } while (0)
    ML_LOAD(0); ML_WRITE(0); __syncthreads();
    if (tid < 128) ML_QK(0, 0, 0);
    __syncthreads();
    for (int g = 0; g < NG; ++g) {
        if (g + 1 < NG) ML_LOAD(g + 1);
        for (int tok = 0; tok < 16; ++tok) {
            const int n = g * 16 + tok, cur = n & 1;
            const LAS float* rg = raw + (g & 1) * RAWN;
            const float ve = rg[2304 + tok * 128 + e];
            const float ig = rg[4352 + 2 * tok], fg = rg[4352 + 2 * tok + 1];
            const float logf = fminf(fg, 0.f) - log1pf(__expf(-fabsf(fg)));
            const float mnew = fmaxf(logf + m, ig);
            const float fw = __expf(logf + m - mnew), iw = __expf(ig - mnew);
            float num = 0.f, den = 0.f;
#pragma unroll
            for (int dd = 0; dd < 16; ++dd) { const int d = dg * 16 + dd; const float qd = qk[cur * 128 + d], kd = qk[cur * 128 + 64 + d];
                C[dd] = fw * C[dd] + (iw * kd) * ve; ns[dd] = fw * ns[dd] + iw * kd; num += C[dd] * qd; den += ns[dd] * qd; }
            opart[cur * 512 + dg * 128 + e] = num; if (e == 0) dpart[cur * 4 + dg] = den;
            m = mnew;
            if (tok == 8 && g + 1 < NG) ML_WRITE(g + 1);
            if (tid < 128 && n + 1 < TT) { const int tok1 = (tok + 1) & 15, gb = (tok == 15) ? ((g + 1) & 1) : (g & 1); ML_QK(gb, tok1, cur ^ 1); }
            __syncthreads();
            if (dg == 0) { const float s = (opart[cur * 512 + e] + opart[cur * 512 + 128 + e]) + (opart[cur * 512 + 256 + e] + opart[cur * 512 + 384 + e]);
                const float dn = (dpart[cur * 4] + dpart[cur * 4 + 1]) + (dpart[cur * 4 + 2] + dpart[cur * 4 + 3]);
                const float hv = s / fmaxf(fabsf(dn), __expf(-mnew));
                O[(size_t)scan_row(b, dir, n) * DM + 512 + h * 128 + e] = (bf16)f2bf(hv); }
        }
    }
#undef ML_GEOM
#undef ML_LOAD
#undef ML_WRITE
#undef ML_QK
    __syncthreads();
}

__device__ __forceinline__ void og_pass(const Frame& F, const bf16* OF, const bf16* OB) {
    const int lane = F.lane, gw = blockIdx.x * 8 + F.wave, NGW = F.G * 8;
    const bf16* GA = F.PROJ + 2 * SEG; const bf16* GB = F.PROJ + 7 * SEG;
    for (int r = gw; r < M; r += NGW) {
        const int c0 = 16 * lane;
        const v4u a0 = *(const v4u*)(OF + (size_t)r * DM + c0), a1 = *(const v4u*)(OF + (size_t)r * DM + c0 + 8);
        const v4u b0 = *(const v4u*)(OB + (size_t)r * DM + c0), b1 = *(const v4u*)(OB + (size_t)r * DM + c0 + 8);
        const bf16* gp = c0 < 512 ? GA + (size_t)r * 512 + c0 : GB + (size_t)r * 512 + (c0 - 512);
        const v4u g0 = *(const v4u*)gp, g1 = *(const v4u*)(gp + 8);
        float v[16], gt[16];
#pragma unroll
        for (int i = 0; i < 4; ++i) { v[2 * i] = bflo(a0[i]) + bflo(b0[i]); v[2 * i + 1] = bfhi(a0[i]) + bfhi(b0[i]); v[8 + 2 * i] = bflo(a1[i]) + bflo(b1[i]); v[8 + 2 * i + 1] = bfhi(a1[i]) + bfhi(b1[i]);
            gt[2 * i] = bflo(g0[i]); gt[2 * i + 1] = bfhi(g0[i]); gt[8 + 2 * i] = bflo(g1[i]); gt[8 + 2 * i + 1] = bfhi(g1[i]); }
        float ss = 0.f;
#pragma unroll
        for (int i = 0; i < 16; ++i) ss += v[i] * v[i];
        ss += __shfl_xor(ss, 1); ss += __shfl_xor(ss, 2); ss += __shfl_xor(ss, 4);
        const float rstd = rsqrtf(ss * (1.f / 128.f) + EPS);
        const float* og = F.in[I_OUTG] + c0;
        unsigned o[8];
#pragma unroll
        for (int i = 0; i < 8; ++i) o[i] = pk2(v[2 * i] * rstd * og[2 * i] * gt[2 * i], v[2 * i + 1] * rstd * og[2 * i + 1] * gt[2 * i + 1]);
        *(v4u*)(F.OG + (size_t)r * DM + c0) = (v4u){o[0], o[1], o[2], o[3]}; *(v4u*)(F.OG + (size_t)r * DM + c0 + 8) = (v4u){o[4], o[5], o[6], o[7]};
    }
}

__device__ __forceinline__ void qknorm_pass(const Frame& F) {
    const int lane = F.lane, gw = blockIdx.x * 8 + F.wave, NGW = F.G * 8;
    const float inv = exp2f(-(float)(2 * (lane & 31)) * (13.287712379549449f / 64.f));
    for (int r = gw; r < M; r += NGW) {
        const int b = r / TT, tt = r - b * TT; const bool isctx = tt < CTX;
        float c0 = 1.f, s0 = 0.f, c1 = 1.f, s1 = 0.f;
        if (!isctx) { const int t = tt - CTX; sincosf((float)(t >> 6) * inv, &s0, &c0); sincosf((float)(t & 63) * inv, &s1, &c1); }
        for (int hh = (isctx ? 8 : 0); hh < 10; ++hh) {
            bf16* p = hh < 8 ? F.Q + (size_t)r * 1024 + hh * 128 : F.K + (size_t)r * 256 + (hh - 8) * 128;
            const float* g = F.in[I_QKG] + (hh < 8 ? 0 : 128);
            const float x0 = bf2f(p[lane]), x1 = bf2f(p[64 + lane]);
            const float rstd = rsqrtf(wave_sum(x0 * x0 + x1 * x1) * (1.f / 128.f) + EPS);
            float y0 = x0 * rstd * g[lane], y1 = x1 * rstd * g[64 + lane];
            if (!isctx) { const float p0 = __shfl_xor(y0, 32), p1 = __shfl_xor(y1, 32);
                y0 = lane < 32 ? y0 * c0 - p0 * s0 : y0 * c0 + p0 * s0;
                y1 = lane < 32 ? y1 * c1 - p1 * s1 : y1 * c1 + p1 * s1; }
            p[lane] = (bf16)f2bf(y0); p[64 + lane] = (bf16)f2bf(y1);
        }
    }
}

enum { PH_PRO = 0, PH_MOD0, PH_INPROJ, PH_SCAN, PH_OG, PH_OUT0, PH_ROW0A, PH_FFI0, PH_FFO0, PH_ROW0B, PH_QKV, PH_QKN, PH_ATTN, PH_OUT1, PH_ROW1A, PH_FFI1, PH_FFO1, PH_ROW1B, NPH };
struct Args { const float* in[18]; float* out; unsigned char* ws; int ph_lo, ph_hi; };

template <class FN> __device__ __forceinline__ void run_gemm(Frame& F, const bf16* A, const bf16* Bt, int N, int K, int skipctx, const FN& fn) {
    pg8::Gemm g{A, Bt, M, N, K}; pg8::TileOrder S; S.init(skipctx ? 64 : 68, N, F.G, (int)blockIdx.x, skipctx);
    pg8::Epi8<FN> E{fn};
    pg8::gemm_phase<pg8::Epi8<FN>, pg8::TileOrder, true, true>(F.lds, g, S, E);
}

__global__ void __launch_bounds__(512, 2) mk_fwd(Args args) {
    extern __shared__ __attribute__((aligned(16))) unsigned char lds[];
    cg::grid_group grid = cg::this_grid();
    Frame F;
    F.lds = (LAS unsigned char*)lds;
    F.tid = threadIdx.x; F.lane = F.tid & 63; F.wave = __builtin_amdgcn_readfirstlane(F.tid >> 6); F.G = gridDim.x;
#pragma unroll
    for (int i = 0; i < 18; ++i) F.in[i] = args.in[i];
    F.out = args.out; F.ws = args.ws;
    unsigned char* ws = args.ws;
    F.MOD = (float*)(ws + WS_MOD); F.XCTX = (float*)(ws + WS_XCTX); F.H = (bf16*)(ws + WS_H); F.PROJ = (bf16*)(ws + WS_PROJ); F.BG = (float*)(ws + WS_BG);
    F.OG = (bf16*)(ws + WS_OG); F.Y = (bf16*)(ws + WS_Y); F.ACT = (bf16*)(ws + WS_ACT); F.Q = (bf16*)(ws + WS_Q); F.K = (bf16*)(ws + WS_K); F.V = (bf16*)(ws + WS_V);
    F.WAB = (bf16*)(ws + WS_WAB); F.WABO = (bf16*)(ws + WS_WABO); F.WFI0 = (bf16*)(ws + WS_WFI0); F.WFI1 = (bf16*)(ws + WS_WFI1); F.WFO0 = (bf16*)(ws + WS_WFO0); F.WFO1 = (bf16*)(ws + WS_WFO1);
    F.WQKV = (bf16*)(ws + WS_WQKV); F.WAO = (bf16*)(ws + WS_WAO);
    bf16* OF = (bf16*)F.out;
    bf16* OB = F.H;
    const float* MOD0 = F.MOD; const float* MOD1 = F.MOD + 5 * 6144;
    const float* NG = F.in[I_NORMG];
    const int lo = args.ph_lo, hi = args.ph_hi;
#define IN(k) (lo <= (k) && (k) < hi)
#define SEAM(k) do { if (IN(k) && IN((k) + 1)) grid.sync(); } while (0)

    if (IN(PH_PRO)) p0_prologue(F);
    SEAM(PH_PRO);
    if (IN(PH_MOD0)) rowpass<false, false, true, false>(F, F.in[I_X], F.in[I_CTX], nullptr, nullptr, nullptr, 0, nullptr, MOD0, 0, 1024, NG + 0);
    SEAM(PH_MOD0);
    if (IN(PH_INPROJ)) run_gemm(F, F.H, F.WAB, NABP, 1024, 0, pg8::FProj{F.PROJ, F.BG});
    SEAM(PH_INPROJ);
    if (IN(PH_SCAN)) { if (blockIdx.x < 32) scan_hgrn_naive(F, blockIdx.x, OF, OB); else if (blockIdx.x < 64) scan_mlstm_naive(F, blockIdx.x - 32, OF, OB); }
    SEAM(PH_SCAN);
    if (IN(PH_OG)) og_pass(F, OF, OB);
    SEAM(PH_OG);
    if (IN(PH_OUT0)) run_gemm(F, F.OG, F.WABO, 1024, 1024, 0, pg8::FStore{F.Y, 1024});
    SEAM(PH_OUT0);
    if (IN(PH_ROW0A)) rowpass<true, true, true, false>(F, F.in[I_X], F.in[I_CTX], F.out, F.XCTX, MOD0, 2048, NG + 1024, MOD0, 3072, 4096, NG + 2048);
    SEAM(PH_ROW0A);
    if (IN(PH_FFI0)) run_gemm(F, F.H, F.WFI0, 2 * DFF, 1024, 0, pg8::FSwiglu{F.ACT});
    SEAM(PH_FFI0);
    if (IN(PH_FFO0)) run_gemm(F, F.ACT, F.WFO0, 1024, DFF, 0, pg8::FStore{F.Y, 1024});
    SEAM(PH_FFO0);
    if (IN(PH_ROW0B)) rowpass<true, true, true, false>(F, F.out, F.XCTX, F.out, F.XCTX, MOD0, 5120, NG + 3072, MOD1, 0, 1024, NG + 4096);
    SEAM(PH_ROW0B);
    if (IN(PH_QKV)) run_gemm(F, F.H, F.WQKV, NQKV, 1024, 0, pg8::FQkv{F.Q, F.K, F.V});
    SEAM(PH_QKV);
    if (IN(PH_QKN)) qknorm_pass(F);
    SEAM(PH_QKN);
    if (IN(PH_ATTN)) {
        const int bx = blockIdx.x, vcu = (F.G % 8 == 0) ? (bx % 8) * (F.G / 8) + bx / 8 : bx;
        for (int u = vcu; u < 512; u += F.G) {
            const int uu = (u % 256) * 2 + u / 256;
            const int g = uu & 3, qb = (uu >> 2) & 15, kvh = (uu >> 6) & 1, b = uu >> 7, head = kvh * 4 + g;
            const size_t qrow = (size_t)b * TT + CTX + qb * 256;
            attn::attn_dense_body(F.Q + qrow * 1024 + head * 128, F.K + (size_t)b * TT * 256 + kvh * 128, F.V + (size_t)b * TT * 256 + kvh * 128,
                                  F.OG + qrow * 1024 + head * 128, TT, (char*)lds);
            __syncthreads();
        }
    }
    SEAM(PH_ATTN);
    if (IN(PH_OUT1)) run_gemm(F, F.OG, F.WAO, 1024, 1024, 1, pg8::FStore{F.Y, 1024});
    SEAM(PH_OUT1);
    if (IN(PH_ROW1A)) rowpass<true, true, true, true>(F, F.out, F.XCTX, F.out, F.XCTX, MOD1, 2048, NG + 5120, MOD1, 3072, 4096, NG + 6144);
    SEAM(PH_ROW1A);
    if (IN(PH_FFI1)) run_gemm(F, F.H, F.WFI1, 2 * DFF, 1024, 1, pg8::FSwiglu{F.ACT});
    SEAM(PH_FFI1);
    if (IN(PH_FFO1)) run_gemm(F, F.ACT, F.WFO1, 1024, DFF, 1, pg8::FStore{F.Y, 1024});
    SEAM(PH_FFO1);
    if (IN(PH_ROW1B)) rowpass<true, true, false, true>(F, F.out, F.XCTX, F.out, F.XCTX, MOD1, 5120, NG + 7168, nullptr, 0, 0, nullptr);
#undef IN
#undef SEAM
}

extern "C" void kernel_launch(void* const* d_in, const int* in_sizes, int n_in, void* d_out, int out_size, void* d_ws, size_t ws_size, hipStream_t stream) {
    static int grid = 0;
    if (grid == 0) {
        if (n_in != 18 || in_sizes[0] != NB * SEQ * DM || out_size != NB * SEQ * DM || ws_size < WS_END) {
            fprintf(stderr, "kernel_launch: unexpected shapes (n_in %d, in0 %d, out %d, ws %zu)\n", n_in, n_in > 0 ? in_sizes[0] : -1, out_size, ws_size); grid = -1; return; }
        int dev = 0, cus = 0, per_cu = 0;
        if (hipGetDevice(&dev) != hipSuccess || hipDeviceGetAttribute(&cus, hipDeviceAttributeMultiprocessorCount, dev) != hipSuccess) { grid = -1; return; }
        if (hipFuncSetAttribute((const void*)mk_fwd, hipFuncAttributeMaxDynamicSharedMemorySize, LDS_BYTES) != hipSuccess) { fprintf(stderr, "kernel_launch: hipFuncSetAttribute failed\n"); grid = -1; return; }
        if (hipOccupancyMaxActiveBlocksPerMultiprocessor(&per_cu, (const void*)mk_fwd, 512, LDS_BYTES) != hipSuccess || per_cu < 1) { fprintf(stderr, "kernel_launch: occupancy query says %d blocks per CU\n", per_cu); per_cu = 1; }
        (void)hipGetLastError();
        grid = cus;
        fprintf(stderr, "kernel_launch: grid %d (occupancy query %d per CU)\n", grid, per_cu);
    }
    if (grid < 0) return;
    Args a{};
    for (int i = 0; i < 18; ++i) a.in[i] = (const float*)d_in[i];
    a.out = (float*)d_out; a.ws = (unsigned char*)d_ws;
#if MK_ONE
    a.ph_lo = 0; a.ph_hi = NPH;
    void* kargs[] = {&a};
    hipError_t e = hipLaunchCooperativeKernel((const void*)mk_fwd, dim3(grid), dim3(512), kargs, LDS_BYTES, stream);
    if (e != hipSuccess) fprintf(stderr, "kernel_launch: cooperative launch failed: %s (grid %d)\n", hipGetErrorString(e), grid);
#else
    for (int p = 0; p < NPH; ++p) { a.ph_lo = p; a.ph_hi = p + 1; hipLaunchKernelGGL(mk_fwd, dim3(grid), dim3(512), LDS_BYTES, stream, a); }
    const hipError_t le = hipPeekAtLastError();
    if (le != hipSuccess) fprintf(stderr, "kernel_launch: launch failed: %s\n", hipGetErrorName(le));
#endif
}
```

```cpp
#include <hip/hip_runtime.h>
#include <hip/hip_cooperative_groups.h>
#include <cstdio>
#include <cstdint>
namespace cg = cooperative_groups;

constexpr int DM = 1024, NB = 4, SEQ = 4096, CTX = 256, TT = SEQ + CTX, M = NB * TT;
constexpr int DFF = 2816, NAB = 4112, NABP = 4352, NQKV = 1536;
constexpr float EPS = 1e-6f;
#ifndef MK_ONE
#define MK_ONE 1
#endif
#ifndef SCAN_NAIVE
#define SCAN_NAIVE 0
#endif

namespace pg8 {
#define PG8_LAS __attribute__((address_space(3)))
typedef unsigned short bf16_t;
typedef short bf16x8 __attribute__((ext_vector_type(8)));
typedef float f32x4 __attribute__((ext_vector_type(4)));
typedef unsigned u32x4 __attribute__((ext_vector_type(4)));
constexpr int BM = 256, BK = 64, HALF = 128, HTB = HALF * BK * 2  , STAGE_BYTES = 8 * HTB, NXCD = 8, WGM = 8;

__host__ __device__ __forceinline__ int lds_byte(int r, int c) { const int st = (r >> 4) * 2 + (c >> 5), rr = r & 15, cc = c & 31, ob = rr * 64 + cc * 2; return st * 1024 + (ob ^ (((ob >> 9) & 1) << 5)); }
__host__ __device__ __forceinline__ void stage_rc(int b, int& R, int& C) { const int st = b / 1024, sb = b % 1024, swz = sb ^ (((sb >> 9) & 1) << 5); R = (st >> 1) * 16 + swz / 64; C = (st & 1) * 32 + (swz % 64) / 2; }
__host__ __device__ __forceinline__ int perm32(int rho) { const int n = rho >> 4, i = rho & 15; return 8 * (i >> 2) + 4 * n + (i & 3); }

struct Unit { int pm, pn; };
struct Gemm { const bf16_t* A; const bf16_t* Bt; int M, N, K; };

struct TileOrder {
    int nM, nN, nwg, G, c, skip;
    __device__ void init(int nM_, int N, int G_, int c_, int skip_) { nM = nM_; nN = N / BM; nwg = nM * nN; G = G_; c = c_; skip = skip_; }
    __device__ bool next(int i, Unit& u) const {
        const long L = (long)i * G + c; if (L >= nwg) return false;
        int wgid = (int)L; { const int q = nwg / NXCD, r = nwg % NXCD, xcd = wgid % NXCD, off = wgid / NXCD; wgid = (xcd < r ? xcd * (q + 1) : r * (q + 1) + (xcd - r) * q) + off; }
        const int nig = WGM * nN, gid = wgid / nig, fm = gid * WGM, gsz = (nM - fm) < WGM ? (nM - fm) : WGM;
        int pm = fm + ((wgid % nig) % gsz); u.pn = (wgid % nig) / gsz;
        if (skip) pm = pm + (pm >> 4) + 1;
        u.pm = pm; return true;
    }
    __device__ __forceinline__ void a_ready(const Unit&) const {}
    __device__ __forceinline__ void done(const Unit&) const {}
};

__device__ __forceinline__ unsigned cvt_pk_bf16(float lo, float hi) { unsigned r; asm volatile("v_cvt_pk_bf16_f32 %0, %1, %2" : "=v"(r) : "v"(lo), "v"(hi)); return r; }
__device__ __forceinline__ u32x4 pack8(const f32x4 a, const f32x4 b) { u32x4 w; w.x = cvt_pk_bf16(a[0], a[1]); w.y = cvt_pk_bf16(a[2], a[3]); w.z = cvt_pk_bf16(b[0], b[1]); w.w = cvt_pk_bf16(b[2], b[3]); return w; }
__device__ __forceinline__ float fsigmoid(float x) { return __builtin_amdgcn_rcpf(1.0f + __expf(-x)); }
__device__ __forceinline__ f32x4 silu4(f32x4 v) { f32x4 o; o[0] = v[0] * fsigmoid(v[0]); o[1] = v[1] * fsigmoid(v[1]); o[2] = v[2] * fsigmoid(v[2]); o[3] = v[3] * fsigmoid(v[3]); return o; }
__device__ __forceinline__ f32x4 sigm4(f32x4 v) { f32x4 o; o[0] = fsigmoid(v[0]); o[1] = fsigmoid(v[1]); o[2] = fsigmoid(v[2]); o[3] = fsigmoid(v[3]); return o; }

template <class F> struct Epi8 {
    static constexpr bool PERM = true, AFTER_DRAIN = false;
    F f;
    __device__ __forceinline__ void operator()(const f32x4 (&acc)[2][2][4][2], const Unit& u, int wr, int wc, int fr, int fq) const {
        const int col = u.pn * BM + wc * 32 + 8 * fq;
#pragma unroll
        for (int ai = 0; ai < 2; ++ai)
#pragma unroll
            for (int m = 0; m < 4; ++m) { const int row = u.pm * BM + ai * HALF + wr * 64 + m * 16 + fr;
                f.apply(row, col, acc[ai][0][m][0], acc[ai][0][m][1], acc[ai][1][m][0], acc[ai][1][m][1]); }
    }
};
struct FProj {
    bf16_t* proj; float* bg;
    __device__ __forceinline__ void one(int row, int c, f32x4 v0, f32x4 v1) const {
        if (c >= 4096) { if (c < 4112) { float* p = bg + (size_t)row * 16 + (c - 4096); *(f32x4*)p = v0; *(f32x4*)(p + 4) = v1; } return; }
        const int seg = c >> 9, cs = c & 511;
        if (seg == 2) { v0 = silu4(v0); v1 = silu4(v1); }
        if (seg == 7) { v0 = sigm4(v0); v1 = sigm4(v1); }
        *(u32x4*)(proj + (size_t)seg * ((size_t)M * 512) + (size_t)row * 512 + cs) = pack8(v0, v1);
    }
    __device__ __forceinline__ void apply(int row, int col, f32x4 a0, f32x4 a1, f32x4 b0, f32x4 b1) const { one(row, col, a0, a1); one(row, col + 128, b0, b1); }
};
struct FStore {
    bf16_t* O; int ld;
    __device__ __forceinline__ void apply(int row, int col, f32x4 a0, f32x4 a1, f32x4 b0, f32x4 b1) const {
        bf16_t* p = O + (size_t)row * ld + col; *(u32x4*)p = pack8(a0, a1); *(u32x4*)(p + 128) = pack8(b0, b1); }
};
struct FSwiglu {
    bf16_t* act;
    __device__ __forceinline__ void apply(int row, int col, f32x4 a0, f32x4 a1, f32x4 b0, f32x4 b1) const {
        const int hc = (col >> 8) * 128 + (col & 255);
        *(u32x4*)(act + (size_t)row * DFF + hc) = pack8(silu4(a0) * b0, silu4(a1) * b1); }
};
struct FQkv {
    bf16_t *q, *k, *v;
    __device__ __forceinline__ void one(int row, int c, f32x4 v0, f32x4 v1) const {
        bf16_t* p = c < 1024 ? q + (size_t)row * 1024 + c : (c < 1280 ? k + (size_t)row * 256 + (c - 1024) : v + (size_t)row * 256 + (c - 1280));
        *(u32x4*)p = pack8(v0, v1); }
    __device__ __forceinline__ void apply(int row, int col, f32x4 a0, f32x4 a1, f32x4 b0, f32x4 b1) const { one(row, col, a0, a1); one(row, col + 128, b0, b1); }
};

template <class Epi, class Sched, bool ALIGN_EPI = false, bool SP2 = false>
__device__ __forceinline__ void gemm_phase(PG8_LAS unsigned char* lds, const Gemm g, const Sched& S, const Epi& E) {
    const int tid = threadIdx.x, wid = __builtin_amdgcn_readfirstlane(tid >> 6), lane = tid & 63, wr = wid >> 2, wc = wid & 3, fr = lane & 15, fq = lane >> 4;
    const int K = g.K, nt = K / BK;
    unsigned voffA[2], voffB[2];
#pragma unroll
    for (int i = 0; i < 2; ++i) { int R, C; stage_rc(tid * 16 + i * 8192, R, C); const int Rb = Epi::PERM ? ((R & ~31) + perm32(R & 31)) : R;
        voffA[i] = (unsigned)(R * K + C) * 2u; voffB[i] = (unsigned)(Rb * K + C) * 2u; }
    const size_t kstep = (size_t)(BK * 2);
    const size_t hstep = (size_t)HALF * K * 2;
    const size_t tstep = 2 * hstep;
    const unsigned ldsw = (unsigned)wid * 1024u;
    const int aoff = lds_byte(wr * 64 + fr, fq * 8), boff = lds_byte(wc * 32 + fr, fq * 8);
#define PG8_SA(b, h) (((b) * 2 + (h)) * HTB)
#define PG8_SB(b, h) ((4 + (b) * 2 + (h)) * HTB)
#define PG8_STAGE(bufoff, gbase, voff) do { _Pragma("unroll") for (int _i = 0; _i < 2; ++_i) \
        __builtin_amdgcn_global_load_lds((const unsigned*)((const char*)(gbase) + (voff)[_i]), (PG8_LAS unsigned*)(lds + (bufoff) + ldsw + _i * 8192), 16, 0, 0); } while (0)
#define PG8_LDA(dst, b, h) do { _Pragma("unroll") for (int m = 0; m < 4; ++m) _Pragma("unroll") for (int k = 0; k < 2; ++k) dst[m][k] = *(const PG8_LAS bf16x8*)(lds + PG8_SA(b, h) + aoff + m * 2048 + k * 1024); } while (0)
#define PG8_LDB(dst, b, h) do { _Pragma("unroll") for (int n = 0; n < 2; ++n) _Pragma("unroll") for (int k = 0; k < 2; ++k) dst[n][k] = *(const PG8_LAS bf16x8*)(lds + PG8_SB(b, h) + boff + n * 2048 + k * 1024); } while (0)
#define PG8_MMA(ai, bj, At, Bt) do { __builtin_amdgcn_s_setprio(1); _Pragma("unroll") for (int m = 0; m < 4; ++m) _Pragma("unroll") for (int n = 0; n < 2; ++n) _Pragma("unroll") for (int k = 0; k < 2; ++k) \
        acc[ai][bj][m][n] = __builtin_amdgcn_mfma_f32_16x16x32_bf16(Bt[n][k], At[m][k], acc[ai][bj][m][n], 0, 0, 0); __builtin_amdgcn_s_setprio(0); } while (0)
#define PG8_WAIT_V(n) asm volatile("s_waitcnt vmcnt(" #n ")" ::: "memory")
#define PG8_WAIT_L(n) asm volatile("s_waitcnt lgkmcnt(" #n ")" ::: "memory")
#define PG8_BAR __builtin_amdgcn_s_barrier()
#define PG8_SCHED __builtin_amdgcn_sched_barrier(0)
    Unit cur, nxt; int ui = 0;
    if (!S.next(0, cur)) return;
    f32x4 acc[2][2][4][2];
#pragma unroll
    for (int a = 0; a < 2; ++a)
#pragma unroll
        for (int b = 0; b < 2; ++b)
#pragma unroll
            for (int m = 0; m < 4; ++m)
#pragma unroll
                for (int n = 0; n < 2; ++n) acc[a][b][m][n] = (f32x4){0.f, 0.f, 0.f, 0.f};
    bf16x8 At[4][2], B0[2][2], B1[2][2];
    const char* cA = (const char*)g.A + (size_t)cur.pm * tstep; const char* cB = (const char*)g.Bt + (size_t)cur.pn * tstep;
    S.a_ready(cur);
    if constexpr (SP2) {
        PG8_STAGE(PG8_SB(0, 0), cB, voffB); PG8_STAGE(PG8_SB(0, 1), cB + hstep, voffB); PG8_STAGE(PG8_SA(0, 0), cA, voffA); PG8_STAGE(PG8_SA(0, 1), cA + hstep, voffA);
        if (wr == 1) PG8_BAR;
        PG8_WAIT_V(2); PG8_BAR;
        PG8_STAGE(PG8_SB(1, 0), cB + kstep, voffB); PG8_STAGE(PG8_SA(1, 0), cA + kstep, voffA); PG8_STAGE(PG8_SB(1, 1), cB + hstep + kstep, voffB);
        PG8_WAIT_V(6); PG8_BAR;
    } else {
        PG8_STAGE(PG8_SB(0, 0), cB, voffB); PG8_STAGE(PG8_SA(0, 0), cA, voffA); PG8_STAGE(PG8_SB(0, 1), cB + hstep, voffB); PG8_STAGE(PG8_SA(0, 1), cA + hstep, voffA);
        if (wr == 1) PG8_BAR;
        PG8_WAIT_V(4); PG8_BAR;
        PG8_STAGE(PG8_SB(1, 0), cB + kstep, voffB); PG8_STAGE(PG8_SA(1, 0), cA + kstep, voffA); PG8_STAGE(PG8_SB(1, 1), cB + hstep + kstep, voffB);
        PG8_WAIT_V(6); PG8_BAR;
    }
    for (;;) {
        const bool has_next = S.next(ui + 1, nxt);
        const char* nA = has_next ? (const char*)g.A + (size_t)nxt.pm * tstep : cA; const char* nB = has_next ? (const char*)g.Bt + (size_t)nxt.pn * tstep : cB;
        for (int t = 0; t < nt; t += 2) {
            const bool last = (t == nt - 2);
            const char* a1 = cA + (size_t)(t + 1) * kstep;
            const char* a2 = last ? nA : cA + (size_t)(t + 2) * kstep; const char* b2 = last ? nB : cB + (size_t)(t + 2) * kstep;
            const char* a3 = a2 + kstep; const char* b3 = b2 + kstep;
            if (last && has_next) S.a_ready(nxt);
            if constexpr (SP2) {
            PG8_LDB(B0, 0, 0); PG8_LDB(B1, 0, 1); PG8_SCHED; PG8_LDA(At, 0, 0); PG8_STAGE(PG8_SA(1, 1), a1 + hstep, voffA);
            PG8_WAIT_V(8); PG8_WAIT_L(0); PG8_BAR; PG8_MMA(0, 0, At, B0); PG8_MMA(0, 1, At, B1); PG8_BAR; PG8_SCHED;
            PG8_LDA(At, 0, 1); PG8_STAGE(PG8_SB(0, 0), b2, voffB); PG8_STAGE(PG8_SB(0, 1), b2 + hstep, voffB); PG8_STAGE(PG8_SA(0, 0), a2, voffA);
            PG8_WAIT_V(8); PG8_WAIT_L(0); PG8_BAR; PG8_MMA(1, 0, At, B0); PG8_MMA(1, 1, At, B1); PG8_BAR; PG8_SCHED;
            PG8_LDB(B0, 1, 0); PG8_LDB(B1, 1, 1); PG8_SCHED; PG8_LDA(At, 1, 0); PG8_STAGE(PG8_SA(0, 1), a2 + hstep, voffA);
            PG8_WAIT_V(8); PG8_WAIT_L(0); PG8_BAR; PG8_MMA(0, 0, At, B0); PG8_MMA(0, 1, At, B1); PG8_BAR; PG8_SCHED;
            PG8_LDA(At, 1, 1); PG8_STAGE(PG8_SB(1, 0), b3, voffB); PG8_STAGE(PG8_SB(1, 1), b3 + hstep, voffB); PG8_STAGE(PG8_SA(1, 0), a3, voffA);
            PG8_WAIT_V(8); PG8_WAIT_L(0); PG8_BAR; PG8_MMA(1, 0, At, B0); PG8_MMA(1, 1, At, B1); PG8_BAR; PG8_SCHED;
            } else {
            PG8_LDB(B0, 0, 0); PG8_SCHED; PG8_LDA(At, 0, 0); PG8_STAGE(PG8_SA(1, 1), a1 + hstep, voffA);
            PG8_WAIT_L(8); PG8_BAR; PG8_WAIT_L(0); PG8_MMA(0, 0, At, B0); PG8_BAR; PG8_SCHED;
            PG8_LDB(B1, 0, 1); PG8_STAGE(PG8_SB(0, 0), b2, voffB);
            PG8_BAR; PG8_WAIT_L(0); PG8_MMA(0, 1, At, B1); PG8_BAR;
            PG8_LDA(At, 0, 1); PG8_STAGE(PG8_SA(0, 0), a2, voffA);
            PG8_BAR; PG8_WAIT_L(0); PG8_MMA(1, 0, At, B0); PG8_BAR; PG8_SCHED;
            PG8_STAGE(PG8_SB(0, 1), b2 + hstep, voffB);
            PG8_WAIT_V(6); PG8_BAR; PG8_MMA(1, 1, At, B1); PG8_BAR;
            PG8_LDB(B0, 1, 0); PG8_SCHED; PG8_LDA(At, 1, 0); PG8_STAGE(PG8_SA(0, 1), a2 + hstep, voffA);
            PG8_WAIT_L(8); PG8_BAR; PG8_WAIT_L(0); PG8_MMA(0, 0, At, B0); PG8_BAR; PG8_SCHED;
            PG8_LDB(B1, 1, 1); PG8_STAGE(PG8_SB(1, 0), b3, voffB);
            PG8_BAR; PG8_WAIT_L(0); PG8_MMA(0, 1, At, B1); PG8_BAR;
            PG8_LDA(At, 1, 1); PG8_STAGE(PG8_SA(1, 0), a3, voffA);
            PG8_BAR; PG8_WAIT_L(0); PG8_MMA(1, 0, At, B0); PG8_BAR; PG8_SCHED;
            PG8_STAGE(PG8_SB(1, 1), b3 + hstep, voffB);
            PG8_WAIT_V(6); PG8_BAR; PG8_MMA(1, 1, At, B1); PG8_BAR;
            }
        }
        if constexpr (ALIGN_EPI) { if (wr == 0) PG8_BAR; }
        if constexpr (!Epi::AFTER_DRAIN) { E(acc, cur, wr, wc, fr, fq); S.done(cur); }
        if (!has_next) break;
#pragma unroll
        for (int a = 0; a < 2; ++a)
#pragma unroll
            for (int b = 0; b < 2; ++b)
#pragma unroll
                for (int m = 0; m < 4; ++m)
#pragma unroll
                    for (int n = 0; n < 2; ++n) acc[a][b][m][n] = (f32x4){0.f, 0.f, 0.f, 0.f};
        cur = nxt; cA = nA; cB = nB; ++ui;
        if constexpr (ALIGN_EPI) { if (wr == 1) PG8_BAR; }
    }
    PG8_WAIT_V(0);
    if constexpr (!ALIGN_EPI) { if (wr == 0) PG8_BAR; }
    PG8_BAR;
    if constexpr (Epi::AFTER_DRAIN) { E.fused(acc, cur, wr, wc, fr, fq, lds, wid, lane); S.done(cur); }
#undef PG8_SA
#undef PG8_SB
#undef PG8_STAGE
#undef PG8_LDA
#undef PG8_LDB
#undef PG8_MMA
#undef PG8_WAIT_V
#undef PG8_WAIT_L
#undef PG8_BAR
#undef PG8_SCHED
}
}

namespace attn {
typedef unsigned short bf16;
using bf16x8 = __attribute__((ext_vector_type(8))) short;
using s16x4  = __attribute__((ext_vector_type(4))) short;
using f32x16 = __attribute__((ext_vector_type(16))) float;
using u32x4  = __attribute__((ext_vector_type(4))) unsigned;
constexpr int D = 128, NW = 8, QBLK = 32, KVBLK = 64;
constexpr float SCALE = 0.088388347648318440f;
constexpr float THR = 8.f;
constexpr int LDQ = 1024, LDK = 256, LDO = 1024;
constexpr size_t SHM_V = KVBLK * D * 2, SHM_K = KVBLK * D * 2, SHM_ATTN = 2 * SHM_V + 2 * SHM_K + NW * 64 * 4;
#define KSWZ(row, colB) ((row) * 256 + ((colB) ^ (((row) & 7) << 4)))
#define SBAR() __builtin_amdgcn_sched_barrier(0)
__device__ __forceinline__ int crow(int r, int hi) { return (r & 3) + 8 * (r >> 2) + 4 * hi; }
__device__ __forceinline__ unsigned cvtpk(float lo, float hi) { unsigned r; asm volatile("v_cvt_pk_bf16_f32 %0, %1, %2" : "=v"(r) : "v"(lo), "v"(hi)); return r; }
__device__ __forceinline__ bf16x8 ld8(const bf16* p) { return *reinterpret_cast<const bf16x8*>(p); }

__device__ __forceinline__ void partialSM(f32x16& p0, f32x16& p1, float& m_reg, float& mn, float& alpha) {
  constexpr float C = SCALE * 1.4426950408889634f;
  float pmax = p0[0]; for (int r = 1; r < 16; ++r) pmax = fmaxf(pmax, p0[r]); for (int r = 0; r < 16; ++r) pmax = fmaxf(pmax, p1[r]);
  { auto rr = __builtin_amdgcn_permlane32_swap(__float_as_uint(pmax), __float_as_uint(pmax), false, false);
    pmax = fmaxf(__uint_as_float(rr[0]), __uint_as_float(rr[1])); }
  if (__builtin_expect(__all(pmax - m_reg <= THR / SCALE), 1)) { mn = m_reg; alpha = 1.f; }
  else { mn = fmaxf(m_reg, pmax); alpha = __builtin_amdgcn_exp2f((m_reg - mn) * C); m_reg = mn; }
  float mnC = -mn * C;
  for (int r = 0; r < 16; ++r) p0[r] = fmaf(p0[r], C, mnC); for (int r = 0; r < 16; ++r) p1[r] = fmaf(p1[r], C, mnC);
  for (int r = 0; r < 16; ++r) p0[r] = __builtin_amdgcn_exp2f(p0[r]);
}
__device__ __forceinline__ void finishSM(f32x16& p0, f32x16& p1, float alpha, float& l_reg, bf16x8& pa0, bf16x8& pa1, bf16x8& pa2, bf16x8& pa3) {
  for (int r = 0; r < 16; ++r) p1[r] = __builtin_amdgcn_exp2f(p1[r]);
  float ps = 0; for (int r = 0; r < 16; ++r) ps += p0[r]; for (int r = 0; r < 16; ++r) ps += p1[r];
  { auto rr = __builtin_amdgcn_permlane32_swap(__float_as_uint(ps), __float_as_uint(ps), false, false);
    ps = __uint_as_float(rr[0]) + __uint_as_float(rr[1]); }
  l_reg = l_reg * alpha + ps;
#define PK4(P, BASE, OUT) do { unsigned a0 = cvtpk(P[BASE + 0], P[BASE + 1]), a1 = cvtpk(P[BASE + 2], P[BASE + 3]);   \
    unsigned b0 = cvtpk(P[BASE + 4], P[BASE + 5]), b1 = cvtpk(P[BASE + 6], P[BASE + 7]);                              \
    auto r0 = __builtin_amdgcn_permlane32_swap(a0, b0, false, false); auto r1 = __builtin_amdgcn_permlane32_swap(a1, b1, false, false); \
    u32x4 w = {r0[0], r1[0], r0[1], r1[1]}; OUT = *reinterpret_cast<bf16x8*>(&w); } while (0)
  PK4(p0, 0, pa0); PK4(p0, 8, pa1); PK4(p1, 0, pa2); PK4(p1, 8, pa3);
#undef PK4
}
__device__ __forceinline__ void qkt(f32x16& p0, f32x16& p1, const bf16* Ks, const bf16x8* qr, int r32, int hi) {
  p0 = f32x16{}; p1 = f32x16{};
  for (int d0 = 0; d0 < 8; ++d0) { int cb = (d0 * 16 + hi * 8) * 2;
    bf16x8 b0 = *reinterpret_cast<const bf16x8*>((const char*)Ks + KSWZ(r32, cb));
    bf16x8 b1 = *reinterpret_cast<const bf16x8*>((const char*)Ks + KSWZ(32 + r32, cb));
    p0 = __builtin_amdgcn_mfma_f32_32x32x16_bf16(b0, qr[d0], p0, 0, 0, 0);
    p1 = __builtin_amdgcn_mfma_f32_32x32x16_bf16(b1, qr[d0], p1, 0, 0, 0); }
}
__device__ __forceinline__ int v_st(int k, int c) { const int kk = (k & ~0xC) | ((k & 4) << 1) | ((k & 8) >> 1); return ((kk >> 3) * 4 + (c >> 5)) * 512 + ((kk & 7) * 32 + (c & 31)) * 2; }
__device__ __forceinline__ int v_rd_base(int lane) { return ((lane & 3) << 3) | (((lane >> 2) & 3) << 6) | (((lane >> 4) & 1) << 5) | (((lane >> 5) & 1) << 8); }
constexpr int v_rd_off(int d0, int ks, int half) { return d0 * 512 + ks * 4096 + half * 2048; }
template <int OFF> __device__ __forceinline__ s16x4 tr_read(int vb) {
  s16x4 r; asm volatile("ds_read_b64_tr_b16 %0, %1 offset:%2" : "=&v"(r) : "v"(vb), "i"(OFF) : "memory"); return r;
}
template <int D0> __device__ __forceinline__ void pv_one(f32x16& od, int vb, bf16x8 pa0, bf16x8 pa1, bf16x8 pa2, bf16x8 pa3) {
  const s16x4 l0 = tr_read<v_rd_off(D0, 0, 0)>(vb), h0 = tr_read<v_rd_off(D0, 0, 1)>(vb), l1 = tr_read<v_rd_off(D0, 1, 0)>(vb), h1 = tr_read<v_rd_off(D0, 1, 1)>(vb);
  const s16x4 l2 = tr_read<v_rd_off(D0, 2, 0)>(vb), h2 = tr_read<v_rd_off(D0, 2, 1)>(vb), l3 = tr_read<v_rd_off(D0, 3, 0)>(vb), h3 = tr_read<v_rd_off(D0, 3, 1)>(vb);
  asm volatile("s_waitcnt lgkmcnt(0)" ::: "memory"); SBAR();
#define PK(L, H) (bf16x8){L[0], L[1], L[2], L[3], H[0], H[1], H[2], H[3]}
  od = __builtin_amdgcn_mfma_f32_32x32x16_bf16(pa0, PK(l0, h0), od, 0, 0, 0);
  od = __builtin_amdgcn_mfma_f32_32x32x16_bf16(pa1, PK(l1, h1), od, 0, 0, 0);
  od = __builtin_amdgcn_mfma_f32_32x32x16_bf16(pa2, PK(l2, h2), od, 0, 0, 0);
  od = __builtin_amdgcn_mfma_f32_32x32x16_bf16(pa3, PK(l3, h3), od, 0, 0, 0);
#undef PK
}
__device__ __forceinline__ void pv_d0(f32x16* o, int vb, bf16x8 pa0, bf16x8 pa1, bf16x8 pa2, bf16x8 pa3) {
  pv_one<0>(o[0], vb, pa0, pa1, pa2, pa3); pv_one<1>(o[1], vb, pa0, pa1, pa2, pa3); pv_one<2>(o[2], vb, pa0, pa1, pa2, pa3); pv_one<3>(o[3], vb, pa0, pa1, pa2, pa3);
}
__device__ __forceinline__ void attn_dense_body(const bf16* __restrict__ Qb, const bf16* __restrict__ Kh, const bf16* __restrict__ Vh,
                                                bf16* __restrict__ Ob, int seq, char* lds) {
  constexpr int SDEPTH = 2;
  const int tid = threadIdx.x, wid = tid >> 6, lane = tid & 63, r32 = lane & 31, hi = lane >> 5;
  bf16* V_lds = (bf16*)lds; bf16* K_lds = (bf16*)(lds + 2 * SHM_V);
  float* ws = (float*)(lds + 2 * SHM_V + 2 * SHM_K) + wid * 64; float* li_l = ws; float* al_l = ws + 32;
  float m_reg = -1e30f, l_reg = 0; f32x16 o[4] = {}; bf16x8 qr[8];
  const bf16* Qw = Qb + (long)(wid * QBLK + r32) * LDQ + hi * 8;
#pragma unroll
  for (int d0 = 0; d0 < 8; ++d0) qr[d0] = ld8(Qw + d0 * 16);
  const int sr = tid >> 4, sc = (tid & 15) * 8, vst0 = v_st(sr, sc), vst1 = v_st(32 + sr, sc);
  const int vb0 = (int)(uintptr_t)V_lds + v_rd_base(lane);
  struct { bf16x8 vs0, vs1, ks0, ks1; } sr_[SDEPTH];
#define SLOAD(i, k0) do { sr_[i].vs0 = ld8(&Vh[(long)((k0) + sr) * LDK + sc]); sr_[i].vs1 = ld8(&Vh[(long)((k0) + 32 + sr) * LDK + sc]); \
    sr_[i].ks0 = ld8(&Kh[(long)((k0) + sr) * LDK + sc]); sr_[i].ks1 = ld8(&Kh[(long)((k0) + 32 + sr) * LDK + sc]); } while (0)
#define SWRITE(b, i) do { *(bf16x8*)((char*)V_lds + (b) * SHM_V + vst0) = sr_[i].vs0;          \
    *(bf16x8*)((char*)V_lds + (b) * SHM_V + vst1) = sr_[i].vs1; int kc = sc * 2;               \
    *(bf16x8*)((char*)K_lds + (b) * SHM_K + KSWZ(sr, kc)) = sr_[i].ks0;                       \
    *(bf16x8*)((char*)K_lds + (b) * SHM_K + KSWZ(32 + sr, kc)) = sr_[i].ks1; } while (0)
#define SWAIT() do { asm volatile("s_waitcnt vmcnt(4)" ::: "memory"); } while (0)
#define RESC(a) do { if (__any((a) < 1.f)) { if (hi == 0) al_l[r32] = (a); asm volatile("s_waitcnt lgkmcnt(0)" ::: "memory"); \
    for (int d = 0; d < 4; ++d) for (int r = 0; r < 16; ++r) o[d][r] *= al_l[crow(r, hi)]; } } while (0)
  f32x16 pA0, pA1, pB0, pB1; float mnA, mnB, alA, alB; bf16x8 pa0, pa1, pa2, pa3; const int NT = seq / KVBLK;
  constexpr int SE = 0, SO = SDEPTH - 1;
  SLOAD(SE, 0); asm volatile("s_waitcnt vmcnt(0)" ::: "memory"); SWRITE(0, SE); __syncthreads();
  qkt(pA0, pA1, K_lds, qr, r32, hi); partialSM(pA0, pA1, m_reg, mnA, alA);
  SLOAD(SO, KVBLK); if (2 < NT) SLOAD(SE, 2 * KVBLK);
  SWAIT(); SWRITE(1, SO); __syncthreads();
  for (int j = 1; j + 1 < NT; j += 2) {
    SBAR(); qkt(pB0, pB1, (bf16*)((char*)K_lds + SHM_K), qr, r32, hi);
    finishSM(pA0, pA1, alA, l_reg, pa0, pa1, pa2, pa3); SBAR();
    SLOAD(SO, (j + SDEPTH) * KVBLK); SBAR();
    pv_d0(o, vb0, pa0, pa1, pa2, pa3); partialSM(pB0, pB1, m_reg, mnB, alB);
    __syncthreads(); SWAIT(); SWRITE(0, SE);
    RESC(alB); __syncthreads();
    SBAR(); qkt(pA0, pA1, K_lds, qr, r32, hi);
    finishSM(pB0, pB1, alB, l_reg, pa0, pa1, pa2, pa3); SBAR();
    if (j + 3 < NT) SLOAD(SE, (j + 1 + SDEPTH) * KVBLK); SBAR();
    pv_d0(o, vb0 + (int)SHM_V, pa0, pa1, pa2, pa3); partialSM(pA0, pA1, m_reg, mnA, alA);
    __syncthreads(); SWAIT(); SWRITE(1, SO);
    RESC(alA); __syncthreads();
  }
  SBAR(); qkt(pB0, pB1, (bf16*)((char*)K_lds + SHM_K), qr, r32, hi);
  finishSM(pA0, pA1, alA, l_reg, pa0, pa1, pa2, pa3); SBAR();
  pv_d0(o, vb0, pa0, pa1, pa2, pa3); partialSM(pB0, pB1, m_reg, mnB, alB);
  __syncthreads(); RESC(alB);
  finishSM(pB0, pB1, alB, l_reg, pa0, pa1, pa2, pa3); SBAR();
  pv_d0(o, vb0 + (int)SHM_V, pa0, pa1, pa2, pa3);
  if (hi == 0) li_l[r32] = l_reg; asm volatile("s_waitcnt lgkmcnt(0)" ::: "memory");
  float rli[16];
#pragma unroll
  for (int r = 0; r < 16; ++r) rli[r] = __builtin_amdgcn_rcpf(li_l[crow(r, hi)]);
  bf16* Ow = Ob + (long)(wid * QBLK) * LDO;
#pragma unroll
  for (int r = 0; r < 16; ++r) { int orow = crow(r, hi);
    for (int d0 = 0; d0 < 4; ++d0) { const float v = o[d0][r] * rli[r]; const unsigned u = __float_as_uint(v);
      Ow[(long)orow * LDO + d0 * 32 + r32] = (bf16)((u + 0x7fffu + ((u >> 16) & 1u)) >> 16); } }
#undef SLOAD
#undef SWRITE
#undef SWAIT
#undef RESC
}
#undef KSWZ
#undef SBAR
}

#define LAS __attribute__((address_space(3)))
typedef unsigned short bf16;
typedef unsigned v4u __attribute__((ext_vector_type(4)));
typedef unsigned v2u __attribute__((ext_vector_type(2)));
typedef float f32x4 __attribute__((ext_vector_type(4)));
typedef float f32x2 __attribute__((ext_vector_type(2)));

constexpr size_t HM = 1u << 19;
constexpr size_t WS_MOD = 2 * HM;
constexpr size_t WS_WAB = 4 * HM, WS_WABO = 21 * HM, WS_WFI0 = 25 * HM, WS_WFI1 = 47 * HM, WS_WFO0 = 69 * HM, WS_WFO1 = 80 * HM, WS_WQKV = 91 * HM, WS_WAO = 97 * HM;
constexpr size_t WS_XCTX = 102 * HM;
constexpr size_t WS_H = 110 * HM;
constexpr size_t WS_PROJ = 178 * HM;
constexpr size_t SEG = (size_t)M * 512;
constexpr size_t WS_ACT = 178 * HM;
constexpr size_t WS_Q = 178 * HM, WS_K = 246 * HM, WS_V = 263 * HM;
constexpr size_t WS_OG = 280 * HM;
constexpr size_t WS_Y = 382 * HM;
constexpr size_t WS_BG = 450 * HM;
constexpr size_t WS_END = 512 * HM;
static_assert(WS_BG + (size_t)M * 16 * 4 <= WS_END && WS_Y + (size_t)M * DM * 2 <= WS_BG && WS_PROJ + 8 * SEG * 2 == WS_BG, "ws map");
static_assert(WS_ACT + (size_t)M * DFF * 2 <= WS_Y && WS_V + (size_t)M * 256 * 2 <= WS_OG && WS_OG + (size_t)M * DM * 2 <= WS_Y, "ws map 2");

constexpr int LDS_BYTES = 147456;

__device__ __forceinline__ unsigned f2bf(float f) { unsigned u = __builtin_bit_cast(unsigned, f); return (u + 0x7fffu + ((u >> 16) & 1u)) >> 16; }
__device__ __forceinline__ unsigned pk2(float lo, float hi) { return f2bf(lo) | (f2bf(hi) << 16); }
__device__ __forceinline__ float bf2f(unsigned short h) { return __builtin_bit_cast(float, (unsigned)h << 16); }
__device__ __forceinline__ float bflo(unsigned w) { return __builtin_bit_cast(float, w << 16); }
__device__ __forceinline__ float bfhi(unsigned w) { return __builtin_bit_cast(float, w & 0xffff0000u); }
__device__ __forceinline__ float wave_sum(float v) {
#pragma unroll
    for (int o = 1; o < 64; o <<= 1) v += __shfl_xor(v, o);
    return v;
}
__device__ __forceinline__ float sigmoidf_(float x) { return 1.0f / (1.0f + __expf(-x)); }

struct Frame {
    LAS unsigned char* lds;
    int tid, lane, wave, G;
    const float* in[18]; float* out; unsigned char* ws;
    float* MOD; float* XCTX; bf16* H; bf16* PROJ; float* BG; bf16* OG; bf16* Y; bf16* ACT; bf16 *Q, *K, *V;
    bf16 *WAB, *WABO, *WFI0, *WFI1, *WFO0, *WFO1, *WQKV, *WAO;
};
enum { I_X = 0, I_C, I_CTX, I_CCTX, I_ADAW, I_ADAB, I_NORMG, I_FWIN, I_FWOUT, I_ABWIN, I_CONV, I_GATEB, I_LB, I_OUTG, I_ABWOUT, I_WQKV, I_QKG, I_AWOUT };

__device__ __forceinline__ int drow_of(int mode, int n0) { if (mode == 0) return n0; const int j = n0 < DFF ? n0 : n0 - DFF; return (j >> 7) * 256 + (n0 < DFF ? 0 : 128) + (j & 127); }
__device__ __forceinline__ void p0_transpose_item(const float* W, int K, int N, bf16* WT, int mode, LAS float* scr, int item, int lane) {
    const int nblk = (N + 31) / 32, kb = item / nblk, nb = item % nblk, k0 = 64 * kb, n0 = 32 * nb;
    const int n = n0 + (lane & 31); const bool ok = n < N;
#pragma unroll 8
    for (int i = 0; i < 32; ++i) { const int kk = 2 * i + (lane >> 5); scr[kk * 33 + (lane & 31)] = ok ? W[(size_t)(k0 + kk) * N + n] : 0.f; }
    asm volatile("s_waitcnt lgkmcnt(0)" ::: "memory");
    const int c = lane & 7; const int dr = drow_of(mode, n0);
#pragma unroll
    for (int j = 0; j < 4; ++j) { const int nn = (lane >> 3) + 8 * j; const LAS float* s = scr + (8 * c) * 33 + nn;
        v4u o; o.x = pk2(s[0 * 33], s[1 * 33]); o.y = pk2(s[2 * 33], s[3 * 33]); o.z = pk2(s[4 * 33], s[5 * 33]); o.w = pk2(s[6 * 33], s[7 * 33]);
        *(v4u*)(WT + (size_t)(dr + nn) * K + k0 + 8 * c) = o; }
    asm volatile("s_waitcnt lgkmcnt(0)" ::: "memory");
}
__device__ __forceinline__ void p0_prologue(Frame& F) {
    const int tid = F.tid, lane = F.lane, w = F.wave;
    if (blockIdx.x < 96) {
        LAS float* sc = (LAS float*)F.lds; LAS float* part = sc + 5120;
        for (int i = tid; i < 5120; i += 512) { const int j = i >> 10, k = i & 1023; const float v = j < 4 ? F.in[I_C][j * 1024 + k] : F.in[I_CCTX][k]; sc[i] = v * sigmoidf_(v); }
        __syncthreads();
        const int l = blockIdx.x / 48, col0 = (blockIdx.x % 48) * 128;
        const float* wp = F.in[I_ADAW] + ((size_t)l * 1024 + 128 * w) * 6144 + col0 + 2 * lane;
        float acc[5][2];
#pragma unroll
        for (int j = 0; j < 5; ++j) { acc[j][0] = 0.f; acc[j][1] = 0.f; }
#pragma unroll 8
        for (int kk = 0; kk < 128; ++kk) { const f32x2 wv = *(const f32x2*)(wp + (size_t)kk * 6144);
#pragma unroll
            for (int j = 0; j < 5; ++j) { const float s = sc[j * 1024 + 128 * w + kk]; acc[j][0] += s * wv.x; acc[j][1] += s * wv.y; } }
#pragma unroll
        for (int j = 0; j < 5; ++j) { part[(w * 5 + j) * 128 + 2 * lane] = acc[j][0]; part[(w * 5 + j) * 128 + 2 * lane + 1] = acc[j][1]; }
        __syncthreads();
        for (int i = tid; i < 640; i += 512) { const int j = i >> 7, cc = i & 127; float s = 0.f;
#pragma unroll
            for (int ww = 0; ww < 8; ++ww) s += part[(ww * 5 + j) * 128 + cc];
            F.MOD[(size_t)(l * 5 + j) * 6144 + col0 + cc] = s + F.in[I_ADAB][l * 6144 + col0 + cc]; }
        __syncthreads();
    }
    LAS float* scr = (LAS float*)(F.lds + w * 16384);
    const int gw = blockIdx.x * 8 + w, NGW = F.G * 8;
    constexpr int I_AB = 16 * 129, I_ABO = 16 * 32, I_FI = 16 * 176, I_FO = 44 * 32, I_QK = 16 * 48, I_AO = 16 * 32;
    constexpr int NITEMS = I_AB + I_ABO + 2 * I_FI + 2 * I_FO + I_QK + I_AO;
    for (int it = gw; it < NITEMS; it += NGW) {
        int r = it;
        if (r < I_AB) { p0_transpose_item(F.in[I_ABWIN], 1024, NAB, F.WAB, 0, scr, r, lane); continue; } r -= I_AB;
        if (r < I_ABO) { p0_transpose_item(F.in[I_ABWOUT], 1024, 1024, F.WABO, 0, scr, r, lane); continue; } r -= I_ABO;
        if (r < I_FI) { p0_transpose_item(F.in[I_FWIN], 1024, 2 * DFF, F.WFI0, 1, scr, r, lane); continue; } r -= I_FI;
        if (r < I_FI) { p0_transpose_item(F.in[I_FWIN] + (size_t)1024 * 2 * DFF, 1024, 2 * DFF, F.WFI1, 1, scr, r, lane); continue; } r -= I_FI;
        if (r < I_FO) { p0_transpose_item(F.in[I_FWOUT], DFF, 1024, F.WFO0, 0, scr, r, lane); continue; } r -= I_FO;
        if (r < I_FO) { p0_transpose_item(F.in[I_FWOUT] + (size_t)DFF * 1024, DFF, 1024, F.WFO1, 0, scr, r, lane); continue; } r -= I_FO;
        if (r < I_QK) { p0_transpose_item(F.in[I_WQKV], 1024, NQKV, F.WQKV, 0, scr, r, lane); continue; } r -= I_QK;
        p0_transpose_item(F.in[I_AWOUT], 1024, 1024, F.WAO, 0, scr, r, lane);
    }
    { const int gt = blockIdx.x * 512 + tid, NT_ = F.G * 512; const int n16 = (NABP - 4128) * 1024 * 2 / 16; v4u z = {0u, 0u, 0u, 0u};
      for (int i = gt; i < n16; i += NT_) *((v4u*)(F.WAB + (size_t)4128 * 1024) + i) = z; }
}

template <bool HAS_Y, bool WRITE_X, bool HAS_NEXT, bool LAT_ONLY>
__device__ __forceinline__ void rowpass(const Frame& F, const float* xs_lat, const float* xs_ctx, float* xd_lat, float* xd_ctx,
                                        const float* mod_y, int gate_off, const float* gn_y, const float* mod_n, int sh_off, int sc_off, const float* gn_n) {
    const int lane = F.lane, gw = blockIdx.x * 8 + F.wave, NGW = F.G * 8;
    for (int r = gw; r < M; r += NGW) {
        const int b = r / TT, tt = r - b * TT; const bool isctx = tt < CTX; if (LAT_ONLY && isctx) continue;
        const int j = isctx ? 4 : b;
        const size_t xo = isctx ? (size_t)(b * CTX + tt) * DM : (size_t)(b * SEQ + tt - CTX) * DM;
        const float* xs = (isctx ? xs_ctx : xs_lat) + xo;
        f32x4 x[4];
#pragma unroll
        for (int jj = 0; jj < 4; ++jj) x[jj] = *(const f32x4*)(xs + 4 * lane + 256 * jj);
        if (HAS_Y) {
            f32x4 y[4]; float ss = 0.f;
#pragma unroll
            for (int jj = 0; jj < 4; ++jj) { const v2u w = *(const v2u*)(F.Y + (size_t)r * DM + 4 * lane + 256 * jj);
                y[jj] = (f32x4){bflo(w.x), bfhi(w.x), bflo(w.y), bfhi(w.y)}; ss += (y[jj][0] * y[jj][0] + y[jj][1] * y[jj][1]) + (y[jj][2] * y[jj][2] + y[jj][3] * y[jj][3]); }
            const float rstd = rsqrtf(wave_sum(ss) * (1.f / DM) + EPS);
#pragma unroll
            for (int jj = 0; jj < 4; ++jj) { const int c = 4 * lane + 256 * jj;
                const f32x4 g = *(const f32x4*)(mod_y + (size_t)j * 6144 + gate_off + c), gn = *(const f32x4*)(gn_y + c);
                x[jj] = x[jj] + g * (y[jj] * rstd * gn); }
        }
        if (WRITE_X) { float* xd = (isctx ? xd_ctx : xd_lat) + xo;
#pragma unroll
            for (int jj = 0; jj < 4; ++jj) *(f32x4*)(xd + 4 * lane + 256 * jj) = x[jj]; }
        if (HAS_NEXT) {
            float ss = 0.f;
#pragma unroll
            for (int jj = 0; jj < 4; ++jj) ss += (x[jj][0] * x[jj][0] + x[jj][1] * x[jj][1]) + (x[jj][2] * x[jj][2] + x[jj][3] * x[jj][3]);
            const float rstd = rsqrtf(wave_sum(ss) * (1.f / DM) + EPS);
#pragma unroll
            for (int jj = 0; jj < 4; ++jj) { const int c = 4 * lane + 256 * jj;
                const f32x4 sh = *(const f32x4*)(mod_n + (size_t)j * 6144 + sh_off + c), sc = *(const f32x4*)(mod_n + (size_t)j * 6144 + sc_off + c), gn = *(const f32x4*)(gn_n + c);
                const f32x4 hv = (x[jj] * rstd * gn) * (sc + 1.0f) + sh;
                v2u o; o.x = pk2(hv[0], hv[1]); o.y = pk2(hv[2], hv[3]);
                *(v2u*)(F.H + (size_t)r * DM + c) = o; }
        }
    }
}

__device__ __forceinline__ int scan_row(int b, int dir, int n) {
    if (n < CTX) return b * TT + (dir ? CTX - 1 - n : n);
    const int i = n - CTX; return b * TT + CTX + (dir ? SEQ - 1 - i : i);
}
__device__ __forceinline__ void scan_hgrn_naive(const Frame& F, int ch, bf16* OF, bf16* OB) {
    const int tid = F.tid, e = tid & 127, dg = tid >> 7;
    const int b = ch >> 3, h = (ch >> 1) & 3, dir = ch & 1;
    const bf16* QA = F.PROJ; const bf16* VA = F.PROJ + SEG; const bf16* Z = F.PROJ + (3 + dir) * SEG;
    bf16* O = dir ? OB : OF;
    LAS float* raw = (LAS float*)F.lds;
    LAS float* fkq = raw + 2 * 6144;
    LAS float* opart = fkq + 768;
    float lb = 0.f;
    if (tid < 128) { const float* p = F.in[I_LB] + (size_t)dir * 3 * 512 + h * 128 + tid; const float a0 = p[0], a1 = p[512], a2 = p[1024];
        const float mx = fmaxf(a0, fmaxf(a1, a2)); const float e0 = __expf(a0 - mx), e1 = __expf(a1 - mx), e2 = __expf(a2 - mx); lb = e0 / (e0 + e1 + e2); }
    float S[32];
#pragma unroll
    for (int i = 0; i < 32; ++i) S[i] = 0.f;
    float pre[12];
    constexpr int NG = TT / 16;
#define HG_LOAD(g) do { _Pragma("unroll") for (int j = 0; j < 12; ++j) { const int idx = tid + 512 * j; const int tok = idx / 384, rem = idx - tok * 384, which = rem >> 7, c = rem & 127; \
        const int row = scan_row(b, dir, (g) * 16 + tok); const bf16* src = which == 0 ? Z : (which == 1 ? QA : VA); pre[j] = bf2f(src[(size_t)row * 512 + h * 128 + c]); } } while (0)
#define HG_WRITE(g) do { _Pragma("unroll") for (int j = 0; j < 12; ++j) raw[((g) & 1) * 6144 + tid + 512 * j] = pre[j]; } while (0)
#define HG_FKQ(gb, tok1, dstb) do { const float z = raw[(gb) * 6144 + (tok1) * 384 + tid], q = raw[(gb) * 6144 + (tok1) * 384 + 128 + tid]; const float sg = sigmoidf_(z); \
        fkq[(dstb) * 384 + tid] = lb + (1.f - lb) * sg; fkq[(dstb) * 384 + 128 + tid] = (1.f - lb) * (1.f - sg); fkq[(dstb) * 384 + 256 + tid] = q; } while (0)
    HG_LOAD(0); HG_WRITE(0); __syncthreads();
    if (tid < 128) HG_FKQ(0, 0, 0);
    __syncthreads();
    for (int g = 0; g < NG; ++g) {
        if (g + 1 < NG) HG_LOAD(g + 1);
        for (int tok = 0; tok < 16; ++tok) {
            const int n = g * 16 + tok, cur = n & 1;
            const float ve = raw[(g & 1) * 6144 + tok * 384 + 256 + e];
            float o = 0.f;
#pragma unroll
            for (int dd = 0; dd < 32; ++dd) { const int d = dg * 32 + dd; const float f = fkq[cur * 384 + d], k = fkq[cur * 384 + 128 + d], q = fkq[cur * 384 + 256 + d];
                S[dd] = f * S[dd] + k * ve; o += S[dd] * q; }
            opart[cur * 512 + dg * 128 + e] = o;
            if (tok == 8 && g + 1 < NG) HG_WRITE(g + 1);
            if (tid < 128 && n + 1 < TT) { const int tok1 = (tok + 1) & 15, gb = (tok == 15) ? ((g + 1) & 1) : (g & 1); HG_FKQ(gb, tok1, cur ^ 1); }
            __syncthreads();
            if (dg == 0) { const float s = (opart[cur * 512 + e] + opart[cur * 512 + 128 + e]) + (opart[cur * 512 + 256 + e] + opart[cur * 512 + 384 + e]);
                O[(size_t)scan_row(b, dir, n) * DM + h * 128 + e] = (bf16)f2bf(s); }
        }
    }
#undef HG_LOAD
#undef HG_WRITE
#undef HG_FKQ
    __syncthreads();
}
__device__ __forceinline__ void scan_mlstm_naive(const Frame& F, int ch, bf16* OF, bf16* OB) {
    const int tid = F.tid, e = tid & 127, dg = tid >> 7;
    const int b = ch >> 3, h = (ch >> 1) & 3, dir = ch & 1;
    const bf16* BQK = F.PROJ + 5 * SEG; const bf16* VB = F.PROJ + 6 * SEG;
    bf16* O = dir ? OB : OF;
    constexpr int RAWN = 4384;
    LAS float* raw = (LAS float*)F.lds;
    LAS float* qk = raw + 2 * RAWN;
    LAS float* opart = qk + 256;
    LAS float* dpart = opart + 1024;
    float w0 = 0.f, w1 = 0.f, w2 = 0.f;
    if (tid < 128) { const int col = tid < 64 ? h * 64 + tid : 256 + h * 64 + (tid - 64); w0 = F.in[I_CONV][col]; w1 = F.in[I_CONV][512 + col]; w2 = F.in[I_CONV][1024 + col]; }
    float C[16], ns[16];
#pragma unroll
    for (int i = 0; i < 16; ++i) { C[i] = 0.f; ns[i] = 0.f; }
    float m = 0.f;
    float pre[9];
    constexpr int NG = TT / 16;
#define ML_GEOM(g, L_, tlo_, rb_) const int n0_ = (g) * 16; const bool lat_ = n0_ >= CTX; const int i0_ = lat_ ? n0_ - CTX : n0_; const int L_ = lat_ ? SEQ : CTX; \
        const int tlo_ = dir ? L_ - 1 - (i0_ + 15) : i0_; const int rb_ = b * TT + (lat_ ? CTX : 0);
#define ML_LOAD(g) do { ML_GEOM(g, L, tlo, rb) _Pragma("unroll") for (int j = 0; j < 9; ++j) { const int idx = tid + 512 * j; float val = 0.f; \
        if (idx < 2304) { const int rr = idx >> 7, c = idx & 127, t = tlo - 1 + rr; const int col = c < 64 ? h * 64 + c : 256 + h * 64 + (c - 64); \
            if (t >= 0 && t < L) val = bf2f(BQK[(size_t)(rb + t) * 512 + col]); } \
        else if (idx < 4352) { const int i2 = idx - 2304, tok = i2 >> 7, c = i2 & 127; const int t = dir ? tlo + 15 - tok : tlo + tok; val = bf2f(VB[(size_t)(rb + t) * 512 + h * 128 + c]); } \
        else if (idx < RAWN) { const int i3 = idx - 4352, tok = i3 >> 1, which = i3 & 1; const int t = dir ? tlo + 15 - tok : tlo + tok; const int gi = 4 * (2 * dir + which) + h; \
            val = F.BG[(size_t)(rb + t) * 16 + gi] + F.in[I_GATEB][gi]; } \
        pre[j] = val; } } while (0)
#define ML_WRITE(g) do { _Pragma("unroll") for (int j = 0; j < 9; ++j) { const int idx = tid + 512 * j; if (idx < RAWN) raw[((g) & 1) * RAWN + idx] = pre[j]; } } while (0)
#define ML_QK(gb, tok1, dstb) do { const int rr = (dir ? 15 - (tok1) : (tok1)) + 1; const LAS float* rp = raw + (gb) * RAWN + rr * 128 + tid; \
        const float cv = w0 * rp[-128] + w1 * rp[0] + w2 * rp[128]; const float s = cv * sigmoidf_(cv); qk[(dstb) * 128 + tid] = tid < 64 ? s * 0.125f : s; } while (0)
    ML_LOAD(0); ML_WRITE(0); __syncthreads();
    if (tid < 128) ML_QK(0, 0, 0);
    __syncthreads();
    for (int g = 0; g < NG; ++g) {
        if (g + 1 < NG) ML_LOAD(g + 1);
        for (int tok = 0; tok < 16; ++tok) {
            const int n = g * 16 + tok, cur = n & 1;
            const LAS float* rg = raw + (g & 1) * RAWN;
            const float ve = rg[2304 + tok * 128 + e];
            const float ig = rg[4352 + 2 * tok], fg = rg[4352 + 2 * tok + 1];
            const float logf = fminf(fg, 0.f) - log1pf(__expf(-fabsf(fg)));
            const float mnew = fmaxf(logf + m, ig);
            const float fw = __expf(logf + m - mnew), iw = __expf(ig - mnew);
            float num = 0.f, den = 0.f;
#pragma unroll
            for (int dd = 0; dd < 16; ++dd) { const int d = dg * 16 + dd; const float qd = qk[cur * 128 + d], kd = qk[cur * 128 + 64 + d];
                C[dd] = fw * C[dd] + (iw * kd) * ve; ns[dd] = fw * ns[dd] + iw * kd; num += C[dd] * qd; den += ns[dd] * qd; }
            opart[cur * 512 + dg * 128 + e] = num; if (e == 0) dpart[cur * 4 + dg] = den;
            m = mnew;
            if (tok == 8 && g + 1 < NG) ML_WRITE(g + 1);
            if (tid < 128 && n + 1 < TT) { const int tok1 = (tok + 1) & 15, gb = (tok == 15) ? ((g + 1) & 1) : (g & 1); ML_QK(gb, tok1, cur ^ 1); }
            __syncthreads();
            if (dg == 0) { const float s = (opart[cur * 512 + e] + opart[cur * 512 + 128 + e]) + (opart[cur * 512 + 256 + e] + opart[cur * 512 + 384 + e]);
                const float dn = (dpart[cur * 4] + dpart[cur * 4 + 1]) + (dpart[cur * 4 + 2] + dpart[cur * 4 + 3]);
                const float hv = s / fmaxf(fabsf(dn), __expf(-mnew));
                O[(size_t)scan_row(b, dir, n) * DM + 512 + h * 128 + e] = (bf16)f2bf(hv); }
        }
    }
#undef ML_GEOM
#undef ML_LOAD
#undef ML_WRITE
#undef ML_QK
    __syncthreads();
}

__device__ __forceinline__ void og_pass(const Frame& F, const bf16* OF, const bf16* OB) {
    const int lane = F.lane, gw = blockIdx.x * 8 + F.wave, NGW = F.G * 8;
    const bf16* GA = F.PROJ + 2 * SEG; const bf16* GB = F.PROJ + 7 * SEG;
    for (int r = gw; r < M; r += NGW) {
        const int c0 = 16 * lane;
        const v4u a0 = *(const v4u*)(OF + (size_t)r * DM + c0), a1 = *(const v4u*)(OF + (size_t)r * DM + c0 + 8);
        const v4u b0 = *(const v4u*)(OB + (size_t)r * DM + c0), b1 = *(const v4u*)(OB + (size_t)r * DM + c0 + 8);
        const bf16* gp = c0 < 512 ? GA + (size_t)r * 512 + c0 : GB + (size_t)r * 512 + (c0 - 512);
        const v4u g0 = *(const v4u*)gp, g1 = *(const v4u*)(gp + 8);
        float v[16], gt[16];
#pragma unroll
        for (int i = 0; i < 4; ++i) { v[2 * i] = bflo(a0[i]) + bflo(b0[i]); v[2 * i + 1] = bfhi(a0[i]) + bfhi(b0[i]); v[8 + 2 * i] = bflo(a1[i]) + bflo(b1[i]); v[8 + 2 * i + 1] = bfhi(a1[i]) + bfhi(b1[i]);
            gt[2 * i] = bflo(g0[i]); gt[2 * i + 1] = bfhi(g0[i]); gt[8 + 2 * i] = bflo(g1[i]); gt[8 + 2 * i + 1] = bfhi(g1[i]); }
        float ss = 0.f;
#pragma unroll
        for (int i = 0; i < 16; ++i) ss += v[i] * v[i];
        ss += __shfl_xor(ss, 1); ss += __shfl_xor(ss, 2); ss += __shfl_xor(ss, 4);
        const float rstd = rsqrtf(ss * (1.f / 128.f) + EPS);
        const float* og = F.in[I_OUTG] + c0;
        unsigned o[8];
#pragma unroll
        for (int i = 0; i < 8; ++i) o[i] = pk2(v[2 * i] * rstd * og[2 * i] * gt[2 * i], v[2 * i + 1] * rstd * og[2 * i + 1] * gt[2 * i + 1]);
        *(v4u*)(F.OG + (size_t)r * DM + c0) = (v4u){o[0], o[1], o[2], o[3]}; *(v4u*)(F.OG + (size_t)r * DM + c0 + 8) = (v4u){o[4], o[5], o[6], o[7]};
    }
}

__device__ __forceinline__ void qknorm_pass(const Frame& F) {
    const int lane = F.lane, gw = blockIdx.x * 8 + F.wave, NGW = F.G * 8;
    const float inv = exp2f(-(float)(2 * (lane & 31)) * (13.287712379549449f / 64.f));
    for (int r = gw; r < M; r += NGW) {
        const int b = r / TT, tt = r - b * TT; const bool isctx = tt < CTX;
        float c0 = 1.f, s0 = 0.f, c1 = 1.f, s1 = 0.f;
        if (!isctx) { const int t = tt - CTX; sincosf((float)(t >> 6) * inv, &s0, &c0); sincosf((float)(t & 63) * inv, &s1, &c1); }
        for (int hh = (isctx ? 8 : 0); hh < 10; ++hh) {
            bf16* p = hh < 8 ? F.Q + (size_t)r * 1024 + hh * 128 : F.K + (size_t)r * 256 + (hh - 8) * 128;
            const float* g = F.in[I_QKG] + (hh < 8 ? 0 : 128);
            const float x0 = bf2f(p[lane]), x1 = bf2f(p[64 + lane]);
            const float rstd = rsqrtf(wave_sum(x0 * x0 + x1 * x1) * (1.f / 128.f) + EPS);
            float y0 = x0 * rstd * g[lane], y1 = x1 * rstd * g[64 + lane];
            if (!isctx) { const float p0 = __shfl_xor(y0, 32), p1 = __shfl_xor(y1, 32);
                y0 = lane < 32 ? y0 * c0 - p0 * s0 : y0 * c0 + p0 * s0;
                y1 = lane < 32 ? y1 * c1 - p1 * s1 : y1 * c1 + p1 * s1; }
            p[lane] = (bf16)f2bf(y0); p[64 + lane] = (bf16)f2bf(y1);
        }
    }
}

namespace scan {
typedef short bf16x8 __attribute__((ext_vector_type(8)));
typedef float f32x16 __attribute__((ext_vector_type(16)));
typedef float f32x4 __attribute__((ext_vector_type(4)));
typedef unsigned u32x4 __attribute__((ext_vector_type(4)));
typedef unsigned u32x2 __attribute__((ext_vector_type(2)));
constexpr int NCH = TT / 32;
constexpr int TS = 80;
__device__ __forceinline__ int crow(int r, int hi) { return (r & 3) + 8 * (r >> 2) + 4 * hi; }
__device__ __forceinline__ int kpos(int x) { return (x & ~12) | ((x & 4) << 1) | ((x & 8) >> 1); }
__device__ __forceinline__ unsigned cvtpk(float lo, float hi) { unsigned r; asm volatile("v_cvt_pk_bf16_f32 %0, %1, %2" : "=v"(r) : "v"(lo), "v"(hi)); return r; }
__device__ __forceinline__ bf16x8 pack8(const f32x16& v, int base) {
    u32x4 w; w.x = cvtpk(v[base + 0], v[base + 1]); w.y = cvtpk(v[base + 2], v[base + 3]); w.z = cvtpk(v[base + 4], v[base + 5]); w.w = cvtpk(v[base + 6], v[base + 7]);
    return __builtin_bit_cast(bf16x8, w); }
__device__ __forceinline__ float lo16(unsigned w) { return __builtin_bit_cast(float, w << 16); }
__device__ __forceinline__ float hi16(unsigned w) { return __builtin_bit_cast(float, w & 0xffff0000u); }
__device__ __forceinline__ float xhalf_sum(float v) { auto rr = __builtin_amdgcn_permlane32_swap(__float_as_uint(v), __float_as_uint(v), false, false); return __uint_as_float(rr[0]) + __uint_as_float(rr[1]); }
__device__ __forceinline__ int chunk_row0(int b, int dir, int c) {
    if (c < CTX / 32) return b * TT + (dir ? CTX - 1 - 32 * c : 32 * c);
    const int cc = c - CTX / 32; return b * TT + CTX + (dir ? SEQ - 1 - 32 * cc : 32 * cc);
}
template <int DK> struct Lay {
    static constexpr int RS = DK * 2 + 16;
    static constexpr int Q1 = 0, K1 = 32 * RS, Q2 = 64 * RS, K2T = 96 * RS, VT = K2T + DK * TS, SC = VT + 128 * TS, BYTES = SC + 1024;
};

template <int DK, bool ML>
__device__ __forceinline__ void consume(const LAS unsigned char* buf, f32x16 (&S)[DK / 32], LAS float* wpriv, int w, int r32, int hi,
                                        unsigned short* O, int row0, int rstep, int colbase) {
    using L = Lay<DK>; constexpr int DT = DK / 32, NK = DK / 16;
    const LAS unsigned char* q1 = buf + L::Q1 + r32 * L::RS + hi * 16;
    const LAS unsigned char* k1 = buf + L::K1 + r32 * L::RS + hi * 16;
    const LAS unsigned char* q2 = buf + L::Q2 + r32 * L::RS + hi * 16;
    const LAS float* sc = (const LAS float*)(buf + L::SC);
    f32x16 X = {}, o = {};
    bf16x8 q2f[NK];
#pragma unroll
    for (int ks = 0; ks < NK; ++ks) { const bf16x8 a = *(const LAS bf16x8*)(k1 + ks * 32), bq = *(const LAS bf16x8*)(q1 + ks * 32);
        X = __builtin_amdgcn_mfma_f32_32x32x16_bf16(a, bq, X, 0, 0, 0); }
#pragma unroll
    for (int ks = 0; ks < NK; ++ks) { q2f[ks] = *(const LAS bf16x8*)(q2 + ks * 32);
        o = __builtin_amdgcn_mfma_f32_32x32x16_bf16(q2f[ks], pack8(S[ks >> 1], (ks & 1) * 8), o, 0, 0, 0); }
    float rden[16];
    if (ML) {
        const float ct = sc[32 + r32];
        float colsum = 0.f;
#pragma unroll
        for (int g = 0; g < 4; ++g) { const f32x4 av = *(const LAS f32x4*)(sc + 8 * g + 4 * hi);
#pragma unroll
            for (int i = 0; i < 4; ++i) { const int r = 4 * g + i, s = 8 * g + 4 * hi + i; const float p = (s <= r32) ? __expf(av[i] - ct) : 0.f; X[r] *= p; colsum += X[r]; } }
        float qn = 0.f;
#pragma unroll
        for (int ks = 0; ks < NK; ++ks) { const u32x4 qa = __builtin_bit_cast(u32x4, q2f[ks]);
            const f32x4 n0 = *(const LAS f32x4*)(wpriv + 16 * ks + 4 * hi), n1 = *(const LAS f32x4*)(wpriv + 16 * ks + 8 + 4 * hi);
            qn += lo16(qa.x) * n0[0] + hi16(qa.x) * n0[1] + lo16(qa.y) * n0[2] + hi16(qa.y) * n0[3] + lo16(qa.z) * n1[0] + hi16(qa.z) * n1[1] + lo16(qa.w) * n1[2] + hi16(qa.w) * n1[3]; }
        const float den = xhalf_sum(colsum + qn);
        const float rd = 1.0f / fmaxf(fabsf(den), sc[64 + r32]);
        if (hi == 0) wpriv[64 + r32] = rd;
#pragma unroll
        for (int g = 0; g < 4; ++g) { const f32x4 dv = *(const LAS f32x4*)(wpriv + 64 + 8 * g + 4 * hi);
#pragma unroll
            for (int i = 0; i < 4; ++i) rden[4 * g + i] = dv[i]; }
    } else {
#pragma unroll
        for (int r = 0; r < 16; ++r) { if (crow(r, hi) > r32) X[r] = 0.f; }
    }
    const LAS unsigned char* vt = buf + L::VT + (32 * w + r32) * TS + hi * 16;
    const bf16x8 v0 = *(const LAS bf16x8*)(vt), v1 = *(const LAS bf16x8*)(vt + 32);
    o = __builtin_amdgcn_mfma_f32_32x32x16_bf16(pack8(X, 0), v0, o, 0, 0, 0);
    o = __builtin_amdgcn_mfma_f32_32x32x16_bf16(pack8(X, 8), v1, o, 0, 0, 0);
    const LAS unsigned char* k2 = buf + L::K2T + r32 * TS + hi * 16;
    const float decay = ML ? sc[96] : 1.f;
#pragma unroll
    for (int dt = 0; dt < DT; ++dt) {
        if (ML) { S[dt] = S[dt] * decay; }
        else {
#pragma unroll
            for (int g = 0; g < 4; ++g) { const f32x4 gv = *(const LAS f32x4*)(sc + 32 * dt + 8 * g + 4 * hi);
#pragma unroll
                for (int i = 0; i < 4; ++i) S[dt][4 * g + i] *= gv[i]; } }
        const bf16x8 a0 = *(const LAS bf16x8*)(k2 + dt * 32 * TS), a1 = *(const LAS bf16x8*)(k2 + dt * 32 * TS + 32);
        S[dt] = __builtin_amdgcn_mfma_f32_32x32x16_bf16(a0, v0, S[dt], 0, 0, 0);
        S[dt] = __builtin_amdgcn_mfma_f32_32x32x16_bf16(a1, v1, S[dt], 0, 0, 0);
        if (ML) {
            const u32x4 ua = __builtin_bit_cast(u32x4, a0), ub = __builtin_bit_cast(u32x4, a1);
            float ksum = (lo16(ua.x) + hi16(ua.x)) + (lo16(ua.y) + hi16(ua.y)) + (lo16(ua.z) + hi16(ua.z)) + (lo16(ua.w) + hi16(ua.w))
                       + (lo16(ub.x) + hi16(ub.x)) + (lo16(ub.y) + hi16(ub.y)) + (lo16(ub.z) + hi16(ub.z)) + (lo16(ub.w) + hi16(ub.w));
            ksum = xhalf_sum(ksum);
            if (hi == 0) wpriv[32 * dt + r32] = decay * wpriv[32 * dt + r32] + ksum;
        }
    }
    unsigned short* op = O + colbase + 32 * w + r32;
#pragma unroll
    for (int r = 0; r < 16; ++r) { const float v = ML ? o[r] * rden[r] : o[r]; const unsigned u = __float_as_uint(v);
        op[(long)(row0 + rstep * crow(r, hi)) * DM] = (unsigned short)((u + 0x7fffu + ((u >> 16) & 1u)) >> 16); }
}

struct HgPre { unsigned z[8], q[8], v[8]; };
__device__ __forceinline__ void hg_load(HgPre& P, const unsigned short* Z, const unsigned short* QA, const unsigned short* VA, int row0, int rstep, int colg, int qd) {
#pragma unroll
    for (int ii = 0; ii < 8; ++ii) { const size_t off = (size_t)(row0 + rstep * (8 * qd + ii)) * 512 + colg;
        P.z[ii] = *(const unsigned*)(Z + off); P.q[ii] = *(const unsigned*)(QA + off); P.v[ii] = *(const unsigned*)(VA + off); }
}
__device__ __forceinline__ void hg_produce(LAS unsigned char* buf, const HgPre& P, float lb0, float lb1, int pw, int cp, int qd) {
    using L = Lay<128>;
    const int d0 = 32 * pw + 2 * cp;
    float q[2][8], k[2][8], Pc[2][8], RP[2][8];
#pragma unroll
    for (int x = 0; x < 2; ++x) { const float lb = x ? lb1 : lb0; float p = 1.f, rp = 1.f;
#pragma unroll
        for (int ii = 0; ii < 8; ++ii) { const float z = x ? hi16(P.z[ii]) : lo16(P.z[ii]); q[x][ii] = x ? hi16(P.q[ii]) : lo16(P.q[ii]);
            const float sg = __builtin_amdgcn_rcpf(1.f + __expf(-z)); const float f = lb + (1.f - lb) * sg; k[x][ii] = (1.f - lb) * (1.f - sg);
            p *= f; rp *= __builtin_amdgcn_rcpf(f); Pc[x][ii] = p; RP[x][ii] = rp; } }
    const int lane = cp + 16 * qd;
    unsigned k2lo[2][2], k2hi[2][2];
#pragma unroll
    for (int x = 0; x < 2; ++x) {
        const float T = Pc[x][7];
        const float T0 = __shfl(T, cp), T1 = __shfl(T, cp + 16), T2 = __shfl(T, cp + 32), T3 = __shfl(T, cp + 48);
        const float emid = T0 * T1, elast = T2 * T3;
        const float scale = qd == 0 ? __builtin_amdgcn_rcpf(emid) : (qd == 1 ? __builtin_amdgcn_rcpf(T1) : (qd == 2 ? 1.f : T2));
        const float rscale = qd == 0 ? emid : (qd == 1 ? T1 : (qd == 2 ? 1.f : __builtin_amdgcn_rcpf(T2)));
#pragma unroll
        for (int ii = 0; ii < 8; ++ii) { const float qt = q[x][ii] * (Pc[x][ii] * scale), kt = k[x][ii] * (RP[x][ii] * rscale);
            q[x][ii] = qt; k[x][ii] = kt; Pc[x][ii] = qt * emid; RP[x][ii] = kt * elast; }
        k2lo[x][0] = cvtpk(RP[x][0], RP[x][1]); k2lo[x][1] = cvtpk(RP[x][2], RP[x][3]); k2hi[x][0] = cvtpk(RP[x][4], RP[x][5]); k2hi[x][1] = cvtpk(RP[x][6], RP[x][7]);
        if (qd == 0) ((LAS float*)(buf + L::SC))[d0 + x] = emid * elast;
    }
    (void)lane;
    const int pd = ((d0 & ~15) | kpos(d0 & 15)) * 2;
#pragma unroll
    for (int ii = 0; ii < 8; ++ii) { const int i = 8 * qd + ii;
        *(LAS unsigned*)(buf + L::Q1 + i * L::RS + pd) = cvtpk(q[0][ii], q[1][ii]);
        *(LAS unsigned*)(buf + L::K1 + i * L::RS + pd) = cvtpk(k[0][ii], k[1][ii]);
        *(LAS unsigned*)(buf + L::Q2 + i * L::RS + pd) = cvtpk(Pc[0][ii], Pc[1][ii]); }
    const int ps = (16 * (qd >> 1) + 4 * (qd & 1)) * 2;
#pragma unroll
    for (int x = 0; x < 2; ++x) {
        *(LAS u32x2*)(buf + L::K2T + (d0 + x) * TS + ps) = (u32x2){k2lo[x][0], k2lo[x][1]};
        *(LAS u32x2*)(buf + L::K2T + (d0 + x) * TS + ps + 16) = (u32x2){k2hi[x][0], k2hi[x][1]};
        unsigned a, b2, c2, d2;
        if (x == 0) { a = (P.v[0] & 0xffffu) | (P.v[1] << 16); b2 = (P.v[2] & 0xffffu) | (P.v[3] << 16); c2 = (P.v[4] & 0xffffu) | (P.v[5] << 16); d2 = (P.v[6] & 0xffffu) | (P.v[7] << 16); }
        else { a = (P.v[0] >> 16) | (P.v[1] & 0xffff0000u); b2 = (P.v[2] >> 16) | (P.v[3] & 0xffff0000u); c2 = (P.v[4] >> 16) | (P.v[5] & 0xffff0000u); d2 = (P.v[6] >> 16) | (P.v[7] & 0xffff0000u); }
        *(LAS u32x2*)(buf + L::VT + (d0 + x) * TS + ps) = (u32x2){a, b2};
        *(LAS u32x2*)(buf + L::VT + (d0 + x) * TS + ps + 16) = (u32x2){c2, d2};
    }
}

struct MlPre { unsigned x[10], v[8]; float ig, fg; };
__device__ __forceinline__ void ml_load(MlPre& P, const unsigned short* BQK, const unsigned short* VB, const float* BG, int segrow0, int L, int tq0, int colq, int colv,
                                        int row0, int rstep, int qd, int i32, int gi_i, int gi_f, float gb_i, float gb_f) {
#pragma unroll
    for (int jj = 0; jj < 10; ++jj) { const int t = tq0 - 1 + jj; P.x[jj] = (t >= 0 && t < L) ? *(const unsigned*)(BQK + (size_t)(segrow0 + t) * 512 + colq) : 0u; }
#pragma unroll
    for (int ii = 0; ii < 8; ++ii) P.v[ii] = *(const unsigned*)(VB + (size_t)(row0 + rstep * (8 * qd + ii)) * 512 + colv);
    const size_t gr = (size_t)(row0 + rstep * i32) * 16;
    P.ig = BG[gr + gi_i] + gb_i; P.fg = BG[gr + gi_f] + gb_f;
}
__device__ __forceinline__ void ml_produce(LAS unsigned char* buf, const MlPre& P, LAS float* ppriv, float& m, int dir, int pw, int cp, int qd, int lane,
                                           float w00, float w01, float w02, float w10, float w11, float w12) {
    using L = Lay<64>;
    const int i32 = lane & 31;
    const float logf = fminf(P.fg, 0.f) - log1pf(__expf(-fabsf(P.fg)));
    float bh = logf;
#pragma unroll
    for (int o = 1; o < 32; o <<= 1) { const float t = __shfl_up(bh, o, 32); if (i32 >= o) bh += t; }
    const float a = P.ig - bh;
    float pm = a;
#pragma unroll
    for (int o = 1; o < 32; o <<= 1) { const float t = __shfl_up(pm, o, 32); if (i32 >= o) pm = fmaxf(pm, t); }
    const float c = fmaxf(pm, m);
    const float c31 = __shfl(c, 31, 32), bh31 = __shfl(bh, 31, 32);
    const float winter = __expf(m - c), wk = __expf(a - c31), decay = __expf(m - c31), flo = __expf(-(bh + c));
    if (lane < 32) { ppriv[i32] = winter; ppriv[32 + i32] = wk; }
    if (pw == 0 && lane < 32) { LAS float* sc = (LAS float*)(buf + L::SC); sc[i32] = a; sc[32 + i32] = c; sc[64 + i32] = flo; if (i32 == 0) sc[96] = decay; }
    m = bh31 + c31;
    const bool isk = pw >= 2;
    float y[2][8];
#pragma unroll
    for (int mm = 0; mm < 8; ++mm) {
        const float c0v = w00 * lo16(P.x[mm]) + w01 * lo16(P.x[mm + 1]) + w02 * lo16(P.x[mm + 2]);
        const float c1v = w10 * hi16(P.x[mm]) + w11 * hi16(P.x[mm + 1]) + w12 * hi16(P.x[mm + 2]);
        const float s0 = c0v * __builtin_amdgcn_rcpf(1.f + __expf(-c0v)), s1 = c1v * __builtin_amdgcn_rcpf(1.f + __expf(-c1v));
        const int ii = dir ? 7 - mm : mm;
        y[0][ii] = isk ? s0 : s0 * 0.125f; y[1][ii] = isk ? s1 : s1 * 0.125f; }
    const LAS float* wp = ppriv + (isk ? 32 : 0) + 8 * qd;
    const f32x4 wa = *(const LAS f32x4*)wp, wb = *(const LAS f32x4*)(wp + 4);
    float ws[8] = {wa[0], wa[1], wa[2], wa[3], wb[0], wb[1], wb[2], wb[3]};
    const int cc = (32 * pw + 2 * cp) & 63;
    const int ps = (16 * (qd >> 1) + 4 * (qd & 1)) * 2;
    if (!isk) {
        const int pd = ((cc & ~15) | kpos(cc & 15)) * 2;
#pragma unroll
        for (int ii = 0; ii < 8; ++ii) { const int i = 8 * qd + ii;
            *(LAS unsigned*)(buf + L::Q1 + i * L::RS + pd) = cvtpk(y[0][ii], y[1][ii]);
            *(LAS unsigned*)(buf + L::Q2 + i * L::RS + pd) = cvtpk(y[0][ii] * ws[ii], y[1][ii] * ws[ii]); }
    } else {
        const int pd = ((cc & ~15) | kpos(cc & 15)) * 2;
#pragma unroll
        for (int ii = 0; ii < 8; ++ii) { const int i = 8 * qd + ii; *(LAS unsigned*)(buf + L::K1 + i * L::RS + pd) = cvtpk(y[0][ii], y[1][ii]); }
#pragma unroll
        for (int x = 0; x < 2; ++x) {
            *(LAS u32x2*)(buf + L::K2T + (cc + x) * TS + ps) = (u32x2){cvtpk(y[x][0] * ws[0], y[x][1] * ws[1]), cvtpk(y[x][2] * ws[2], y[x][3] * ws[3])};
            *(LAS u32x2*)(buf + L::K2T + (cc + x) * TS + ps + 16) = (u32x2){cvtpk(y[x][4] * ws[4], y[x][5] * ws[5]), cvtpk(y[x][6] * ws[6], y[x][7] * ws[7])}; }
    }
    const int e0 = 32 * pw + 2 * cp;
#pragma unroll
    for (int x = 0; x < 2; ++x) {
        unsigned a2, b2, c2, d2;
        if (x == 0) { a2 = (P.v[0] & 0xffffu) | (P.v[1] << 16); b2 = (P.v[2] & 0xffffu) | (P.v[3] << 16); c2 = (P.v[4] & 0xffffu) | (P.v[5] << 16); d2 = (P.v[6] & 0xffffu) | (P.v[7] << 16); }
        else { a2 = (P.v[0] >> 16) | (P.v[1] & 0xffff0000u); b2 = (P.v[2] >> 16) | (P.v[3] & 0xffff0000u); c2 = (P.v[4] >> 16) | (P.v[5] & 0xffff0000u); d2 = (P.v[6] >> 16) | (P.v[7] & 0xffff0000u); }
        *(LAS u32x2*)(buf + L::VT + (e0 + x) * TS + ps) = (u32x2){a2, b2};
        *(LAS u32x2*)(buf + L::VT + (e0 + x) * TS + ps + 16) = (u32x2){c2, d2};
    }
}

#define SCAN_BAR() do { asm volatile("s_waitcnt lgkmcnt(0)" ::: "memory"); __builtin_amdgcn_s_barrier(); asm volatile("" ::: "memory"); } while (0)

__device__ __forceinline__ void run_hgrn(LAS unsigned char* lds, int ch, const unsigned short* PROJ, const float* hgrn_lb, unsigned short* OF, unsigned short* OB) {
    using L = Lay<128>;
    const int tid = threadIdx.x, wave = __builtin_amdgcn_readfirstlane(tid >> 6), lane = tid & 63;
    const int b = ch >> 3, h = (ch >> 1) & 3, dir = ch & 1, rstep = dir ? -1 : 1;
    const unsigned short* QA = PROJ; const unsigned short* VA = PROJ + SEG; const unsigned short* Z = PROJ + (3 + dir) * SEG;
    unsigned short* O = dir ? OB : OF;
    if (wave < 4) {
        f32x16 S[4] = {};
        const int r32 = lane & 31, hi = lane >> 5;
        SCAN_BAR();
        for (int c = 0; c < NCH; ++c) {
            consume<128, false>(lds + (c & 1) * L::BYTES, S, nullptr, wave, r32, hi, O, chunk_row0(b, dir, c), rstep, h * 128);
            SCAN_BAR();
        }
    } else {
        const int pw = wave - 4, cp = lane & 15, qd = lane >> 4, d0 = 32 * pw + 2 * cp, colg = h * 128 + d0;
        float lbv[2];
#pragma unroll
        for (int x = 0; x < 2; ++x) { const float* p = hgrn_lb + (size_t)dir * 3 * 512 + h * 128 + d0 + x; const float a0 = p[0], a1 = p[512], a2 = p[1024];
            const float mx = fmaxf(a0, fmaxf(a1, a2)); const float e0 = __expf(a0 - mx), e1 = __expf(a1 - mx), e2 = __expf(a2 - mx); lbv[x] = e0 / (e0 + e1 + e2); }
        HgPre P;
        hg_load(P, Z, QA, VA, chunk_row0(b, dir, 0), rstep, colg, qd);
        hg_produce(lds, P, lbv[0], lbv[1], pw, cp, qd);
        hg_load(P, Z, QA, VA, chunk_row0(b, dir, 1), rstep, colg, qd);
        SCAN_BAR();
        for (int c = 0; c < NCH; ++c) {
            if (c + 1 < NCH) {
                hg_produce(lds + ((c + 1) & 1) * L::BYTES, P, lbv[0], lbv[1], pw, cp, qd);
                if (c + 2 < NCH) hg_load(P, Z, QA, VA, chunk_row0(b, dir, c + 2), rstep, colg, qd);
            }
            SCAN_BAR();
        }
    }
}
__device__ __forceinline__ void run_mlstm(LAS unsigned char* lds, int ch, const unsigned short* PROJ, const float* BG, const float* conv, const float* gate_b, unsigned short* OF, unsigned short* OB) {
    using L = Lay<64>;
    const int tid = threadIdx.x, wave = __builtin_amdgcn_readfirstlane(tid >> 6), lane = tid & 63;
    const int b = ch >> 3, h = (ch >> 1) & 3, dir = ch & 1, rstep = dir ? -1 : 1;
    const unsigned short* BQK = PROJ + 5 * SEG; const unsigned short* VB = PROJ + 6 * SEG;
    unsigned short* O = dir ? OB : OF;
    LAS float* priv = (LAS float*)(lds + 2 * L::BYTES) + wave * 128;
    if (wave < 4) {
        f32x16 S[2] = {};
        const int r32 = lane & 31, hi = lane >> 5;
        priv[lane] = 0.f;
        SCAN_BAR();
        for (int c = 0; c < NCH; ++c) {
            consume<64, true>(lds + (c & 1) * L::BYTES, S, priv, wave, r32, hi, O, chunk_row0(b, dir, c), rstep, 512 + h * 128);
            SCAN_BAR();
        }
    } else {
        const int pw = wave - 4, cp = lane & 15, qd = lane >> 4, i32 = lane & 31;
        const int cc = 32 * pw + 2 * cp;
        const int colq = cc < 64 ? h * 64 + cc : 256 + h * 64 + (cc - 64);
        const int colv = h * 128 + cc;
        const float w00 = conv[colq], w01 = conv[512 + colq], w02 = conv[1024 + colq], w10 = conv[colq + 1], w11 = conv[512 + colq + 1], w12 = conv[1024 + colq + 1];
        const int gi_i = 4 * (2 * dir) + h, gi_f = 4 * (2 * dir + 1) + h; const float gb_i = gate_b[gi_i], gb_f = gate_b[gi_f];
        float m = 0.f;
        MlPre P;
#define ML_LOADC(c_) do { const int c__ = (c_); const bool lat = c__ >= CTX / 32; const int Lg = lat ? SEQ : CTX; const int segrow0 = b * TT + (lat ? CTX : 0); \
        const int i0 = 32 * (lat ? c__ - CTX / 32 : c__) + 8 * qd; const int tq0 = dir ? Lg - 1 - (i0 + 7) : i0; \
        ml_load(P, BQK, VB, BG, segrow0, Lg, tq0, colq, colv, chunk_row0(b, dir, c__), rstep, qd, i32, gi_i, gi_f, gb_i, gb_f); } while (0)
        ML_LOADC(0);
        ml_produce(lds, P, priv, m, dir, pw, cp, qd, lane, w00, w01, w02, w10, w11, w12);
        ML_LOADC(1);
        SCAN_BAR();
        for (int c = 0; c < NCH; ++c) {
            if (c + 1 < NCH) {
                ml_produce(lds + ((c + 1) & 1) * L::BYTES, P, priv, m, dir, pw, cp, qd, lane, w00, w01, w02, w10, w11, w12);
                if (c + 2 < NCH) ML_LOADC(c + 2);
            }
            SCAN_BAR();
        }
#undef ML_LOADC
    }
}
#undef SCAN_BAR
}

enum { PH_PRO = 0, PH_MOD0, PH_INPROJ, PH_SCAN, PH_OG, PH_OUT0, PH_ROW0A, PH_FFI0, PH_FFO0, PH_ROW0B, PH_QKV, PH_QKN, PH_ATTN, PH_OUT1, PH_ROW1A, PH_FFI1, PH_FFO1, PH_ROW1B, NPH };
struct Args { const float* in[18]; float* out; unsigned char* ws; int ph_lo, ph_hi; };

template <class FN> __device__ __forceinline__ void run_gemm(Frame& F, const bf16* A, const bf16* Bt, int N, int K, int skipctx, const FN& fn) {
    pg8::Gemm g{A, Bt, M, N, K}; pg8::TileOrder S; S.init(skipctx ? 64 : 68, N, F.G, (int)blockIdx.x, skipctx);
    pg8::Epi8<FN> E{fn};
    pg8::gemm_phase<pg8::Epi8<FN>, pg8::TileOrder, true, true>(F.lds, g, S, E);
}

__global__ void __launch_bounds__(512, 2) mk_fwd(Args args) {
    extern __shared__ __attribute__((aligned(16))) unsigned char lds[];
    cg::grid_group grid = cg::this_grid();
    Frame F;
    F.lds = (LAS unsigned char*)lds;
    F.tid = threadIdx.x; F.lane = F.tid & 63; F.wave = __builtin_amdgcn_readfirstlane(F.tid >> 6); F.G = gridDim.x;
#pragma unroll
    for (int i = 0; i < 18; ++i) F.in[i] = args.in[i];
    F.out = args.out; F.ws = args.ws;
    unsigned char* ws = args.ws;
    F.MOD = (float*)(ws + WS_MOD); F.XCTX = (float*)(ws + WS_XCTX); F.H = (bf16*)(ws + WS_H); F.PROJ = (bf16*)(ws + WS_PROJ); F.BG = (float*)(ws + WS_BG);
    F.OG = (bf16*)(ws + WS_OG); F.Y = (bf16*)(ws + WS_Y); F.ACT = (bf16*)(ws + WS_ACT); F.Q = (bf16*)(ws + WS_Q); F.K = (bf16*)(ws + WS_K); F.V = (bf16*)(ws + WS_V);
    F.WAB = (bf16*)(ws + WS_WAB); F.WABO = (bf16*)(ws + WS_WABO); F.WFI0 = (bf16*)(ws + WS_WFI0); F.WFI1 = (bf16*)(ws + WS_WFI1); F.WFO0 = (bf16*)(ws + WS_WFO0); F.WFO1 = (bf16*)(ws + WS_WFO1);
    F.WQKV = (bf16*)(ws + WS_WQKV); F.WAO = (bf16*)(ws + WS_WAO);
    bf16* OF = (bf16*)F.out;
    bf16* OB = F.H;
    const float* MOD0 = F.MOD; const float* MOD1 = F.MOD + 5 * 6144;
    const float* NG = F.in[I_NORMG];
    const int lo = args.ph_lo, hi = args.ph_hi;
#define IN(k) (lo <= (k) && (k) < hi)
#define SEAM(k) do { if (IN(k) && IN((k) + 1)) grid.sync(); } while (0)

    if (IN(PH_PRO)) p0_prologue(F);
    SEAM(PH_PRO);
    if (IN(PH_MOD0)) rowpass<false, false, true, false>(F, F.in[I_X], F.in[I_CTX], nullptr, nullptr, nullptr, 0, nullptr, MOD0, 0, 1024, NG + 0);
    SEAM(PH_MOD0);
    if (IN(PH_INPROJ)) run_gemm(F, F.H, F.WAB, NABP, 1024, 0, pg8::FProj{F.PROJ, F.BG});
    SEAM(PH_INPROJ);
#if SCAN_NAIVE
    if (IN(PH_SCAN)) { if (blockIdx.x < 32) scan_hgrn_naive(F, blockIdx.x, OF, OB); else if (blockIdx.x < 64) scan_mlstm_naive(F, blockIdx.x - 32, OF, OB); }
#else
    if (IN(PH_SCAN)) { if (blockIdx.x < 32) scan::run_hgrn(F.lds, blockIdx.x, F.PROJ, F.in[I_LB], OF, OB);
                       else if (blockIdx.x < 64) scan::run_mlstm(F.lds, blockIdx.x - 32, F.PROJ, F.BG, F.in[I_CONV], F.in[I_GATEB], OF, OB); }
#endif
    SEAM(PH_SCAN);
    if (IN(PH_OG)) og_pass(F, OF, OB);
    SEAM(PH_OG);
    if (IN(PH_OUT0)) run_gemm(F, F.OG, F.WABO, 1024, 1024, 0, pg8::FStore{F.Y, 1024});
    SEAM(PH_OUT0);
    if (IN(PH_ROW0A)) rowpass<true, true, true, false>(F, F.in[I_X], F.in[I_CTX], F.out, F.XCTX, MOD0, 2048, NG + 1024, MOD0, 3072, 4096, NG + 2048);
    SEAM(PH_ROW0A);
    if (IN(PH_FFI0)) run_gemm(F, F.H, F.WFI0, 2 * DFF, 1024, 0, pg8::FSwiglu{F.ACT});
    SEAM(PH_FFI0);
    if (IN(PH_FFO0)) run_gemm(F, F.ACT, F.WFO0, 1024, DFF, 0, pg8::FStore{F.Y, 1024});
    SEAM(PH_FFO0);
    if (IN(PH_ROW0B)) rowpass<true, true, true, false>(F, F.out, F.XCTX, F.out, F.XCTX, MOD0, 5120, NG + 3072, MOD1, 0, 1024, NG + 4096);
    SEAM(PH_ROW0B);
    if (IN(PH_QKV)) run_gemm(F, F.H, F.WQKV, NQKV, 1024, 0, pg8::FQkv{F.Q, F.K, F.V});
    SEAM(PH_QKV);
    if (IN(PH_QKN)) qknorm_pass(F);
    SEAM(PH_QKN);
    if (IN(PH_ATTN)) {
        const int bx = blockIdx.x, vcu = (F.G % 8 == 0) ? (bx % 8) * (F.G / 8) + bx / 8 : bx;
        for (int u = vcu; u < 512; u += F.G) {
            const int uu = (u % 256) * 2 + u / 256;
            const int g = uu & 3, qb = (uu >> 2) & 15, kvh = (uu >> 6) & 1, b = uu >> 7, head = kvh * 4 + g;
            const size_t qrow = (size_t)b * TT + CTX + qb * 256;
            attn::attn_dense_body(F.Q + qrow * 1024 + head * 128, F.K + (size_t)b * TT * 256 + kvh * 128, F.V + (size_t)b * TT * 256 + kvh * 128,
                                  F.OG + qrow * 1024 + head * 128, TT, (char*)lds);
            __syncthreads();
        }
    }
    SEAM(PH_ATTN);
    if (IN(PH_OUT1)) run_gemm(F, F.OG, F.WAO, 1024, 1024, 1, pg8::FStore{F.Y, 1024});
    SEAM(PH_OUT1);
    if (IN(PH_ROW1A)) rowpass<true, true, true, true>(F, F.out, F.XCTX, F.out, F.XCTX, MOD1, 2048, NG + 5120, MOD1, 3072, 4096, NG + 6144);
    SEAM(PH_ROW1A);
    if (IN(PH_FFI1)) run_gemm(F, F.H, F.WFI1, 2 * DFF, 1024, 1, pg8::FSwiglu{F.ACT});
    SEAM(PH_FFI1);
    if (IN(PH_FFO1)) run_gemm(F, F.ACT, F.WFO1, 1024, DFF, 1, pg8::FStore{F.Y, 1024});
    SEAM(PH_FFO1);
    if (IN(PH_ROW1B)) rowpass<true, true, false, true>(F, F.out, F.XCTX, F.out, F.XCTX, MOD1, 5120, NG + 7168, nullptr, 0, 0, nullptr);
#undef IN
#undef SEAM
}

extern "C" void kernel_launch(void* const* d_in, const int* in_sizes, int n_in, void* d_out, int out_size, void* d_ws, size_t ws_size, hipStream_t stream) {
    static int grid = 0;
    if (grid == 0) {
        if (n_in != 18 || in_sizes[0] != NB * SEQ * DM || out_size != NB * SEQ * DM || ws_size < WS_END) {
            fprintf(stderr, "kernel_launch: unexpected shapes (n_in %d, in0 %d, out %d, ws %zu)\n", n_in, n_in > 0 ? in_sizes[0] : -1, out_size, ws_size); grid = -1; return; }
        int dev = 0, cus = 0, per_cu = 0;
        if (hipGetDevice(&dev) != hipSuccess || hipDeviceGetAttribute(&cus, hipDeviceAttributeMultiprocessorCount, dev) != hipSuccess) { grid = -1; return; }
        if (hipFuncSetAttribute((const void*)mk_fwd, hipFuncAttributeMaxDynamicSharedMemorySize, LDS_BYTES) != hipSuccess) { fprintf(stderr, "kernel_launch: hipFuncSetAttribute failed\n"); grid = -1; return; }
        if (hipOccupancyMaxActiveBlocksPerMultiprocessor(&per_cu, (const void*)mk_fwd, 512, LDS_BYTES) != hipSuccess || per_cu < 1) { fprintf(stderr, "kernel_launch: occupancy query says %d blocks per CU\n", per_cu); per_cu = 1; }
        (void)hipGetLastError();
        grid = cus;
        fprintf(stderr, "kernel_launch: grid %d (occupancy query %d per CU)\n", grid, per_cu);
    }
    if (grid < 0) return;
    Args a{};
    for (int i = 0; i < 18; ++i) a.in[i] = (const float*)d_in[i];
    a.out = (float*)d_out; a.ws = (unsigned char*)d_ws;
#if MK_ONE
    a.ph_lo = 0; a.ph_hi = NPH;
    void* kargs[] = {&a};
    hipError_t e = hipLaunchCooperativeKernel((const void*)mk_fwd, dim3(grid), dim3(512), kargs, LDS_BYTES, stream);
    if (e != hipSuccess) fprintf(stderr, "kernel_launch: cooperative launch failed: %s (grid %d)\n", hipGetErrorString(e), grid);
#else
    for (int p = 0; p < NPH; ++p) { a.ph_lo = p; a.ph_hi = p + 1; hipLaunchKernelGGL(mk_fwd, dim3(grid), dim3(512), LDS_BYTES, stream, a); }
    const hipError_t le = hipPeekAtLastError();
    if (le != hipSuccess) fprintf(stderr, "kernel_launch: launch failed: %s\n", hipGetErrorName(le));
#endif
}
```

```cpp
#include <hip/hip_runtime.h>
#include <hip/hip_cooperative_groups.h>
#include <cstdio>
#include <cstdint>
namespace cg = cooperative_groups;

constexpr int DM = 1024, NB = 4, SEQ = 4096, CTX = 256, TT = SEQ + CTX, M = NB * TT;
constexpr int DFF = 2816, NAB = 4112, NABP = 4352, NQKV = 1536;
constexpr float EPS = 1e-6f;
#ifndef MK_ONE
#define MK_ONE 1
#endif
#ifndef PROBE_REP
#define PROBE_REP 0
#endif
#ifndef SCAN_NAIVE
#define SCAN_NAIVE 0
#endif

namespace pg8 {
#define PG8_LAS __attribute__((address_space(3)))
typedef unsigned short bf16_t;
typedef short bf16x8 __attribute__((ext_vector_type(8)));
typedef float f32x4 __attribute__((ext_vector_type(4)));
typedef unsigned u32x4 __attribute__((ext_vector_type(4)));
constexpr int BM = 256, BK = 64, HALF = 128, HTB = HALF * BK * 2  , STAGE_BYTES = 8 * HTB, NXCD = 8, WGM = 8;

__host__ __device__ __forceinline__ int lds_byte(int r, int c) { const int st = (r >> 4) * 2 + (c >> 5), rr = r & 15, cc = c & 31, ob = rr * 64 + cc * 2; return st * 1024 + (ob ^ (((ob >> 9) & 1) << 5)); }
__host__ __device__ __forceinline__ void stage_rc(int b, int& R, int& C) { const int st = b / 1024, sb = b % 1024, swz = sb ^ (((sb >> 9) & 1) << 5); R = (st >> 1) * 16 + swz / 64; C = (st & 1) * 32 + (swz % 64) / 2; }
__host__ __device__ __forceinline__ int perm32(int rho) { const int n = rho >> 4, i = rho & 15; return 8 * (i >> 2) + 4 * n + (i & 3); }

struct Unit { int pm, pn; };
struct Gemm { const bf16_t* A; const bf16_t* Bt; int M, N, K; };

struct TileOrder {
    int nM, nN, nwg, G, c, skip;
    __device__ void init(int nM_, int N, int G_, int c_, int skip_) { nM = nM_; nN = N / BM; nwg = nM * nN; G = G_; c = c_; skip = skip_; }
    __device__ bool next(int i, Unit& u) const {
        const long L = (long)i * G + c; if (L >= nwg) return false;
        int wgid = (int)L; { const int q = nwg / NXCD, r = nwg % NXCD, xcd = wgid % NXCD, off = wgid / NXCD; wgid = (xcd < r ? xcd * (q + 1) : r * (q + 1) + (xcd - r) * q) + off; }
        const int nig = WGM * nN, gid = wgid / nig, fm = gid * WGM, gsz = (nM - fm) < WGM ? (nM - fm) : WGM;
        int pm = fm + ((wgid % nig) % gsz); u.pn = (wgid % nig) / gsz;
        if (skip) pm = pm + (pm >> 4) + 1;
        u.pm = pm; return true;
    }
    __device__ __forceinline__ void a_ready(const Unit&) const {}
    __device__ __forceinline__ void done(const Unit&) const {}
};

__device__ __forceinline__ unsigned cvt_pk_bf16(float lo, float hi) { unsigned r; asm volatile("v_cvt_pk_bf16_f32 %0, %1, %2" : "=v"(r) : "v"(lo), "v"(hi)); return r; }
__device__ __forceinline__ u32x4 pack8(const f32x4 a, const f32x4 b) { u32x4 w; w.x = cvt_pk_bf16(a[0], a[1]); w.y = cvt_pk_bf16(a[2], a[3]); w.z = cvt_pk_bf16(b[0], b[1]); w.w = cvt_pk_bf16(b[2], b[3]); return w; }
__device__ __forceinline__ float fsigmoid(float x) { return __builtin_amdgcn_rcpf(1.0f + __expf(-x)); }
__device__ __forceinline__ f32x4 silu4(f32x4 v) { f32x4 o; o[0] = v[0] * fsigmoid(v[0]); o[1] = v[1] * fsigmoid(v[1]); o[2] = v[2] * fsigmoid(v[2]); o[3] = v[3] * fsigmoid(v[3]); return o; }
__device__ __forceinline__ f32x4 sigm4(f32x4 v) { f32x4 o; o[0] = fsigmoid(v[0]); o[1] = fsigmoid(v[1]); o[2] = fsigmoid(v[2]); o[3] = fsigmoid(v[3]); return o; }

template <class F> struct Epi8 {
    static constexpr bool PERM = true, AFTER_DRAIN = false;
    F f;
    __device__ __forceinline__ void operator()(const f32x4 (&acc)[2][2][4][2], const Unit& u, int wr, int wc, int fr, int fq) const {
        const int col = u.pn * BM + wc * 32 + 8 * fq;
#pragma unroll
        for (int ai = 0; ai < 2; ++ai)
#pragma unroll
            for (int m = 0; m < 4; ++m) { const int row = u.pm * BM + ai * HALF + wr * 64 + m * 16 + fr;
                f.apply(row, col, acc[ai][0][m][0], acc[ai][0][m][1], acc[ai][1][m][0], acc[ai][1][m][1]); }
    }
};
struct FProj {
    bf16_t* proj; float* bg;
    __device__ __forceinline__ void one(int row, int c, f32x4 v0, f32x4 v1) const {
        if (c >= 4096) { if (c < 4112) { float* p = bg + (size_t)row * 16 + (c - 4096); *(f32x4*)p = v0; *(f32x4*)(p + 4) = v1; } return; }
        const int seg = c >> 9, cs = c & 511;
        if (seg == 2) { v0 = silu4(v0); v1 = silu4(v1); }
        if (seg == 7) { v0 = sigm4(v0); v1 = sigm4(v1); }
        *(u32x4*)(proj + (size_t)seg * ((size_t)M * 512) + (size_t)row * 512 + cs) = pack8(v0, v1);
    }
    __device__ __forceinline__ void apply(int row, int col, f32x4 a0, f32x4 a1, f32x4 b0, f32x4 b1) const { one(row, col, a0, a1); one(row, col + 128, b0, b1); }
};
struct FStore {
    bf16_t* O; int ld;
    __device__ __forceinline__ void apply(int row, int col, f32x4 a0, f32x4 a1, f32x4 b0, f32x4 b1) const {
        bf16_t* p = O + (size_t)row * ld + col; *(u32x4*)p = pack8(a0, a1); *(u32x4*)(p + 128) = pack8(b0, b1); }
};
struct FSwiglu {
    bf16_t* act;
    __device__ __forceinline__ void apply(int row, int col, f32x4 a0, f32x4 a1, f32x4 b0, f32x4 b1) const {
        const int hc = (col >> 8) * 128 + (col & 255);
        *(u32x4*)(act + (size_t)row * DFF + hc) = pack8(silu4(a0) * b0, silu4(a1) * b1); }
};
struct FQkv {
    bf16_t *q, *k, *v;
    __device__ __forceinline__ void one(int row, int c, f32x4 v0, f32x4 v1) const {
        bf16_t* p = c < 1024 ? q + (size_t)row * 1024 + c : (c < 1280 ? k + (size_t)row * 256 + (c - 1024) : v + (size_t)row * 256 + (c - 1280));
        *(u32x4*)p = pack8(v0, v1); }
    __device__ __forceinline__ void apply(int row, int col, f32x4 a0, f32x4 a1, f32x4 b0, f32x4 b1) const { one(row, col, a0, a1); one(row, col + 128, b0, b1); }
};

template <class Epi, class Sched, bool ALIGN_EPI = false, bool SP2 = false>
__device__ __forceinline__ void gemm_phase(PG8_LAS unsigned char* lds, const Gemm g, const Sched& S, const Epi& E) {
    const int tid = threadIdx.x, wid = __builtin_amdgcn_readfirstlane(tid >> 6), lane = tid & 63, wr = wid >> 2, wc = wid & 3, fr = lane & 15, fq = lane >> 4;
    const int K = g.K, nt = K / BK;
    unsigned voffA[2], voffB[2];
#pragma unroll
    for (int i = 0; i < 2; ++i) { int R, C; stage_rc(tid * 16 + i * 8192, R, C); const int Rb = Epi::PERM ? ((R & ~31) + perm32(R & 31)) : R;
        voffA[i] = (unsigned)(R * K + C) * 2u; voffB[i] = (unsigned)(Rb * K + C) * 2u; }
    const size_t kstep = (size_t)(BK * 2);
    const size_t hstep = (size_t)HALF * K * 2;
    const size_t tstep = 2 * hstep;
    const unsigned ldsw = (unsigned)wid * 1024u;
    const int aoff = lds_byte(wr * 64 + fr, fq * 8), boff = lds_byte(wc * 32 + fr, fq * 8);
#define PG8_SA(b, h) (((b) * 2 + (h)) * HTB)
#define PG8_SB(b, h) ((4 + (b) * 2 + (h)) * HTB)
#define PG8_STAGE(bufoff, gbase, voff) do { _Pragma("unroll") for (int _i = 0; _i < 2; ++_i) \
        __builtin_amdgcn_global_load_lds((const unsigned*)((const char*)(gbase) + (voff)[_i]), (PG8_LAS unsigned*)(lds + (bufoff) + ldsw + _i * 8192), 16, 0, 0); } while (0)
#define PG8_LDA(dst, b, h) do { _Pragma("unroll") for (int m = 0; m < 4; ++m) _Pragma("unroll") for (int k = 0; k < 2; ++k) dst[m][k] = *(const PG8_LAS bf16x8*)(lds + PG8_SA(b, h) + aoff + m * 2048 + k * 1024); } while (0)
#define PG8_LDB(dst, b, h) do { _Pragma("unroll") for (int n = 0; n < 2; ++n) _Pragma("unroll") for (int k = 0; k < 2; ++k) dst[n][k] = *(const PG8_LAS bf16x8*)(lds + PG8_SB(b, h) + boff + n * 2048 + k * 1024); } while (0)
#define PG8_MMA(ai, bj, At, Bt) do { __builtin_amdgcn_s_setprio(1); _Pragma("unroll") for (int m = 0; m < 4; ++m) _Pragma("unroll") for (int n = 0; n < 2; ++n) _Pragma("unroll") for (int k = 0; k < 2; ++k) \
        acc[ai][bj][m][n] = __builtin_amdgcn_mfma_f32_16x16x32_bf16(Bt[n][k], At[m][k], acc[ai][bj][m][n], 0, 0, 0); __builtin_amdgcn_s_setprio(0); } while (0)
#define PG8_WAIT_V(n) asm volatile("s_waitcnt vmcnt(" #n ")" ::: "memory")
#define PG8_WAIT_L(n) asm volatile("s_waitcnt lgkmcnt(" #n ")" ::: "memory")
#define PG8_BAR __builtin_amdgcn_s_barrier()
#define PG8_SCHED __builtin_amdgcn_sched_barrier(0)
    Unit cur, nxt; int ui = 0;
    if (!S.next(0, cur)) return;
    f32x4 acc[2][2][4][2];
#pragma unroll
    for (int a = 0; a < 2; ++a)
#pragma unroll
        for (int b = 0; b < 2; ++b)
#pragma unroll
            for (int m = 0; m < 4; ++m)
#pragma unroll
                for (int n = 0; n < 2; ++n) acc[a][b][m][n] = (f32x4){0.f, 0.f, 0.f, 0.f};
    bf16x8 At[4][2], B0[2][2], B1[2][2];
    const char* cA = (const char*)g.A + (size_t)cur.pm * tstep; const char* cB = (const char*)g.Bt + (size_t)cur.pn * tstep;
    S.a_ready(cur);
    if constexpr (SP2) {
        PG8_STAGE(PG8_SB(0, 0), cB, voffB); PG8_STAGE(PG8_SB(0, 1), cB + hstep, voffB); PG8_STAGE(PG8_SA(0, 0), cA, voffA); PG8_STAGE(PG8_SA(0, 1), cA + hstep, voffA);
        if (wr == 1) PG8_BAR;
        PG8_WAIT_V(2); PG8_BAR;
        PG8_STAGE(PG8_SB(1, 0), cB + kstep, voffB); PG8_STAGE(PG8_SA(1, 0), cA + kstep, voffA); PG8_STAGE(PG8_SB(1, 1), cB + hstep + kstep, voffB);
        PG8_WAIT_V(6); PG8_BAR;
    } else {
        PG8_STAGE(PG8_SB(0, 0), cB, voffB); PG8_STAGE(PG8_SA(0, 0), cA, voffA); PG8_STAGE(PG8_SB(0, 1), cB + hstep, voffB); PG8_STAGE(PG8_SA(0, 1), cA + hstep, voffA);
        if (wr == 1) PG8_BAR;
        PG8_WAIT_V(4); PG8_BAR;
        PG8_STAGE(PG8_SB(1, 0), cB + kstep, voffB); PG8_STAGE(PG8_SA(1, 0), cA + kstep, voffA); PG8_STAGE(PG8_SB(1, 1), cB + hstep + kstep, voffB);
        PG8_WAIT_V(6); PG8_BAR;
    }
    for (;;) {
        const bool has_next = S.next(ui + 1, nxt);
        const char* nA = has_next ? (const char*)g.A + (size_t)nxt.pm * tstep : cA; const char* nB = has_next ? (const char*)g.Bt + (size_t)nxt.pn * tstep : cB;
        for (int t = 0; t < nt; t += 2) {
            const bool last = (t == nt - 2);
            const char* a1 = cA + (size_t)(t + 1) * kstep;
            const char* a2 = last ? nA : cA + (size_t)(t + 2) * kstep; const char* b2 = last ? nB : cB + (size_t)(t + 2) * kstep;
            const char* a3 = a2 + kstep; const char* b3 = b2 + kstep;
            if (last && has_next) S.a_ready(nxt);
            if constexpr (SP2) {
            PG8_LDB(B0, 0, 0); PG8_LDB(B1, 0, 1); PG8_SCHED; PG8_LDA(At, 0, 0); PG8_STAGE(PG8_SA(1, 1), a1 + hstep, voffA);
            PG8_WAIT_V(8); PG8_WAIT_L(0); PG8_BAR; PG8_MMA(0, 0, At, B0); PG8_MMA(0, 1, At, B1); PG8_BAR; PG8_SCHED;
            PG8_LDA(At, 0, 1); PG8_STAGE(PG8_SB(0, 0), b2, voffB); PG8_STAGE(PG8_SB(0, 1), b2 + hstep, voffB); PG8_STAGE(PG8_SA(0, 0), a2, voffA);
            PG8_WAIT_V(8); PG8_WAIT_L(0); PG8_BAR; PG8_MMA(1, 0, At, B0); PG8_MMA(1, 1, At, B1); PG8_BAR; PG8_SCHED;
            PG8_LDB(B0, 1, 0); PG8_LDB(B1, 1, 1); PG8_SCHED; PG8_LDA(At, 1, 0); PG8_STAGE(PG8_SA(0, 1), a2 + hstep, voffA);
            PG8_WAIT_V(8); PG8_WAIT_L(0); PG8_BAR; PG8_MMA(0, 0, At, B0); PG8_MMA(0, 1, At, B1); PG8_BAR; PG8_SCHED;
            PG8_LDA(At, 1, 1); PG8_STAGE(PG8_SB(1, 0), b3, voffB); PG8_STAGE(PG8_SB(1, 1), b3 + hstep, voffB); PG8_STAGE(PG8_SA(1, 0), a3, voffA);
            PG8_WAIT_V(8); PG8_WAIT_L(0); PG8_BAR; PG8_MMA(1, 0, At, B0); PG8_MMA(1, 1, At, B1); PG8_BAR; PG8_SCHED;
            } else {
            PG8_LDB(B0, 0, 0); PG8_SCHED; PG8_LDA(At, 0, 0); PG8_STAGE(PG8_SA(1, 1), a1 + hstep, voffA);
            PG8_WAIT_L(8); PG8_BAR; PG8_WAIT_L(0); PG8_MMA(0, 0, At, B0); PG8_BAR; PG8_SCHED;
            PG8_LDB(B1, 0, 1); PG8_STAGE(PG8_SB(0, 0), b2, voffB);
            PG8_BAR; PG8_WAIT_L(0); PG8_MMA(0, 1, At, B1); PG8_BAR;
            PG8_LDA(At, 0, 1); PG8_STAGE(PG8_SA(0, 0), a2, voffA);
            PG8_BAR; PG8_WAIT_L(0); PG8_MMA(1, 0, At, B0); PG8_BAR; PG8_SCHED;
            PG8_STAGE(PG8_SB(0, 1), b2 + hstep, voffB);
            PG8_WAIT_V(6); PG8_BAR; PG8_MMA(1, 1, At, B1); PG8_BAR;
            PG8_LDB(B0, 1, 0); PG8_SCHED; PG8_LDA(At, 1, 0); PG8_STAGE(PG8_SA(0, 1), a2 + hstep, voffA);
            PG8_WAIT_L(8); PG8_BAR; PG8_WAIT_L(0); PG8_MMA(0, 0, At, B0); PG8_BAR; PG8_SCHED;
            PG8_LDB(B1, 1, 1); PG8_STAGE(PG8_SB(1, 0), b3, voffB);
            PG8_BAR; PG8_WAIT_L(0); PG8_MMA(0, 1, At, B1); PG8_BAR;
            PG8_LDA(At, 1, 1); PG8_STAGE(PG8_SA(1, 0), a3, voffA);
            PG8_BAR; PG8_WAIT_L(0); PG8_MMA(1, 0, At, B0); PG8_BAR; PG8_SCHED;
            PG8_STAGE(PG8_SB(1, 1), b3 + hstep, voffB);
            PG8_WAIT_V(6); PG8_BAR; PG8_MMA(1, 1, At, B1); PG8_BAR;
            }
        }
        if constexpr (ALIGN_EPI) { if (wr == 0) PG8_BAR; }
        if constexpr (!Epi::AFTER_DRAIN) { E(acc, cur, wr, wc, fr, fq); S.done(cur); }
        if (!has_next) break;
#pragma unroll
        for (int a = 0; a < 2; ++a)
#pragma unroll
            for (int b = 0; b < 2; ++b)
#pragma unroll
                for (int m = 0; m < 4; ++m)
#pragma unroll
                    for (int n = 0; n < 2; ++n) acc[a][b][m][n] = (f32x4){0.f, 0.f, 0.f, 0.f};
        cur = nxt; cA = nA; cB = nB; ++ui;
        if constexpr (ALIGN_EPI) { if (wr == 1) PG8_BAR; }
    }
    PG8_WAIT_V(0);
    if constexpr (!ALIGN_EPI) { if (wr == 0) PG8_BAR; }
    PG8_BAR;
    if constexpr (Epi::AFTER_DRAIN) { E.fused(acc, cur, wr, wc, fr, fq, lds, wid, lane); S.done(cur); }
#undef PG8_SA
#undef PG8_SB
#undef PG8_STAGE
#undef PG8_LDA
#undef PG8_LDB
#undef PG8_MMA
#undef PG8_WAIT_V
#undef PG8_WAIT_L
#undef PG8_BAR
#undef PG8_SCHED
}
}

namespace attn {
typedef unsigned short bf16;
using bf16x8 = __attribute__((ext_vector_type(8))) short;
using s16x4  = __attribute__((ext_vector_type(4))) short;
using f32x16 = __attribute__((ext_vector_type(16))) float;
using u32x4  = __attribute__((ext_vector_type(4))) unsigned;
constexpr int D = 128, NW = 8, QBLK = 32, KVBLK = 64;
constexpr float SCALE = 0.088388347648318440f;
constexpr float THR = 8.f;
constexpr int LDQ = 1024, LDK = 256, LDO = 1024;
constexpr size_t SHM_V = KVBLK * D * 2, SHM_K = KVBLK * D * 2, SHM_ATTN = 2 * SHM_V + 2 * SHM_K + NW * 64 * 4;
#define KSWZ(row, colB) ((row) * 256 + ((colB) ^ (((row) & 7) << 4)))
#define SBAR() __builtin_amdgcn_sched_barrier(0)
__device__ __forceinline__ int crow(int r, int hi) { return (r & 3) + 8 * (r >> 2) + 4 * hi; }
__device__ __forceinline__ unsigned cvtpk(float lo, float hi) { unsigned r; asm volatile("v_cvt_pk_bf16_f32 %0, %1, %2" : "=v"(r) : "v"(lo), "v"(hi)); return r; }
__device__ __forceinline__ bf16x8 ld8(const bf16* p) { return *reinterpret_cast<const bf16x8*>(p); }

__device__ __forceinline__ void partialSM(f32x16& p0, f32x16& p1, float& m_reg, float& mn, float& alpha) {
  constexpr float C = SCALE * 1.4426950408889634f;
  float pmax = p0[0]; for (int r = 1; r < 16; ++r) pmax = fmaxf(pmax, p0[r]); for (int r = 0; r < 16; ++r) pmax = fmaxf(pmax, p1[r]);
  { auto rr = __builtin_amdgcn_permlane32_swap(__float_as_uint(pmax), __float_as_uint(pmax), false, false);
    pmax = fmaxf(__uint_as_float(rr[0]), __uint_as_float(rr[1])); }
  if (__builtin_expect(__all(pmax - m_reg <= THR / SCALE), 1)) { mn = m_reg; alpha = 1.f; }
  else { mn = fmaxf(m_reg, pmax); alpha = __builtin_amdgcn_exp2f((m_reg - mn) * C); m_reg = mn; }
  float mnC = -mn * C;
  for (int r = 0; r < 16; ++r) p0[r] = fmaf(p0[r], C, mnC); for (int r = 0; r < 16; ++r) p1[r] = fmaf(p1[r], C, mnC);
  for (int r = 0; r < 16; ++r) p0[r] = __builtin_amdgcn_exp2f(p0[r]);
}
__device__ __forceinline__ void finishSM(f32x16& p0, f32x16& p1, float alpha, float& l_reg, bf16x8& pa0, bf16x8& pa1, bf16x8& pa2, bf16x8& pa3) {
  for (int r = 0; r < 16; ++r) p1[r] = __builtin_amdgcn_exp2f(p1[r]);
  float ps = 0; for (int r = 0; r < 16; ++r) ps += p0[r]; for (int r = 0; r < 16; ++r) ps += p1[r];
  { auto rr = __builtin_amdgcn_permlane32_swap(__float_as_uint(ps), __float_as_uint(ps), false, false);
    ps = __uint_as_float(rr[0]) + __uint_as_float(rr[1]); }
  l_reg = l_reg * alpha + ps;
#define PK4(P, BASE, OUT) do { unsigned a0 = cvtpk(P[BASE + 0], P[BASE + 1]), a1 = cvtpk(P[BASE + 2], P[BASE + 3]);   \
    unsigned b0 = cvtpk(P[BASE + 4], P[BASE + 5]), b1 = cvtpk(P[BASE + 6], P[BASE + 7]);                              \
    auto r0 = __builtin_amdgcn_permlane32_swap(a0, b0, false, false); auto r1 = __builtin_amdgcn_permlane32_swap(a1, b1, false, false); \
    u32x4 w = {r0[0], r1[0], r0[1], r1[1]}; OUT = *reinterpret_cast<bf16x8*>(&w); } while (0)
  PK4(p0, 0, pa0); PK4(p0, 8, pa1); PK4(p1, 0, pa2); PK4(p1, 8, pa3);
#undef PK4
}
__device__ __forceinline__ void qkt(f32x16& p0, f32x16& p1, const bf16* Ks, const bf16x8* qr, int r32, int hi) {
  p0 = f32x16{}; p1 = f32x16{};
  for (int d0 = 0; d0 < 8; ++d0) { int cb = (d0 * 16 + hi * 8) * 2;
    bf16x8 b0 = *reinterpret_cast<const bf16x8*>((const char*)Ks + KSWZ(r32, cb));
    bf16x8 b1 = *reinterpret_cast<const bf16x8*>((const char*)Ks + KSWZ(32 + r32, cb));
    p0 = __builtin_amdgcn_mfma_f32_32x32x16_bf16(b0, qr[d0], p0, 0, 0, 0);
    p1 = __builtin_amdgcn_mfma_f32_32x32x16_bf16(b1, qr[d0], p1, 0, 0, 0); }
}
__device__ __forceinline__ int v_st(int k, int c) { const int kk = (k & ~0xC) | ((k & 4) << 1) | ((k & 8) >> 1); return ((kk >> 3) * 4 + (c >> 5)) * 512 + ((kk & 7) * 32 + (c & 31)) * 2; }
__device__ __forceinline__ int v_rd_base(int lane) { return ((lane & 3) << 3) | (((lane >> 2) & 3) << 6) | (((lane >> 4) & 1) << 5) | (((lane >> 5) & 1) << 8); }
constexpr int v_rd_off(int d0, int ks, int half) { return d0 * 512 + ks * 4096 + half * 2048; }
template <int OFF> __device__ __forceinline__ s16x4 tr_read(int vb) {
  s16x4 r; asm volatile("ds_read_b64_tr_b16 %0, %1 offset:%2" : "=&v"(r) : "v"(vb), "i"(OFF) : "memory"); return r;
}
template <int D0> __device__ __forceinline__ void pv_one(f32x16& od, int vb, bf16x8 pa0, bf16x8 pa1, bf16x8 pa2, bf16x8 pa3) {
  const s16x4 l0 = tr_read<v_rd_off(D0, 0, 0)>(vb), h0 = tr_read<v_rd_off(D0, 0, 1)>(vb), l1 = tr_read<v_rd_off(D0, 1, 0)>(vb), h1 = tr_read<v_rd_off(D0, 1, 1)>(vb);
  const s16x4 l2 = tr_read<v_rd_off(D0, 2, 0)>(vb), h2 = tr_read<v_rd_off(D0, 2, 1)>(vb), l3 = tr_read<v_rd_off(D0, 3, 0)>(vb), h3 = tr_read<v_rd_off(D0, 3, 1)>(vb);
  asm volatile("s_waitcnt lgkmcnt(0)" ::: "memory"); SBAR();
#define PK(L, H) (bf16x8){L[0], L[1], L[2], L[3], H[0], H[1], H[2], H[3]}
  od = __builtin_amdgcn_mfma_f32_32x32x16_bf16(pa0, PK(l0, h0), od, 0, 0, 0);
  od = __builtin_amdgcn_mfma_f32_32x32x16_bf16(pa1, PK(l1, h1), od, 0, 0, 0);
  od = __builtin_amdgcn_mfma_f32_32x32x16_bf16(pa2, PK(l2, h2), od, 0, 0, 0);
  od = __builtin_amdgcn_mfma_f32_32x32x16_bf16(pa3, PK(l3, h3), od, 0, 0, 0);
#undef PK
}
__device__ __forceinline__ void pv_d0(f32x16* o, int vb, bf16x8 pa0, bf16x8 pa1, bf16x8 pa2, bf16x8 pa3) {
  pv_one<0>(o[0], vb, pa0, pa1, pa2, pa3); pv_one<1>(o[1], vb, pa0, pa1, pa2, pa3); pv_one<2>(o[2], vb, pa0, pa1, pa2, pa3); pv_one<3>(o[3], vb, pa0, pa1, pa2, pa3);
}
__device__ __forceinline__ void attn_dense_body(const bf16* __restrict__ Qb, const bf16* __restrict__ Kh, const bf16* __restrict__ Vh,
                                                bf16* __restrict__ Ob, int seq, char* lds) {
  constexpr int SDEPTH = 2;
  const int tid = threadIdx.x, wid = tid >> 6, lane = tid & 63, r32 = lane & 31, hi = lane >> 5;
  bf16* V_lds = (bf16*)lds; bf16* K_lds = (bf16*)(lds + 2 * SHM_V);
  float* ws = (float*)(lds + 2 * SHM_V + 2 * SHM_K) + wid * 64; float* li_l = ws; float* al_l = ws + 32;
  float m_reg = -1e30f, l_reg = 0; f32x16 o[4] = {}; bf16x8 qr[8];
  const bf16* Qw = Qb + (long)(wid * QBLK + r32) * LDQ + hi * 8;
#pragma unroll
  for (int d0 = 0; d0 < 8; ++d0) qr[d0] = ld8(Qw + d0 * 16);
  const int sr = tid >> 4, sc = (tid & 15) * 8, vst0 = v_st(sr, sc), vst1 = v_st(32 + sr, sc);
  const int vb0 = (int)(uintptr_t)V_lds + v_rd_base(lane);
  struct { bf16x8 vs0, vs1, ks0, ks1; } sr_[SDEPTH];
#define SLOAD(i, k0) do { sr_[i].vs0 = ld8(&Vh[(long)((k0) + sr) * LDK + sc]); sr_[i].vs1 = ld8(&Vh[(long)((k0) + 32 + sr) * LDK + sc]); \
    sr_[i].ks0 = ld8(&Kh[(long)((k0) + sr) * LDK + sc]); sr_[i].ks1 = ld8(&Kh[(long)((k0) + 32 + sr) * LDK + sc]); } while (0)
#define SWRITE(b, i) do { *(bf16x8*)((char*)V_lds + (b) * SHM_V + vst0) = sr_[i].vs0;          \
    *(bf16x8*)((char*)V_lds + (b) * SHM_V + vst1) = sr_[i].vs1; int kc = sc * 2;               \
    *(bf16x8*)((char*)K_lds + (b) * SHM_K + KSWZ(sr, kc)) = sr_[i].ks0;                       \
    *(bf16x8*)((char*)K_lds + (b) * SHM_K + KSWZ(32 + sr, kc)) = sr_[i].ks1; } while (0)
#define SWAIT() do { asm volatile("s_waitcnt vmcnt(4)" ::: "memory"); } while (0)
#define RESC(a) do { if (__any((a) < 1.f)) { if (hi == 0) al_l[r32] = (a); asm volatile("s_waitcnt lgkmcnt(0)" ::: "memory"); \
    for (int d = 0; d < 4; ++d) for (int r = 0; r < 16; ++r) o[d][r] *= al_l[crow(r, hi)]; } } while (0)
  f32x16 pA0, pA1, pB0, pB1; float mnA, mnB, alA, alB; bf16x8 pa0, pa1, pa2, pa3; const int NT = seq / KVBLK;
  constexpr int SE = 0, SO = SDEPTH - 1;
  SLOAD(SE, 0); asm volatile("s_waitcnt vmcnt(0)" ::: "memory"); SWRITE(0, SE); __syncthreads();
  qkt(pA0, pA1, K_lds, qr, r32, hi); partialSM(pA0, pA1, m_reg, mnA, alA);
  SLOAD(SO, KVBLK); if (2 < NT) SLOAD(SE, 2 * KVBLK);
  SWAIT(); SWRITE(1, SO); __syncthreads();
  for (int j = 1; j + 1 < NT; j += 2) {
    SBAR(); qkt(pB0, pB1, (bf16*)((char*)K_lds + SHM_K), qr, r32, hi);
    finishSM(pA0, pA1, alA, l_reg, pa0, pa1, pa2, pa3); SBAR();
    SLOAD(SO, (j + SDEPTH) * KVBLK); SBAR();
    pv_d0(o, vb0, pa0, pa1, pa2, pa3); partialSM(pB0, pB1, m_reg, mnB, alB);
    __syncthreads(); SWAIT(); SWRITE(0, SE);
    RESC(alB); __syncthreads();
    SBAR(); qkt(pA0, pA1, K_lds, qr, r32, hi);
    finishSM(pB0, pB1, alB, l_reg, pa0, pa1, pa2, pa3); SBAR();
    if (j + 3 < NT) SLOAD(SE, (j + 1 + SDEPTH) * KVBLK); SBAR();
    pv_d0(o, vb0 + (int)SHM_V, pa0, pa1, pa2, pa3); partialSM(pA0, pA1, m_reg, mnA, alA);
    __syncthreads(); SWAIT(); SWRITE(1, SO);
    RESC(alA); __syncthreads();
  }
  SBAR(); qkt(pB0, pB1, (bf16*)((char*)K_lds + SHM_K), qr, r32, hi);
  finishSM(pA0, pA1, alA, l_reg, pa0, pa1, pa2, pa3); SBAR();
  pv_d0(o, vb0, pa0, pa1, pa2, pa3); partialSM(pB0, pB1, m_reg, mnB, alB);
  __syncthreads(); RESC(alB);
  finishSM(pB0, pB1, alB, l_reg, pa0, pa1, pa2, pa3); SBAR();
  pv_d0(o, vb0 + (int)SHM_V, pa0, pa1, pa2, pa3);
  if (hi == 0) li_l[r32] = l_reg; asm volatile("s_waitcnt lgkmcnt(0)" ::: "memory");
  float rli[16];
#pragma unroll
  for (int r = 0; r < 16; ++r) rli[r] = __builtin_amdgcn_rcpf(li_l[crow(r, hi)]);
  bf16* Ow = Ob + (long)(wid * QBLK) * LDO;
#pragma unroll
  for (int r = 0; r < 16; ++r) { int orow = crow(r, hi);
    for (int d0 = 0; d0 < 4; ++d0) { const float v = o[d0][r] * rli[r]; const unsigned u = __float_as_uint(v);
      Ow[(long)orow * LDO + d0 * 32 + r32] = (bf16)((u + 0x7fffu + ((u >> 16) & 1u)) >> 16); } }
#undef SLOAD
#undef SWRITE
#undef SWAIT
#undef RESC
}
#undef KSWZ
#undef SBAR
}

#define LAS __attribute__((address_space(3)))
typedef unsigned short bf16;
typedef unsigned v4u __attribute__((ext_vector_type(4)));
typedef unsigned v2u __attribute__((ext_vector_type(2)));
typedef float f32x4 __attribute__((ext_vector_type(4)));
typedef float f32x2 __attribute__((ext_vector_type(2)));

constexpr size_t HM = 1u << 19;
constexpr size_t WS_MOD = 2 * HM;
constexpr size_t WS_WAB = 4 * HM, WS_WABO = 21 * HM, WS_WFI0 = 25 * HM, WS_WFI1 = 47 * HM, WS_WFO0 = 69 * HM, WS_WFO1 = 80 * HM, WS_WQKV = 91 * HM, WS_WAO = 97 * HM;
constexpr size_t WS_XCTX = 102 * HM;
constexpr size_t WS_H = 110 * HM;
constexpr size_t WS_PROJ = 178 * HM;
constexpr size_t SEG = (size_t)M * 512;
constexpr size_t WS_ACT = 178 * HM;
constexpr size_t WS_Q = 178 * HM, WS_K = 246 * HM, WS_V = 263 * HM;
constexpr size_t WS_OG = 280 * HM;
constexpr size_t WS_Y = 382 * HM;
constexpr size_t WS_BG = 450 * HM;
constexpr size_t WS_END = 512 * HM;
static_assert(WS_BG + (size_t)M * 16 * 4 <= WS_END && WS_Y + (size_t)M * DM * 2 <= WS_BG && WS_PROJ + 8 * SEG * 2 == WS_BG, "ws map");
static_assert(WS_ACT + (size_t)M * DFF * 2 <= WS_Y && WS_V + (size_t)M * 256 * 2 <= WS_OG && WS_OG + (size_t)M * DM * 2 <= WS_Y, "ws map 2");

constexpr int LDS_BYTES = 147456;

__device__ __forceinline__ unsigned f2bf(float f) { unsigned u = __builtin_bit_cast(unsigned, f); return (u + 0x7fffu + ((u >> 16) & 1u)) >> 16; }
__device__ __forceinline__ unsigned pk2(float lo, float hi) { return f2bf(lo) | (f2bf(hi) << 16); }
__device__ __forceinline__ float bf2f(unsigned short h) { return __builtin_bit_cast(float, (unsigned)h << 16); }
__device__ __forceinline__ float bflo(unsigned w) { return __builtin_bit_cast(float, w << 16); }
__device__ __forceinline__ float bfhi(unsigned w) { return __builtin_bit_cast(float, w & 0xffff0000u); }
__device__ __forceinline__ float wave_sum(float v) {
#pragma unroll
    for (int o = 1; o < 64; o <<= 1) v += __shfl_xor(v, o);
    return v;
}
__device__ __forceinline__ float sigmoidf_(float x) { return 1.0f / (1.0f + __expf(-x)); }

struct Frame {
    LAS unsigned char* lds;
    int tid, lane, wave, G;
    const float* in[18]; float* out; unsigned char* ws;
    float* MOD; float* XCTX; bf16* H; bf16* PROJ; float* BG; bf16* OG; bf16* Y; bf16* ACT; bf16 *Q, *K, *V;
    bf16 *WAB, *WABO, *WFI0, *WFI1, *WFO0, *WFO1, *WQKV, *WAO;
};
enum { I_X = 0, I_C, I_CTX, I_CCTX, I_ADAW, I_ADAB, I_NORMG, I_FWIN, I_FWOUT, I_ABWIN, I_CONV, I_GATEB, I_LB, I_OUTG, I_ABWOUT, I_WQKV, I_QKG, I_AWOUT };

__device__ __forceinline__ int drow_of(int mode, int n0) { if (mode == 0) return n0; const int j = n0 < DFF ? n0 : n0 - DFF; return (j >> 7) * 256 + (n0 < DFF ? 0 : 128) + (j & 127); }
__device__ __forceinline__ void p0_transpose_item(const float* W, int K, int N, bf16* WT, int mode, LAS float* scr, int item, int lane) {
    const int nblk = (N + 31) / 32, kb = item / nblk, nb = item % nblk, k0 = 64 * kb, n0 = 32 * nb;
    const int n = n0 + (lane & 31); const bool ok = n < N;
#pragma unroll 8
    for (int i = 0; i < 32; ++i) { const int kk = 2 * i + (lane >> 5); scr[kk * 33 + (lane & 31)] = ok ? W[(size_t)(k0 + kk) * N + n] : 0.f; }
    asm volatile("s_waitcnt lgkmcnt(0)" ::: "memory");
    const int c = lane & 7; const int dr = drow_of(mode, n0);
#pragma unroll
    for (int j = 0; j < 4; ++j) { const int nn = (lane >> 3) + 8 * j; const LAS float* s = scr + (8 * c) * 33 + nn;
        v4u o; o.x = pk2(s[0 * 33], s[1 * 33]); o.y = pk2(s[2 * 33], s[3 * 33]); o.z = pk2(s[4 * 33], s[5 * 33]); o.w = pk2(s[6 * 33], s[7 * 33]);
        *(v4u*)(WT + (size_t)(dr + nn) * K + k0 + 8 * c) = o; }
    asm volatile("s_waitcnt lgkmcnt(0)" ::: "memory");
}
__device__ __forceinline__ void p0_prologue(Frame& F) {
    const int tid = F.tid, lane = F.lane, w = F.wave;
    if (blockIdx.x < 96) {
        LAS float* sc = (LAS float*)F.lds; LAS float* part = sc + 5120;
        for (int i = tid; i < 5120; i += 512) { const int j = i >> 10, k = i & 1023; const float v = j < 4 ? F.in[I_C][j * 1024 + k] : F.in[I_CCTX][k]; sc[i] = v * sigmoidf_(v); }
        __syncthreads();
        const int l = blockIdx.x / 48, col0 = (blockIdx.x % 48) * 128;
        const float* wp = F.in[I_ADAW] + ((size_t)l * 1024 + 128 * w) * 6144 + col0 + 2 * lane;
        float acc[5][2];
#pragma unroll
        for (int j = 0; j < 5; ++j) { acc[j][0] = 0.f; acc[j][1] = 0.f; }
#pragma unroll 8
        for (int kk = 0; kk < 128; ++kk) { const f32x2 wv = *(const f32x2*)(wp + (size_t)kk * 6144);
#pragma unroll
            for (int j = 0; j < 5; ++j) { const float s = sc[j * 1024 + 128 * w + kk]; acc[j][0] += s * wv.x; acc[j][1] += s * wv.y; } }
#pragma unroll
        for (int j = 0; j < 5; ++j) { part[(w * 5 + j) * 128 + 2 * lane] = acc[j][0]; part[(w * 5 + j) * 128 + 2 * lane + 1] = acc[j][1]; }
        __syncthreads();
        for (int i = tid; i < 640; i += 512) { const int j = i >> 7, cc = i & 127; float s = 0.f;
#pragma unroll
            for (int ww = 0; ww < 8; ++ww) s += part[(ww * 5 + j) * 128 + cc];
            F.MOD[(size_t)(l * 5 + j) * 6144 + col0 + cc] = s + F.in[I_ADAB][l * 6144 + col0 + cc]; }
        __syncthreads();
    }
    LAS float* scr = (LAS float*)(F.lds + w * 16384);
    const int gw = blockIdx.x * 8 + w, NGW = F.G * 8;
    constexpr int I_AB = 16 * 129, I_ABO = 16 * 32, I_FI = 16 * 176, I_FO = 44 * 32, I_QK = 16 * 48, I_AO = 16 * 32;
    constexpr int NITEMS = I_AB + I_ABO + 2 * I_FI + 2 * I_FO + I_QK + I_AO;
    for (int it = gw; it < NITEMS; it += NGW) {
        int r = it;
        if (r < I_AB) { p0_transpose_item(F.in[I_ABWIN], 1024, NAB, F.WAB, 0, scr, r, lane); continue; } r -= I_AB;
        if (r < I_ABO) { p0_transpose_item(F.in[I_ABWOUT], 1024, 1024, F.WABO, 0, scr, r, lane); continue; } r -= I_ABO;
        if (r < I_FI) { p0_transpose_item(F.in[I_FWIN], 1024, 2 * DFF, F.WFI0, 1, scr, r, lane); continue; } r -= I_FI;
        if (r < I_FI) { p0_transpose_item(F.in[I_FWIN] + (size_t)1024 * 2 * DFF, 1024, 2 * DFF, F.WFI1, 1, scr, r, lane); continue; } r -= I_FI;
        if (r < I_FO) { p0_transpose_item(F.in[I_FWOUT], DFF, 1024, F.WFO0, 0, scr, r, lane); continue; } r -= I_FO;
        if (r < I_FO) { p0_transpose_item(F.in[I_FWOUT] + (size_t)DFF * 1024, DFF, 1024, F.WFO1, 0, scr, r, lane); continue; } r -= I_FO;
        if (r < I_QK) { p0_transpose_item(F.in[I_WQKV], 1024, NQKV, F.WQKV, 0, scr, r, lane); continue; } r -= I_QK;
        p0_transpose_item(F.in[I_AWOUT], 1024, 1024, F.WAO, 0, scr, r, lane);
    }
    { const int gt = blockIdx.x * 512 + tid, NT_ = F.G * 512; const int n16 = (NABP - 4128) * 1024 * 2 / 16; v4u z = {0u, 0u, 0u, 0u};
      for (int i = gt; i < n16; i += NT_) *((v4u*)(F.WAB + (size_t)4128 * 1024) + i) = z; }
}

template <bool HAS_Y, bool WRITE_X, bool HAS_NEXT, bool LAT_ONLY>
__device__ __forceinline__ void rowpass(const Frame& F, const float* xs_lat, const float* xs_ctx, float* xd_lat, float* xd_ctx,
                                        const float* mod_y, int gate_off, const float* gn_y, const float* mod_n, int sh_off, int sc_off, const float* gn_n) {
    const int lane = F.lane, gw = blockIdx.x * 8 + F.wave, NGW = F.G * 8;
    for (int r = gw; r < M; r += NGW) {
        const int b = r / TT, tt = r - b * TT; const bool isctx = tt < CTX; if (LAT_ONLY && isctx) continue;
        const int j = isctx ? 4 : b;
        const size_t xo = isctx ? (size_t)(b * CTX + tt) * DM : (size_t)(b * SEQ + tt - CTX) * DM;
        const float* xs = (isctx ? xs_ctx : xs_lat) + xo;
        f32x4 x[4];
#pragma unroll
        for (int jj = 0; jj < 4; ++jj) x[jj] = *(const f32x4*)(xs + 4 * lane + 256 * jj);
        if (HAS_Y) {
            f32x4 y[4]; float ss = 0.f;
#pragma unroll
            for (int jj = 0; jj < 4; ++jj) { const v2u w = *(const v2u*)(F.Y + (size_t)r * DM + 4 * lane + 256 * jj);
                y[jj] = (f32x4){bflo(w.x), bfhi(w.x), bflo(w.y), bfhi(w.y)}; ss += (y[jj][0] * y[jj][0] + y[jj][1] * y[jj][1]) + (y[jj][2] * y[jj][2] + y[jj][3] * y[jj][3]); }
            const float rstd = rsqrtf(wave_sum(ss) * (1.f / DM) + EPS);
#pragma unroll
            for (int jj = 0; jj < 4; ++jj) { const int c = 4 * lane + 256 * jj;
                const f32x4 g = *(const f32x4*)(mod_y + (size_t)j * 6144 + gate_off + c), gn = *(const f32x4*)(gn_y + c);
                x[jj] = x[jj] + g * (y[jj] * rstd * gn); }
        }
        if (WRITE_X) { float* xd = (isctx ? xd_ctx : xd_lat) + xo;
#pragma unroll
            for (int jj = 0; jj < 4; ++jj) *(f32x4*)(xd + 4 * lane + 256 * jj) = x[jj]; }
        if (HAS_NEXT) {
            float ss = 0.f;
#pragma unroll
            for (int jj = 0; jj < 4; ++jj) ss += (x[jj][0] * x[jj][0] + x[jj][1] * x[jj][1]) + (x[jj][2] * x[jj][2] + x[jj][3] * x[jj][3]);
            const float rstd = rsqrtf(wave_sum(ss) * (1.f / DM) + EPS);
#pragma unroll
            for (int jj = 0; jj < 4; ++jj) { const int c = 4 * lane + 256 * jj;
                const f32x4 sh = *(const f32x4*)(mod_n + (size_t)j * 6144 + sh_off + c), sc = *(const f32x4*)(mod_n + (size_t)j * 6144 + sc_off + c), gn = *(const f32x4*)(gn_n + c);
                const f32x4 hv = (x[jj] * rstd * gn) * (sc + 1.0f) + sh;
                v2u o; o.x = pk2(hv[0], hv[1]); o.y = pk2(hv[2], hv[3]);
                *(v2u*)(F.H + (size_t)r * DM + c) = o; }
        }
    }
}

__device__ __forceinline__ int scan_row(int b, int dir, int n) {
    if (n < CTX) return b * TT + (dir ? CTX - 1 - n : n);
    const int i = n - CTX; return b * TT + CTX + (dir ? SEQ - 1 - i : i);
}
__device__ __forceinline__ void scan_hgrn_naive(const Frame& F, int ch, bf16* OF, bf16* OB) {
    const int tid = F.tid, e = tid & 127, dg = tid >> 7;
    const int b = ch >> 3, h = (ch >> 1) & 3, dir = ch & 1;
    const bf16* QA = F.PROJ; const bf16* VA = F.PROJ + SEG; const bf16* Z = F.PROJ + (3 + dir) * SEG;
    bf16* O = dir ? OB : OF;
    LAS float* raw = (LAS float*)F.lds;
    LAS float* fkq = raw + 2 * 6144;
    LAS float* opart = fkq + 768;
    float lb = 0.f;
    if (tid < 128) { const float* p = F.in[I_LB] + (size_t)dir * 3 * 512 + h * 128 + tid; const float a0 = p[0], a1 = p[512], a2 = p[1024];
        const float mx = fmaxf(a0, fmaxf(a1, a2)); const float e0 = __expf(a0 - mx), e1 = __expf(a1 - mx), e2 = __expf(a2 - mx); lb = e0 / (e0 + e1 + e2); }
    float S[32];
#pragma unroll
    for (int i = 0; i < 32; ++i) S[i] = 0.f;
    float pre[12];
    constexpr int NG = TT / 16;
#define HG_LOAD(g) do { _Pragma("unroll") for (int j = 0; j < 12; ++j) { const int idx = tid + 512 * j; const int tok = idx / 384, rem = idx - tok * 384, which = rem >> 7, c = rem & 127; \
        const int row = scan_row(b, dir, (g) * 16 + tok); const bf16* src = which == 0 ? Z : (which == 1 ? QA : VA); pre[j] = bf2f(src[(size_t)row * 512 + h * 128 + c]); } } while (0)
#define HG_WRITE(g) do { _Pragma("unroll") for (int j = 0; j < 12; ++j) raw[((g) & 1) * 6144 + tid + 512 * j] = pre[j]; } while (0)
#define HG_FKQ(gb, tok1, dstb) do { const float z = raw[(gb) * 6144 + (tok1) * 384 + tid], q = raw[(gb) * 6144 + (tok1) * 384 + 128 + tid]; const float sg = sigmoidf_(z); \
        fkq[(dstb) * 384 + tid] = lb + (1.f - lb) * sg; fkq[(dstb) * 384 + 128 + tid] = (1.f - lb) * (1.f - sg); fkq[(dstb) * 384 + 256 + tid] = q; } while (0)
    HG_LOAD(0); HG_WRITE(0); __syncthreads();
    if (tid < 128) HG_FKQ(0, 0, 0);
    __syncthreads();
    for (int g = 0; g < NG; ++g) {
        if (g + 1 < NG) HG_LOAD(g + 1);
        for (int tok = 0; tok < 16; ++tok) {
            const int n = g * 16 + tok, cur = n & 1;
            const float ve = raw[(g & 1) * 6144 + tok * 384 + 256 + e];
            float o = 0.f;
#pragma unroll
            for (int dd = 0; dd < 32; ++dd) { const int d = dg * 32 + dd; const float f = fkq[cur * 384 + d], k = fkq[cur * 384 + 128 + d], q = fkq[cur * 384 + 256 + d];
                S[dd] = f * S[dd] + k * ve; o += S[dd] * q; }
            opart[cur * 512 + dg * 128 + e] = o;
            if (tok == 8 && g + 1 < NG) HG_WRITE(g + 1);
            if (tid < 128 && n + 1 < TT) { const int tok1 = (tok + 1) & 15, gb = (tok == 15) ? ((g + 1) & 1) : (g & 1); HG_FKQ(gb, tok1, cur ^ 1); }
            __syncthreads();
            if (dg == 0) { const float s = (opart[cur * 512 + e] + opart[cur * 512 + 128 + e]) + (opart[cur * 512 + 256 + e] + opart[cur * 512 + 384 + e]);
                O[(size_t)scan_row(b, dir, n) * DM + h * 128 + e] = (bf16)f2bf(s); }
        }
    }
#undef HG_LOAD
#undef HG_WRITE
#undef HG_FKQ
    __syncthreads();
}
__device__ __forceinline__ void scan_mlstm_naive(const Frame& F, int ch, bf16* OF, bf16* OB) {
    const int tid = F.tid, e = tid & 127, dg = tid >> 7;
    const int b = ch >> 3, h = (ch >> 1) & 3, dir = ch & 1;
    const bf16* BQK = F.PROJ + 5 * SEG; const bf16* VB = F.PROJ + 6 * SEG;
    bf16* O = dir ? OB : OF;
    constexpr int RAWN = 4384;
    LAS float* raw = (LAS float*)F.lds;
    LAS float* qk = raw + 2 * RAWN;
    LAS float* opart = qk + 256;
    LAS float* dpart = opart + 1024;
    float w0 = 0.f, w1 = 0.f, w2 = 0.f;
    if (tid < 128) { const int col = tid < 64 ? h * 64 + tid : 256 + h * 64 + (tid - 64); w0 = F.in[I_CONV][col]; w1 = F.in[I_CONV][512 + col]; w2 = F.in[I_CONV][1024 + col]; }
    float C[16], ns[16];
#pragma unroll
    for (int i = 0; i < 16; ++i) { C[i] = 0.f; ns[i] = 0.f; }
    float m = 0.f;
    float pre[9];
    constexpr int NG = TT / 16;
#define ML_GEOM(g, L_, tlo_, rb_) const int n0_ = (g) * 16; const bool lat_ = n0_ >= CTX; const int i0_ = lat_ ? n0_ - CTX : n0_; const int L_ = lat_ ? SEQ : CTX; \
        const int tlo_ = dir ? L_ - 1 - (i0_ + 15) : i0_; const int rb_ = b * TT + (lat_ ? CTX : 0);
#define ML_LOAD(g) do { ML_GEOM(g, L, tlo, rb) _Pragma("unroll") for (int j = 0; j < 9; ++j) { const int idx = tid + 512 * j; float val = 0.f; \
        if (idx < 2304) { const int rr = idx >> 7, c = idx & 127, t = tlo - 1 + rr; const int col = c < 64 ? h * 64 + c : 256 + h * 64 + (c - 64); \
            if (t >= 0 && t < L) val = bf2f(BQK[(size_t)(rb + t) * 512 + col]); } \
        else if (idx < 4352) { const int i2 = idx - 2304, tok = i2 >> 7, c = i2 & 127; const int t = dir ? tlo + 15 - tok : tlo + tok; val = bf2f(VB[(size_t)(rb + t) * 512 + h * 128 + c]); } \
        else if (idx < RAWN) { const int i3 = idx - 4352, tok = i3 >> 1, which = i3 & 1; const int t = dir ? tlo + 15 - tok : tlo + tok; const int gi = 4 * (2 * dir + which) + h; \
            val = F.BG[(size_t)(rb + t) * 16 + gi] + F.in[I_GATEB][gi]; } \
        pre[j] = val; } } while (0)
#define ML_WRITE(g) do { _Pragma("unroll") for (int j = 0; j < 9; ++j) { const int idx = tid + 512 * j; if (idx < RAWN) raw[((g) & 1) * RAWN + idx] = pre[j]; } } while (0)
#define ML_QK(gb, tok1, dstb) do { const int rr = (dir ? 15 - (tok1) : (tok1)) + 1; const LAS float* rp = raw + (gb) * RAWN + rr * 128 + tid; \
        const float cv = w0 * rp[-128] + w1 * rp[0] + w2 * rp[128]; const float s = cv * sigmoidf_(cv); qk[(dstb) * 128 + tid] = tid < 64 ? s * 0.125f : s; } while (0)
    ML_LOAD(0); ML_WRITE(0); __syncthreads();
    if (tid < 128) ML_QK(0, 0, 0);
    __syncthreads();
    for (int g = 0; g < NG; ++g) {
        if (g + 1 < NG) ML_LOAD(g + 1);
        for (int tok = 0; tok < 16; ++tok) {
            const int n = g * 16 + tok, cur = n & 1;
            const LAS float* rg = raw + (g & 1) * RAWN;
            const float ve = rg[2304 + tok * 128 + e];
            const float ig = rg[4352 + 2 * tok], fg = rg[4352 + 2 * tok + 1];
            const float logf = fminf(fg, 0.f) - log1pf(__expf(-fabsf(fg)));
            const float mnew = fmaxf(logf + m, ig);
            const float fw = __expf(logf + m - mnew), iw = __expf(ig - mnew);
            float num = 0.f, den = 0.f;
#pragma unroll
            for (int dd = 0; dd < 16; ++dd) { const int d = dg * 16 + dd; const float qd = qk[cur * 128 + d], kd = qk[cur * 128 + 64 + d];
                C[dd] = fw * C[dd] + (iw * kd) * ve; ns[dd] = fw * ns[dd] + iw * kd; num += C[dd] * qd; den += ns[dd] * qd; }
            opart[cur * 512 + dg * 128 + e] = num; if (e == 0) dpart[cur * 4 + dg] = den;
            m = mnew;
            if (tok == 8 && g + 1 < NG) ML_WRITE(g + 1);
            if (tid < 128 && n + 1 < TT) { const int tok1 = (tok + 1) & 15, gb = (tok == 15) ? ((g + 1) & 1) : (g & 1); ML_QK(gb, tok1, cur ^ 1); }
            __syncthreads();
            if (dg == 0) { const float s = (opart[cur * 512 + e] + opart[cur * 512 + 128 + e]) + (opart[cur * 512 + 256 + e] + opart[cur * 512 + 384 + e]);
                const float dn = (dpart[cur * 4] + dpart[cur * 4 + 1]) + (dpart[cur * 4 + 2] + dpart[cur * 4 + 3]);
                const float hv = s / fmaxf(fabsf(dn), __expf(-mnew));
                O[(size_t)scan_row(b, dir, n) * DM + 512 + h * 128 + e] = (bf16)f2bf(hv); }
        }
    }
#undef ML_GEOM
#undef ML_LOAD
#undef ML_WRITE
#undef ML_QK
    __syncthreads();
}

__device__ __forceinline__ void og_pass(const Frame& F, const bf16* OF, const bf16* OB) {
    const int lane = F.lane, gw = blockIdx.x * 8 + F.wave, NGW = F.G * 8;
    const bf16* GA = F.PROJ + 2 * SEG; const bf16* GB = F.PROJ + 7 * SEG;
    for (int r = gw; r < M; r += NGW) {
        const int c0 = 16 * lane;
        const v4u a0 = *(const v4u*)(OF + (size_t)r * DM + c0), a1 = *(const v4u*)(OF + (size_t)r * DM + c0 + 8);
        const v4u b0 = *(const v4u*)(OB + (size_t)r * DM + c0), b1 = *(const v4u*)(OB + (size_t)r * DM + c0 + 8);
        const bf16* gp = c0 < 512 ? GA + (size_t)r * 512 + c0 : GB + (size_t)r * 512 + (c0 - 512);
        const v4u g0 = *(const v4u*)gp, g1 = *(const v4u*)(gp + 8);
        float v[16], gt[16];
#pragma unroll
        for (int i = 0; i < 4; ++i) { v[2 * i] = bflo(a0[i]) + bflo(b0[i]); v[2 * i + 1] = bfhi(a0[i]) + bfhi(b0[i]); v[8 + 2 * i] = bflo(a1[i]) + bflo(b1[i]); v[8 + 2 * i + 1] = bfhi(a1[i]) + bfhi(b1[i]);
            gt[2 * i] = bflo(g0[i]); gt[2 * i + 1] = bfhi(g0[i]); gt[8 + 2 * i] = bflo(g1[i]); gt[8 + 2 * i + 1] = bfhi(g1[i]); }
        float ss = 0.f;
#pragma unroll
        for (int i = 0; i < 16; ++i) ss += v[i] * v[i];
        ss += __shfl_xor(ss, 1); ss += __shfl_xor(ss, 2); ss += __shfl_xor(ss, 4);
        const float rstd = rsqrtf(ss * (1.f / 128.f) + EPS);
        const float* og = F.in[I_OUTG] + c0;
        unsigned o[8];
#pragma unroll
        for (int i = 0; i < 8; ++i) o[i] = pk2(v[2 * i] * rstd * og[2 * i] * gt[2 * i], v[2 * i + 1] * rstd * og[2 * i + 1] * gt[2 * i + 1]);
        *(v4u*)(F.OG + (size_t)r * DM + c0) = (v4u){o[0], o[1], o[2], o[3]}; *(v4u*)(F.OG + (size_t)r * DM + c0 + 8) = (v4u){o[4], o[5], o[6], o[7]};
    }
}

__device__ __forceinline__ void qknorm_pass(const Frame& F) {
    const int lane = F.lane, gw = blockIdx.x * 8 + F.wave, NGW = F.G * 8;
    const float inv = exp2f(-(float)(2 * (lane & 31)) * (13.287712379549449f / 64.f));
    for (int r = gw; r < M; r += NGW) {
        const int b = r / TT, tt = r - b * TT; const bool isctx = tt < CTX;
        float c0 = 1.f, s0 = 0.f, c1 = 1.f, s1 = 0.f;
        if (!isctx) { const int t = tt - CTX; sincosf((float)(t >> 6) * inv, &s0, &c0); sincosf((float)(t & 63) * inv, &s1, &c1); }
        for (int hh = (isctx ? 8 : 0); hh < 10; ++hh) {
            bf16* p = hh < 8 ? F.Q + (size_t)r * 1024 + hh * 128 : F.K + (size_t)r * 256 + (hh - 8) * 128;
            const float* g = F.in[I_QKG] + (hh < 8 ? 0 : 128);
            const float x0 = bf2f(p[lane]), x1 = bf2f(p[64 + lane]);
            const float rstd = rsqrtf(wave_sum(x0 * x0 + x1 * x1) * (1.f / 128.f) + EPS);
            float y0 = x0 * rstd * g[lane], y1 = x1 * rstd * g[64 + lane];
            if (!isctx) { const float p0 = __shfl_xor(y0, 32), p1 = __shfl_xor(y1, 32);
                y0 = lane < 32 ? y0 * c0 - p0 * s0 : y0 * c0 + p0 * s0;
                y1 = lane < 32 ? y1 * c1 - p1 * s1 : y1 * c1 + p1 * s1; }
            p[lane] = (bf16)f2bf(y0); p[64 + lane] = (bf16)f2bf(y1);
        }
    }
}

namespace scan {
typedef short bf16x8 __attribute__((ext_vector_type(8)));
typedef float f32x16 __attribute__((ext_vector_type(16)));
typedef float f32x4 __attribute__((ext_vector_type(4)));
typedef unsigned u32x4 __attribute__((ext_vector_type(4)));
typedef unsigned u32x2 __attribute__((ext_vector_type(2)));
constexpr int NCH = TT / 32;
constexpr int TS = 80;
__device__ __forceinline__ int crow(int r, int hi) { return (r & 3) + 8 * (r >> 2) + 4 * hi; }
__device__ __forceinline__ int kpos(int x) { return (x & ~12) | ((x & 4) << 1) | ((x & 8) >> 1); }
__device__ __forceinline__ unsigned cvtpk(float lo, float hi) { unsigned r; asm volatile("v_cvt_pk_bf16_f32 %0, %1, %2" : "=v"(r) : "v"(lo), "v"(hi)); return r; }
__device__ __forceinline__ bf16x8 pack8(const f32x16& v, int base) {
    u32x4 w; w.x = cvtpk(v[base + 0], v[base + 1]); w.y = cvtpk(v[base + 2], v[base + 3]); w.z = cvtpk(v[base + 4], v[base + 5]); w.w = cvtpk(v[base + 6], v[base + 7]);
    return __builtin_bit_cast(bf16x8, w); }
__device__ __forceinline__ float lo16(unsigned w) { return __builtin_bit_cast(float, w << 16); }
__device__ __forceinline__ float hi16(unsigned w) { return __builtin_bit_cast(float, w & 0xffff0000u); }
__device__ __forceinline__ float xhalf_sum(float v) { auto rr = __builtin_amdgcn_permlane32_swap(__float_as_uint(v), __float_as_uint(v), false, false); return __uint_as_float(rr[0]) + __uint_as_float(rr[1]); }
__device__ __forceinline__ int chunk_row0(int b, int dir, int c) {
    if (c < CTX / 32) return b * TT + (dir ? CTX - 1 - 32 * c : 32 * c);
    const int cc = c - CTX / 32; return b * TT + CTX + (dir ? SEQ - 1 - 32 * cc : 32 * cc);
}
template <int DK> struct Lay {
    static constexpr int RS = DK * 2 + 16;
    static constexpr int Q1 = 0, K1 = 32 * RS, Q2 = 64 * RS, K2T = 96 * RS, VT = K2T + DK * TS, SC = VT + 128 * TS, BYTES = SC + 1024;
};

template <int DK, bool ML>
__device__ __forceinline__ void consume(const LAS unsigned char* buf, f32x16 (&S)[DK / 32], LAS float* wpriv, int w, int r32, int hi,
                                        unsigned short* O, int row0, int rstep, int colbase) {
    using L = Lay<DK>; constexpr int DT = DK / 32, NK = DK / 16;
    const LAS unsigned char* q1 = buf + L::Q1 + r32 * L::RS + hi * 16;
    const LAS unsigned char* k1 = buf + L::K1 + r32 * L::RS + hi * 16;
    const LAS unsigned char* q2 = buf + L::Q2 + r32 * L::RS + hi * 16;
    const LAS float* sc = (const LAS float*)(buf + L::SC);
    f32x16 X = {}, o = {};
    bf16x8 q2f[NK];
#pragma unroll
    for (int ks = 0; ks < NK; ++ks) { const bf16x8 a = *(const LAS bf16x8*)(k1 + ks * 32), bq = *(const LAS bf16x8*)(q1 + ks * 32);
        X = __builtin_amdgcn_mfma_f32_32x32x16_bf16(a, bq, X, 0, 0, 0); }
#pragma unroll
    for (int ks = 0; ks < NK; ++ks) { q2f[ks] = *(const LAS bf16x8*)(q2 + ks * 32);
        o = __builtin_amdgcn_mfma_f32_32x32x16_bf16(q2f[ks], pack8(S[ks >> 1], (ks & 1) * 8), o, 0, 0, 0); }
    float rden[16];
    if (ML) {
        const float ct = sc[32 + r32];
        float colsum = 0.f;
#pragma unroll
        for (int g = 0; g < 4; ++g) { const f32x4 av = *(const LAS f32x4*)(sc + 8 * g + 4 * hi);
#pragma unroll
            for (int i = 0; i < 4; ++i) { const int r = 4 * g + i, s = 8 * g + 4 * hi + i; const float p = (s <= r32) ? __expf(av[i] - ct) : 0.f; X[r] *= p; colsum += X[r]; } }
        float qn = 0.f;
#pragma unroll
        for (int ks = 0; ks < NK; ++ks) { const u32x4 qa = __builtin_bit_cast(u32x4, q2f[ks]);
            const f32x4 n0 = *(const LAS f32x4*)(wpriv + 16 * ks + 4 * hi), n1 = *(const LAS f32x4*)(wpriv + 16 * ks + 8 + 4 * hi);
            qn += lo16(qa.x) * n0[0] + hi16(qa.x) * n0[1] + lo16(qa.y) * n0[2] + hi16(qa.y) * n0[3] + lo16(qa.z) * n1[0] + hi16(qa.z) * n1[1] + lo16(qa.w) * n1[2] + hi16(qa.w) * n1[3]; }
        const float den = xhalf_sum(colsum + qn);
        const float rd = 1.0f / fmaxf(fabsf(den), sc[64 + r32]);
        if (hi == 0) wpriv[64 + r32] = rd;
#pragma unroll
        for (int g = 0; g < 4; ++g) { const f32x4 dv = *(const LAS f32x4*)(wpriv + 64 + 8 * g + 4 * hi);
#pragma unroll
            for (int i = 0; i < 4; ++i) rden[4 * g + i] = dv[i]; }
    } else {
#pragma unroll
        for (int r = 0; r < 16; ++r) { if (crow(r, hi) > r32) X[r] = 0.f; }
    }
    const LAS unsigned char* vt = buf + L::VT + (32 * w + r32) * TS + hi * 16;
    const bf16x8 v0 = *(const LAS bf16x8*)(vt), v1 = *(const LAS bf16x8*)(vt + 32);
    o = __builtin_amdgcn_mfma_f32_32x32x16_bf16(pack8(X, 0), v0, o, 0, 0, 0);
    o = __builtin_amdgcn_mfma_f32_32x32x16_bf16(pack8(X, 8), v1, o, 0, 0, 0);
    const LAS unsigned char* k2 = buf + L::K2T + r32 * TS + hi * 16;
    const float decay = ML ? sc[96] : 1.f;
#pragma unroll
    for (int dt = 0; dt < DT; ++dt) {
        if (ML) { S[dt] = S[dt] * decay; }
        else {
#pragma unroll
            for (int g = 0; g < 4; ++g) { const f32x4 gv = *(const LAS f32x4*)(sc + 32 * dt + 8 * g + 4 * hi);
#pragma unroll
                for (int i = 0; i < 4; ++i) S[dt][4 * g + i] *= gv[i]; } }
        const bf16x8 a0 = *(const LAS bf16x8*)(k2 + dt * 32 * TS), a1 = *(const LAS bf16x8*)(k2 + dt * 32 * TS + 32);
        S[dt] = __builtin_amdgcn_mfma_f32_32x32x16_bf16(a0, v0, S[dt], 0, 0, 0);
        S[dt] = __builtin_amdgcn_mfma_f32_32x32x16_bf16(a1, v1, S[dt], 0, 0, 0);
        if (ML) {
            const u32x4 ua = __builtin_bit_cast(u32x4, a0), ub = __builtin_bit_cast(u32x4, a1);
            float ksum = (lo16(ua.x) + hi16(ua.x)) + (lo16(ua.y) + hi16(ua.y)) + (lo16(ua.z) + hi16(ua.z)) + (lo16(ua.w) + hi16(ua.w))
                       + (lo16(ub.x) + hi16(ub.x)) + (lo16(ub.y) + hi16(ub.y)) + (lo16(ub.z) + hi16(ub.z)) + (lo16(ub.w) + hi16(ub.w));
            ksum = xhalf_sum(ksum);
            if (hi == 0) wpriv[32 * dt + r32] = decay * wpriv[32 * dt + r32] + ksum;
        }
    }
    unsigned short* op = O + colbase + 32 * w + r32;
#pragma unroll
    for (int r = 0; r < 16; ++r) { const float v = ML ? o[r] * rden[r] : o[r]; const unsigned u = __float_as_uint(v);
        op[(long)(row0 + rstep * crow(r, hi)) * DM] = (unsigned short)((u + 0x7fffu + ((u >> 16) & 1u)) >> 16); }
}

struct HgPre { unsigned z[8], q[8], v[8]; };
__device__ __forceinline__ void hg_load(HgPre& P, const unsigned short* Z, const unsigned short* QA, const unsigned short* VA, int row0, int rstep, int colg, int qd) {
#pragma unroll
    for (int ii = 0; ii < 8; ++ii) { const size_t off = (size_t)(row0 + rstep * (8 * qd + ii)) * 512 + colg;
        P.z[ii] = *(const unsigned*)(Z + off); P.q[ii] = *(const unsigned*)(QA + off); P.v[ii] = *(const unsigned*)(VA + off); }
}
__device__ __forceinline__ void hg_produce(LAS unsigned char* buf, const HgPre& P, float lb0, float lb1, int pw, int cp, int qd) {
    using L = Lay<128>;
    const int d0 = 32 * pw + 2 * cp;
    float q[2][8], k[2][8], Pc[2][8], RP[2][8];
#pragma unroll
    for (int x = 0; x < 2; ++x) { const float lb = x ? lb1 : lb0; float p = 1.f, rp = 1.f;
#pragma unroll
        for (int ii = 0; ii < 8; ++ii) { const float z = x ? hi16(P.z[ii]) : lo16(P.z[ii]); q[x][ii] = x ? hi16(P.q[ii]) : lo16(P.q[ii]);
            const float sg = __builtin_amdgcn_rcpf(1.f + __expf(-z)); const float f = lb + (1.f - lb) * sg; k[x][ii] = (1.f - lb) * (1.f - sg);
            p *= f; rp *= __builtin_amdgcn_rcpf(f); Pc[x][ii] = p; RP[x][ii] = rp; } }
    const int lane = cp + 16 * qd;
    unsigned k2lo[2][2], k2hi[2][2];
#pragma unroll
    for (int x = 0; x < 2; ++x) {
        const float T = Pc[x][7];
        const float T0 = __shfl(T, cp), T1 = __shfl(T, cp + 16), T2 = __shfl(T, cp + 32), T3 = __shfl(T, cp + 48);
        const float emid = T0 * T1, elast = T2 * T3;
        const float scale = qd == 0 ? __builtin_amdgcn_rcpf(emid) : (qd == 1 ? __builtin_amdgcn_rcpf(T1) : (qd == 2 ? 1.f : T2));
        const float rscale = qd == 0 ? emid : (qd == 1 ? T1 : (qd == 2 ? 1.f : __builtin_amdgcn_rcpf(T2)));
#pragma unroll
        for (int ii = 0; ii < 8; ++ii) { const float qt = q[x][ii] * (Pc[x][ii] * scale), kt = k[x][ii] * (RP[x][ii] * rscale);
            q[x][ii] = qt; k[x][ii] = kt; Pc[x][ii] = qt * emid; RP[x][ii] = kt * elast; }
        k2lo[x][0] = cvtpk(RP[x][0], RP[x][1]); k2lo[x][1] = cvtpk(RP[x][2], RP[x][3]); k2hi[x][0] = cvtpk(RP[x][4], RP[x][5]); k2hi[x][1] = cvtpk(RP[x][6], RP[x][7]);
        if (qd == 0) ((LAS float*)(buf + L::SC))[d0 + x] = emid * elast;
    }
    (void)lane;
    const int pd = ((d0 & ~15) | kpos(d0 & 15)) * 2;
#pragma unroll
    for (int ii = 0; ii < 8; ++ii) { const int i = 8 * qd + ii;
        *(LAS unsigned*)(buf + L::Q1 + i * L::RS + pd) = cvtpk(q[0][ii], q[1][ii]);
        *(LAS unsigned*)(buf + L::K1 + i * L::RS + pd) = cvtpk(k[0][ii], k[1][ii]);
        *(LAS unsigned*)(buf + L::Q2 + i * L::RS + pd) = cvtpk(Pc[0][ii], Pc[1][ii]); }
    const int ps = (16 * (qd >> 1) + 4 * (qd & 1)) * 2;
#pragma unroll
    for (int x = 0; x < 2; ++x) {
        *(LAS u32x2*)(buf + L::K2T + (d0 + x) * TS + ps) = (u32x2){k2lo[x][0], k2lo[x][1]};
        *(LAS u32x2*)(buf + L::K2T + (d0 + x) * TS + ps + 16) = (u32x2){k2hi[x][0], k2hi[x][1]};
        unsigned a, b2, c2, d2;
        if (x == 0) { a = (P.v[0] & 0xffffu) | (P.v[1] << 16); b2 = (P.v[2] & 0xffffu) | (P.v[3] << 16); c2 = (P.v[4] & 0xffffu) | (P.v[5] << 16); d2 = (P.v[6] & 0xffffu) | (P.v[7] << 16); }
        else { a = (P.v[0] >> 16) | (P.v[1] & 0xffff0000u); b2 = (P.v[2] >> 16) | (P.v[3] & 0xffff0000u); c2 = (P.v[4] >> 16) | (P.v[5] & 0xffff0000u); d2 = (P.v[6] >> 16) | (P.v[7] & 0xffff0000u); }
        *(LAS u32x2*)(buf + L::VT + (d0 + x) * TS + ps) = (u32x2){a, b2};
        *(LAS u32x2*)(buf + L::VT + (d0 + x) * TS + ps + 16) = (u32x2){c2, d2};
    }
}

struct MlPre { unsigned x[10], v[8]; float ig, fg; };
__device__ __forceinline__ void ml_load(MlPre& P, const unsigned short* BQK, const unsigned short* VB, const float* BG, int segrow0, int L, int tq0, int colq, int colv,
                                        int row0, int rstep, int qd, int i32, int gi_i, int gi_f, float gb_i, float gb_f) {
#pragma unroll
    for (int jj = 0; jj < 10; ++jj) { const int t = tq0 - 1 + jj; P.x[jj] = (t >= 0 && t < L) ? *(const unsigned*)(BQK + (size_t)(segrow0 + t) * 512 + colq) : 0u; }
#pragma unroll
    for (int ii = 0; ii < 8; ++ii) P.v[ii] = *(const unsigned*)(VB + (size_t)(row0 + rstep * (8 * qd + ii)) * 512 + colv);
    const size_t gr = (size_t)(row0 + rstep * i32) * 16;
    P.ig = BG[gr + gi_i] + gb_i; P.fg = BG[gr + gi_f] + gb_f;
}
__device__ __forceinline__ void ml_produce(LAS unsigned char* buf, const MlPre& P, LAS float* ppriv, float& m, int dir, int pw, int cp, int qd, int lane,
                                           float w00, float w01, float w02, float w10, float w11, float w12) {
    using L = Lay<64>;
    const int i32 = lane & 31;
    const float logf = fminf(P.fg, 0.f) - log1pf(__expf(-fabsf(P.fg)));
    float bh = logf;
#pragma unroll
    for (int o = 1; o < 32; o <<= 1) { const float t = __shfl_up(bh, o, 32); if (i32 >= o) bh += t; }
    const float a = P.ig - bh;
    float pm = a;
#pragma unroll
    for (int o = 1; o < 32; o <<= 1) { const float t = __shfl_up(pm, o, 32); if (i32 >= o) pm = fmaxf(pm, t); }
    const float c = fmaxf(pm, m);
    const float c31 = __shfl(c, 31, 32), bh31 = __shfl(bh, 31, 32);
    const float winter = __expf(m - c), wk = __expf(a - c31), decay = __expf(m - c31), flo = __expf(-(bh + c));
    if (lane < 32) { ppriv[i32] = winter; ppriv[32 + i32] = wk; }
    if (pw == 0 && lane < 32) { LAS float* sc = (LAS float*)(buf + L::SC); sc[i32] = a; sc[32 + i32] = c; sc[64 + i32] = flo; if (i32 == 0) sc[96] = decay; }
    m = bh31 + c31;
    const bool isk = pw >= 2;
    float y[2][8];
#pragma unroll
    for (int mm = 0; mm < 8; ++mm) {
        const float c0v = w00 * lo16(P.x[mm]) + w01 * lo16(P.x[mm + 1]) + w02 * lo16(P.x[mm + 2]);
        const float c1v = w10 * hi16(P.x[mm]) + w11 * hi16(P.x[mm + 1]) + w12 * hi16(P.x[mm + 2]);
        const float s0 = c0v * __builtin_amdgcn_rcpf(1.f + __expf(-c0v)), s1 = c1v * __builtin_amdgcn_rcpf(1.f + __expf(-c1v));
        const int ii = dir ? 7 - mm : mm;
        y[0][ii] = isk ? s0 : s0 * 0.125f; y[1][ii] = isk ? s1 : s1 * 0.125f; }
    const LAS float* wp = ppriv + (isk ? 32 : 0) + 8 * qd;
    const f32x4 wa = *(const LAS f32x4*)wp, wb = *(const LAS f32x4*)(wp + 4);
    float ws[8] = {wa[0], wa[1], wa[2], wa[3], wb[0], wb[1], wb[2], wb[3]};
    const int cc = (32 * pw + 2 * cp) & 63;
    const int ps = (16 * (qd >> 1) + 4 * (qd & 1)) * 2;
    if (!isk) {
        const int pd = ((cc & ~15) | kpos(cc & 15)) * 2;
#pragma unroll
        for (int ii = 0; ii < 8; ++ii) { const int i = 8 * qd + ii;
            *(LAS unsigned*)(buf + L::Q1 + i * L::RS + pd) = cvtpk(y[0][ii], y[1][ii]);
            *(LAS unsigned*)(buf + L::Q2 + i * L::RS + pd) = cvtpk(y[0][ii] * ws[ii], y[1][ii] * ws[ii]); }
    } else {
        const int pd = ((cc & ~15) | kpos(cc & 15)) * 2;
#pragma unroll
        for (int ii = 0; ii < 8; ++ii) { const int i = 8 * qd + ii; *(LAS unsigned*)(buf + L::K1 + i * L::RS + pd) = cvtpk(y[0][ii], y[1][ii]); }
#pragma unroll
        for (int x = 0; x < 2; ++x) {
            *(LAS u32x2*)(buf + L::K2T + (cc + x) * TS + ps) = (u32x2){cvtpk(y[x][0] * ws[0], y[x][1] * ws[1]), cvtpk(y[x][2] * ws[2], y[x][3] * ws[3])};
            *(LAS u32x2*)(buf + L::K2T + (cc + x) * TS + ps + 16) = (u32x2){cvtpk(y[x][4] * ws[4], y[x][5] * ws[5]), cvtpk(y[x][6] * ws[6], y[x][7] * ws[7])}; }
    }
    const int e0 = 32 * pw + 2 * cp;
#pragma unroll
    for (int x = 0; x < 2; ++x) {
        unsigned a2, b2, c2, d2;
        if (x == 0) { a2 = (P.v[0] & 0xffffu) | (P.v[1] << 16); b2 = (P.v[2] & 0xffffu) | (P.v[3] << 16); c2 = (P.v[4] & 0xffffu) | (P.v[5] << 16); d2 = (P.v[6] & 0xffffu) | (P.v[7] << 16); }
        else { a2 = (P.v[0] >> 16) | (P.v[1] & 0xffff0000u); b2 = (P.v[2] >> 16) | (P.v[3] & 0xffff0000u); c2 = (P.v[4] >> 16) | (P.v[5] & 0xffff0000u); d2 = (P.v[6] >> 16) | (P.v[7] & 0xffff0000u); }
        *(LAS u32x2*)(buf + L::VT + (e0 + x) * TS + ps) = (u32x2){a2, b2};
        *(LAS u32x2*)(buf + L::VT + (e0 + x) * TS + ps + 16) = (u32x2){c2, d2};
    }
}

#define SCAN_BAR() do { asm volatile("s_waitcnt lgkmcnt(0)" ::: "memory"); __builtin_amdgcn_s_barrier(); asm volatile("" ::: "memory"); } while (0)

__device__ __forceinline__ void run_hgrn(LAS unsigned char* lds, int ch, const unsigned short* PROJ, const float* hgrn_lb, unsigned short* OF, unsigned short* OB) {
    using L = Lay<128>;
    const int tid = threadIdx.x, wave = __builtin_amdgcn_readfirstlane(tid >> 6), lane = tid & 63;
    const int b = ch >> 3, h = (ch >> 1) & 3, dir = ch & 1, rstep = dir ? -1 : 1;
    const unsigned short* QA = PROJ; const unsigned short* VA = PROJ + SEG; const unsigned short* Z = PROJ + (3 + dir) * SEG;
    unsigned short* O = dir ? OB : OF;
    if (wave < 4) {
        f32x16 S[4] = {};
        const int r32 = lane & 31, hi = lane >> 5;
        SCAN_BAR();
        for (int c = 0; c < NCH; ++c) {
            consume<128, false>(lds + (c & 1) * L::BYTES, S, nullptr, wave, r32, hi, O, chunk_row0(b, dir, c), rstep, h * 128);
            SCAN_BAR();
        }
    } else {
        const int pw = wave - 4, cp = lane & 15, qd = lane >> 4, d0 = 32 * pw + 2 * cp, colg = h * 128 + d0;
        float lbv[2];
#pragma unroll
        for (int x = 0; x < 2; ++x) { const float* p = hgrn_lb + (size_t)dir * 3 * 512 + h * 128 + d0 + x; const float a0 = p[0], a1 = p[512], a2 = p[1024];
            const float mx = fmaxf(a0, fmaxf(a1, a2)); const float e0 = __expf(a0 - mx), e1 = __expf(a1 - mx), e2 = __expf(a2 - mx); lbv[x] = e0 / (e0 + e1 + e2); }
        HgPre P0, P1, P2;
#define HG_LD(P_, c_) hg_load(P_, Z, QA, VA, chunk_row0(b, dir, (c_)), rstep, colg, qd)
#define HG_STEP(c_, LS, PS) do { if ((c_) + 3 < NCH) HG_LD(LS, (c_) + 3); if ((c_) + 1 < NCH) hg_produce(lds + (((c_) + 1) & 1) * L::BYTES, PS, lbv[0], lbv[1], pw, cp, qd); SCAN_BAR(); } while (0)
        HG_LD(P0, 0); HG_LD(P1, 1); HG_LD(P2, 2);
        hg_produce(lds, P0, lbv[0], lbv[1], pw, cp, qd);
        SCAN_BAR();
        for (int c = 0; c < NCH - 1; c += 3) { HG_STEP(c, P0, P1); HG_STEP(c + 1, P1, P2); HG_STEP(c + 2, P2, P0); }
        SCAN_BAR();
#undef HG_LD
#undef HG_STEP
    }
}
__device__ __forceinline__ void run_mlstm(LAS unsigned char* lds, int ch, const unsigned short* PROJ, const float* BG, const float* conv, const float* gate_b, unsigned short* OF, unsigned short* OB) {
    using L = Lay<64>;
    const int tid = threadIdx.x, wave = __builtin_amdgcn_readfirstlane(tid >> 6), lane = tid & 63;
    const int b = ch >> 3, h = (ch >> 1) & 3, dir = ch & 1, rstep = dir ? -1 : 1;
    const unsigned short* BQK = PROJ + 5 * SEG; const unsigned short* VB = PROJ + 6 * SEG;
    unsigned short* O = dir ? OB : OF;
    LAS float* priv = (LAS float*)(lds + 2 * L::BYTES) + wave * 128;
    if (wave < 4) {
        f32x16 S[2] = {};
        const int r32 = lane & 31, hi = lane >> 5;
        priv[lane] = 0.f;
        SCAN_BAR();
        for (int c = 0; c < NCH; ++c) {
            consume<64, true>(lds + (c & 1) * L::BYTES, S, priv, wave, r32, hi, O, chunk_row0(b, dir, c), rstep, 512 + h * 128);
            SCAN_BAR();
        }
    } else {
        const int pw = wave - 4, cp = lane & 15, qd = lane >> 4, i32 = lane & 31;
        const int cc = 32 * pw + 2 * cp;
        const int colq = cc < 64 ? h * 64 + cc : 256 + h * 64 + (cc - 64);
        const int colv = h * 128 + cc;
        const float w00 = conv[colq], w01 = conv[512 + colq], w02 = conv[1024 + colq], w10 = conv[colq + 1], w11 = conv[512 + colq + 1], w12 = conv[1024 + colq + 1];
        const int gi_i = 4 * (2 * dir) + h, gi_f = 4 * (2 * dir + 1) + h; const float gb_i = gate_b[gi_i], gb_f = gate_b[gi_f];
        float m = 0.f;
        MlPre P0, P1, P2;
#define ML_LOADC(P, c_) do { const int c__ = (c_); const bool lat = c__ >= CTX / 32; const int Lg = lat ? SEQ : CTX; const int segrow0 = b * TT + (lat ? CTX : 0); \
        const int i0 = 32 * (lat ? c__ - CTX / 32 : c__) + 8 * qd; const int tq0 = dir ? Lg - 1 - (i0 + 7) : i0; \
        ml_load(P, BQK, VB, BG, segrow0, Lg, tq0, colq, colv, chunk_row0(b, dir, c__), rstep, qd, i32, gi_i, gi_f, gb_i, gb_f); } while (0)
#define ML_STEP(c_, LS, PS) do { if ((c_) + 3 < NCH) ML_LOADC(LS, (c_) + 3); if ((c_) + 1 < NCH) ml_produce(lds + (((c_) + 1) & 1) * L::BYTES, PS, priv, m, dir, pw, cp, qd, lane, w00, w01, w02, w10, w11, w12); SCAN_BAR(); } while (0)
        ML_LOADC(P0, 0); ML_LOADC(P1, 1); ML_LOADC(P2, 2);
        ml_produce(lds, P0, priv, m, dir, pw, cp, qd, lane, w00, w01, w02, w10, w11, w12);
        SCAN_BAR();
        for (int c = 0; c < NCH - 1; c += 3) { ML_STEP(c, P0, P1); ML_STEP(c + 1, P1, P2); ML_STEP(c + 2, P2, P0); }
        SCAN_BAR();
#undef ML_STEP
#undef ML_LOADC
    }
}
#undef SCAN_BAR
}

enum { PH_PRO = 0, PH_MOD0, PH_INPROJ, PH_SCAN, PH_OG, PH_OUT0, PH_ROW0A, PH_FFI0, PH_FFO0, PH_ROW0B, PH_QKV, PH_QKN, PH_ATTN, PH_OUT1, PH_ROW1A, PH_FFI1, PH_FFO1, PH_ROW1B, NPH };
struct Args { const float* in[18]; float* out; unsigned char* ws; int ph_lo, ph_hi; };

template <class FN> __device__ __forceinline__ void run_gemm(Frame& F, const bf16* A, const bf16* Bt, int N, int K, int skipctx, const FN& fn) {
    pg8::Gemm g{A, Bt, M, N, K}; pg8::TileOrder S; S.init(skipctx ? 64 : 68, N, F.G, (int)blockIdx.x, skipctx);
    pg8::Epi8<FN> E{fn};
    pg8::gemm_phase<pg8::Epi8<FN>, pg8::TileOrder, true, true>(F.lds, g, S, E);
}

__global__ void __launch_bounds__(512, 2) mk_fwd(Args args) {
    extern __shared__ __attribute__((aligned(16))) unsigned char lds[];
    cg::grid_group grid = cg::this_grid();
    Frame F;
    F.lds = (LAS unsigned char*)lds;
    F.tid = threadIdx.x; F.lane = F.tid & 63; F.wave = __builtin_amdgcn_readfirstlane(F.tid >> 6); F.G = gridDim.x;
#pragma unroll
    for (int i = 0; i < 18; ++i) F.in[i] = args.in[i];
    F.out = args.out; F.ws = args.ws;
    unsigned char* ws = args.ws;
    F.MOD = (float*)(ws + WS_MOD); F.XCTX = (float*)(ws + WS_XCTX); F.H = (bf16*)(ws + WS_H); F.PROJ = (bf16*)(ws + WS_PROJ); F.BG = (float*)(ws + WS_BG);
    F.OG = (bf16*)(ws + WS_OG); F.Y = (bf16*)(ws + WS_Y); F.ACT = (bf16*)(ws + WS_ACT); F.Q = (bf16*)(ws + WS_Q); F.K = (bf16*)(ws + WS_K); F.V = (bf16*)(ws + WS_V);
    F.WAB = (bf16*)(ws + WS_WAB); F.WABO = (bf16*)(ws + WS_WABO); F.WFI0 = (bf16*)(ws + WS_WFI0); F.WFI1 = (bf16*)(ws + WS_WFI1); F.WFO0 = (bf16*)(ws + WS_WFO0); F.WFO1 = (bf16*)(ws + WS_WFO1);
    F.WQKV = (bf16*)(ws + WS_WQKV); F.WAO = (bf16*)(ws + WS_WAO);
    bf16* OF = (bf16*)F.out;
    bf16* OB = F.H;
    const float* MOD0 = F.MOD; const float* MOD1 = F.MOD + 5 * 6144;
    const float* NG = F.in[I_NORMG];
    const int lo = args.ph_lo, hi = args.ph_hi;
#define IN(k) (lo <= (k) && (k) < hi)
#define SEAM(k) do { if (IN(k) && IN((k) + 1)) grid.sync(); } while (0)
#define NREP(k) 1
#define PH(k) for (int rep_ = 0; IN(k) && rep_ < NREP(k); (++rep_ < NREP(k)) ? grid.sync() : (void)0)

    PH(PH_PRO) p0_prologue(F);
    SEAM(PH_PRO);
    PH(PH_MOD0) rowpass<false, false, true, false>(F, F.in[I_X], F.in[I_CTX], nullptr, nullptr, nullptr, 0, nullptr, MOD0, 0, 1024, NG + 0);
    SEAM(PH_MOD0);
    PH(PH_INPROJ) run_gemm(F, F.H, F.WAB, NABP, 1024, 0, pg8::FProj{F.PROJ, F.BG});
    SEAM(PH_INPROJ);
#if SCAN_NAIVE
    PH(PH_SCAN) { if (blockIdx.x < 32) scan_hgrn_naive(F, blockIdx.x, OF, OB); else if (blockIdx.x < 64) scan_mlstm_naive(F, blockIdx.x - 32, OF, OB); }
#else
    PH(PH_SCAN) { if (blockIdx.x < 32) scan::run_hgrn(F.lds, blockIdx.x, F.PROJ, F.in[I_LB], OF, OB);
                       else if (blockIdx.x < 64) scan::run_mlstm(F.lds, blockIdx.x - 32, F.PROJ, F.BG, F.in[I_CONV], F.in[I_GATEB], OF, OB); }
#endif
    SEAM(PH_SCAN);
    PH(PH_OG) og_pass(F, OF, OB);
    SEAM(PH_OG);
    PH(PH_OUT0) run_gemm(F, F.OG, F.WABO, 1024, 1024, 0, pg8::FStore{F.Y, 1024});
    SEAM(PH_OUT0);
    PH(PH_ROW0A) rowpass<true, true, true, false>(F, F.in[I_X], F.in[I_CTX], F.out, F.XCTX, MOD0, 2048, NG + 1024, MOD0, 3072, 4096, NG + 2048);
    SEAM(PH_ROW0A);
    PH(PH_FFI0) run_gemm(F, F.H, F.WFI0, 2 * DFF, 1024, 0, pg8::FSwiglu{F.ACT});
    SEAM(PH_FFI0);
    PH(PH_FFO0) run_gemm(F, F.ACT, F.WFO0, 1024, DFF, 0, pg8::FStore{F.Y, 1024});
    SEAM(PH_FFO0);
    PH(PH_ROW0B) rowpass<true, true, true, false>(F, F.out, F.XCTX, F.out, F.XCTX, MOD0, 5120, NG + 3072, MOD1, 0, 1024, NG + 4096);
    SEAM(PH_ROW0B);
    PH(PH_QKV) run_gemm(F, F.H, F.WQKV, NQKV, 1024, 0, pg8::FQkv{F.Q, F.K, F.V});
    SEAM(PH_QKV);
    PH(PH_QKN) qknorm_pass(F);
    SEAM(PH_QKN);
    PH(PH_ATTN) {
        const int bx = blockIdx.x, vcu = (F.G % 8 == 0) ? (bx % 8) * (F.G / 8) + bx / 8 : bx;
        for (int u = vcu; u < 512; u += F.G) {
            const int uu = (u % 256) * 2 + u / 256;
            const int g = uu & 3, qb = (uu >> 2) & 15, kvh = (uu >> 6) & 1, b = uu >> 7, head = kvh * 4 + g;
            const size_t qrow = (size_t)b * TT + CTX + qb * 256;
            attn::attn_dense_body(F.Q + qrow * 1024 + head * 128, F.K + (size_t)b * TT * 256 + kvh * 128, F.V + (size_t)b * TT * 256 + kvh * 128,
                                  F.OG + qrow * 1024 + head * 128, TT, (char*)lds);
            __syncthreads();
        }
    }
    SEAM(PH_ATTN);
    PH(PH_OUT1) run_gemm(F, F.OG, F.WAO, 1024, 1024, 1, pg8::FStore{F.Y, 1024});
    SEAM(PH_OUT1);
    PH(PH_ROW1A) rowpass<true, true, true, true>(F, F.out, F.XCTX, F.out, F.XCTX, MOD1, 2048, NG + 5120, MOD1, 3072, 4096, NG + 6144);
    SEAM(PH_ROW1A);
    PH(PH_FFI1) run_gemm(F, F.H, F.WFI1, 2 * DFF, 1024, 1, pg8::FSwiglu{F.ACT});
    SEAM(PH_FFI1);
    PH(PH_FFO1) run_gemm(F, F.ACT, F.WFO1, 1024, DFF, 1, pg8::FStore{F.Y, 1024});
    SEAM(PH_FFO1);
    PH(PH_ROW1B) rowpass<true, true, false, true>(F, F.out, F.XCTX, F.out, F.XCTX, MOD1, 5120, NG + 7168, nullptr, 0, 0, nullptr);
#undef IN
#undef SEAM
#undef PH
#undef NREP
}

extern "C" void kernel_launch(void* const* d_in, const int* in_sizes, int n_in, void* d_out, int out_size, void* d_ws, size_t ws_size, hipStream_t stream) {
    static int grid = 0;
    if (grid == 0) {
        if (n_in != 18 || in_sizes[0] != NB * SEQ * DM || out_size != NB * SEQ * DM || ws_size < WS_END) {
            fprintf(stderr, "kernel_launch: unexpected shapes (n_in %d, in0 %d, out %d, ws %zu)\n", n_in, n_in > 0 ? in_sizes[0] : -1, out_size, ws_size); grid = -1; return; }
        int dev = 0, cus = 0, per_cu = 0;
        if (hipGetDevice(&dev) != hipSuccess || hipDeviceGetAttribute(&cus, hipDeviceAttributeMultiprocessorCount, dev) != hipSuccess) { grid = -1; return; }
        if (hipFuncSetAttribute((const void*)mk_fwd, hipFuncAttributeMaxDynamicSharedMemorySize, LDS_BYTES) != hipSuccess) { fprintf(stderr, "kernel_launch: hipFuncSetAttribute failed\n"); grid = -1; return; }
        if (hipOccupancyMaxActiveBlocksPerMultiprocessor(&per_cu, (const void*)mk_fwd, 512, LDS_BYTES) != hipSuccess || per_cu < 1) { fprintf(stderr, "kernel_launch: occupancy query says %d blocks per CU\n", per_cu); per_cu = 1; }
        (void)hipGetLastError();
        grid = cus;
        fprintf(stderr, "kernel_launch: grid %d (occupancy query %d per CU)\n", grid, per_cu);
    }
    if (grid < 0) return;
    Args a{};
    for (int i = 0; i < 18; ++i) a.in[i] = (const float*)d_in[i];
    a.out = (float*)d_out; a.ws = (unsigned char*)d_ws;
#if MK_ONE
    a.ph_lo = 0; a.ph_hi = NPH;
    void* kargs[] = {&a};
    hipError_t e = hipLaunchCooperativeKernel((const void*)mk_fwd, dim3(grid), dim3(512), kargs, LDS_BYTES, stream);
    if (e != hipSuccess) fprintf(stderr, "kernel_launch: cooperative launch failed: %s (grid %d)\n", hipGetErrorString(e), grid);
#else
    for (int p = 0; p < NPH; ++p) for (int rep = 0; rep < ((((PROBE_REP) >> p) & 1) ? 2 : 1); ++rep) { a.ph_lo = p; a.ph_hi = p + 1; hipLaunchKernelGGL(mk_fwd, dim3(grid), dim3(512), LDS_BYTES, stream, a); }
    const hipError_t le = hipPeekAtLastError();
    if (le != hipSuccess) fprintf(stderr, "kernel_launch: launch failed: %s\n", hipGetErrorName(le));
#endif
}
```

```cpp
#include <hip/hip_runtime.h>
#include <hip/hip_cooperative_groups.h>
#include <cstdio>
#include <cstdint>
namespace cg = cooperative_groups;

constexpr int DM = 1024, NB = 4, SEQ = 4096, CTX = 256, TT = SEQ + CTX, M = NB * TT;
constexpr int DFF = 2816, NAB = 4112, NABP = 4352, NQKV = 1536;
constexpr float EPS = 1e-6f;
#ifndef MK_ONE
#define MK_ONE 1
#endif
#ifndef PROBE_REP
#define PROBE_REP 0
#endif
#ifndef PROBE_VAR
#define PROBE_VAR 0
#endif
#ifndef SCAN_NAIVE
#define SCAN_NAIVE 0
#endif

namespace pg8 {
#define PG8_LAS __attribute__((address_space(3)))
typedef unsigned short bf16_t;
typedef short bf16x8 __attribute__((ext_vector_type(8)));
typedef float f32x4 __attribute__((ext_vector_type(4)));
typedef unsigned u32x4 __attribute__((ext_vector_type(4)));
constexpr int BM = 256, BK = 64, HALF = 128, HTB = HALF * BK * 2  , STAGE_BYTES = 8 * HTB, NXCD = 8, WGM = 8;

__host__ __device__ __forceinline__ int lds_byte(int r, int c) { const int st = (r >> 4) * 2 + (c >> 5), rr = r & 15, cc = c & 31, ob = rr * 64 + cc * 2; return st * 1024 + (ob ^ (((ob >> 9) & 1) << 5)); }
__host__ __device__ __forceinline__ void stage_rc(int b, int& R, int& C) { const int st = b / 1024, sb = b % 1024, swz = sb ^ (((sb >> 9) & 1) << 5); R = (st >> 1) * 16 + swz / 64; C = (st & 1) * 32 + (swz % 64) / 2; }
__host__ __device__ __forceinline__ int perm32(int rho) { const int n = rho >> 4, i = rho & 15; return 8 * (i >> 2) + 4 * n + (i & 3); }

struct Unit { int pm, pn; };
struct Gemm { const bf16_t* A; const bf16_t* Bt; int M, N, K; };

struct TileOrder {
    int nM, nN, nwg, G, c, skip;
    __device__ void init(int nM_, int N, int G_, int c_, int skip_) { nM = nM_; nN = N / BM; nwg = nM * nN; G = G_; c = c_; skip = skip_; }
    __device__ bool next(int i, Unit& u) const {
        const long L = (long)i * G + c; if (L >= nwg) return false;
        int wgid = (int)L; { const int q = nwg / NXCD, r = nwg % NXCD, xcd = wgid % NXCD, off = wgid / NXCD; wgid = (xcd < r ? xcd * (q + 1) : r * (q + 1) + (xcd - r) * q) + off; }
        const int nig = WGM * nN, gid = wgid / nig, fm = gid * WGM, gsz = (nM - fm) < WGM ? (nM - fm) : WGM;
        int pm = fm + ((wgid % nig) % gsz); u.pn = (wgid % nig) / gsz;
        if (skip) pm = pm + (pm >> 4) + 1;
        u.pm = pm; return true;
    }
    __device__ __forceinline__ void a_ready(const Unit&) const {}
    __device__ __forceinline__ void done(const Unit&) const {}
};

__device__ __forceinline__ unsigned cvt_pk_bf16(float lo, float hi) { unsigned r; asm volatile("v_cvt_pk_bf16_f32 %0, %1, %2" : "=v"(r) : "v"(lo), "v"(hi)); return r; }
__device__ __forceinline__ u32x4 pack8(const f32x4 a, const f32x4 b) { u32x4 w; w.x = cvt_pk_bf16(a[0], a[1]); w.y = cvt_pk_bf16(a[2], a[3]); w.z = cvt_pk_bf16(b[0], b[1]); w.w = cvt_pk_bf16(b[2], b[3]); return w; }
__device__ __forceinline__ float fsigmoid(float x) { return __builtin_amdgcn_rcpf(1.0f + __expf(-x)); }
__device__ __forceinline__ f32x4 silu4(f32x4 v) { f32x4 o; o[0] = v[0] * fsigmoid(v[0]); o[1] = v[1] * fsigmoid(v[1]); o[2] = v[2] * fsigmoid(v[2]); o[3] = v[3] * fsigmoid(v[3]); return o; }
__device__ __forceinline__ f32x4 sigm4(f32x4 v) { f32x4 o; o[0] = fsigmoid(v[0]); o[1] = fsigmoid(v[1]); o[2] = fsigmoid(v[2]); o[3] = fsigmoid(v[3]); return o; }

template <class F> struct Epi8 {
    static constexpr bool PERM = true, AFTER_DRAIN = false;
    F f;
    __device__ __forceinline__ void operator()(const f32x4 (&acc)[2][2][4][2], const Unit& u, int wr, int wc, int fr, int fq) const {
        const int col = u.pn * BM + wc * 32 + 8 * fq;
#pragma unroll
        for (int ai = 0; ai < 2; ++ai)
#pragma unroll
            for (int m = 0; m < 4; ++m) { const int row = u.pm * BM + ai * HALF + wr * 64 + m * 16 + fr;
                f.apply(row, col, acc[ai][0][m][0], acc[ai][0][m][1], acc[ai][1][m][0], acc[ai][1][m][1]); }
    }
};
struct FProj {
    bf16_t* proj; float* bg;
    __device__ __forceinline__ void one(int row, int c, f32x4 v0, f32x4 v1) const {
        if (c >= 4096) { if (c < 4112) { float* p = bg + (size_t)row * 16 + (c - 4096); *(f32x4*)p = v0; *(f32x4*)(p + 4) = v1; } return; }
        const int seg = c >> 9, cs = c & 511;
        if (seg == 2) { v0 = silu4(v0); v1 = silu4(v1); }
        if (seg == 7) { v0 = sigm4(v0); v1 = sigm4(v1); }
        *(u32x4*)(proj + (size_t)seg * ((size_t)M * 512) + (size_t)row * 512 + cs) = pack8(v0, v1);
    }
    __device__ __forceinline__ void apply(int row, int col, f32x4 a0, f32x4 a1, f32x4 b0, f32x4 b1) const { one(row, col, a0, a1); one(row, col + 128, b0, b1); }
};
struct FStore {
    bf16_t* O; int ld;
    __device__ __forceinline__ void apply(int row, int col, f32x4 a0, f32x4 a1, f32x4 b0, f32x4 b1) const {
        bf16_t* p = O + (size_t)row * ld + col; *(u32x4*)p = pack8(a0, a1); *(u32x4*)(p + 128) = pack8(b0, b1); }
};
struct FSwiglu {
    bf16_t* act;
    __device__ __forceinline__ void apply(int row, int col, f32x4 a0, f32x4 a1, f32x4 b0, f32x4 b1) const {
        const int hc = (col >> 8) * 128 + (col & 255);
        *(u32x4*)(act + (size_t)row * DFF + hc) = pack8(silu4(a0) * b0, silu4(a1) * b1); }
};
struct FQkv {
    bf16_t *q, *k, *v;
    __device__ __forceinline__ void one(int row, int c, f32x4 v0, f32x4 v1) const {
        bf16_t* p = c < 1024 ? q + (size_t)row * 1024 + c : (c < 1280 ? k + (size_t)row * 256 + (c - 1024) : v + (size_t)row * 256 + (c - 1280));
        *(u32x4*)p = pack8(v0, v1); }
    __device__ __forceinline__ void apply(int row, int col, f32x4 a0, f32x4 a1, f32x4 b0, f32x4 b1) const { one(row, col, a0, a1); one(row, col + 128, b0, b1); }
};

template <class Epi, class Sched, bool ALIGN_EPI = false, bool SP2 = false>
__device__ __forceinline__ void gemm_phase(PG8_LAS unsigned char* lds, const Gemm g, const Sched& S, const Epi& E) {
    const int tid = threadIdx.x, wid = __builtin_amdgcn_readfirstlane(tid >> 6), lane = tid & 63, wr = wid >> 2, wc = wid & 3, fr = lane & 15, fq = lane >> 4;
    const int K = g.K, nt = K / BK;
    unsigned voffA[2], voffB[2];
#pragma unroll
    for (int i = 0; i < 2; ++i) { int R, C; stage_rc(tid * 16 + i * 8192, R, C); const int Rb = Epi::PERM ? ((R & ~31) + perm32(R & 31)) : R;
        voffA[i] = (unsigned)(R * K + C) * 2u; voffB[i] = (unsigned)(Rb * K + C) * 2u; }
    const size_t kstep = (size_t)(BK * 2);
    const size_t hstep = (size_t)HALF * K * 2;
    const size_t tstep = 2 * hstep;
    const unsigned ldsw = (unsigned)wid * 1024u;
    const int aoff = lds_byte(wr * 64 + fr, fq * 8), boff = lds_byte(wc * 32 + fr, fq * 8);
#define PG8_SA(b, h) (((b) * 2 + (h)) * HTB)
#define PG8_SB(b, h) ((4 + (b) * 2 + (h)) * HTB)
#define PG8_STAGE(bufoff, gbase, voff) do { _Pragma("unroll") for (int _i = 0; _i < 2; ++_i) \
        __builtin_amdgcn_global_load_lds((const unsigned*)((const char*)(gbase) + (voff)[_i]), (PG8_LAS unsigned*)(lds + (bufoff) + ldsw + _i * 8192), 16, 0, 0); } while (0)
#define PG8_LDA(dst, b, h) do { _Pragma("unroll") for (int m = 0; m < 4; ++m) _Pragma("unroll") for (int k = 0; k < 2; ++k) dst[m][k] = *(const PG8_LAS bf16x8*)(lds + PG8_SA(b, h) + aoff + m * 2048 + k * 1024); } while (0)
#define PG8_LDB(dst, b, h) do { _Pragma("unroll") for (int n = 0; n < 2; ++n) _Pragma("unroll") for (int k = 0; k < 2; ++k) dst[n][k] = *(const PG8_LAS bf16x8*)(lds + PG8_SB(b, h) + boff + n * 2048 + k * 1024); } while (0)
#define PG8_MMA(ai, bj, At, Bt) do { __builtin_amdgcn_s_setprio(1); _Pragma("unroll") for (int m = 0; m < 4; ++m) _Pragma("unroll") for (int n = 0; n < 2; ++n) _Pragma("unroll") for (int k = 0; k < 2; ++k) \
        acc[ai][bj][m][n] = __builtin_amdgcn_mfma_f32_16x16x32_bf16(Bt[n][k], At[m][k], acc[ai][bj][m][n], 0, 0, 0); __builtin_amdgcn_s_setprio(0); } while (0)
#define PG8_WAIT_V(n) asm volatile("s_waitcnt vmcnt(" #n ")" ::: "memory")
#define PG8_WAIT_L(n) asm volatile("s_waitcnt lgkmcnt(" #n ")" ::: "memory")
#define PG8_BAR __builtin_amdgcn_s_barrier()
#define PG8_SCHED __builtin_amdgcn_sched_barrier(0)
    Unit cur, nxt; int ui = 0;
    if (!S.next(0, cur)) return;
    f32x4 acc[2][2][4][2];
#pragma unroll
    for (int a = 0; a < 2; ++a)
#pragma unroll
        for (int b = 0; b < 2; ++b)
#pragma unroll
            for (int m = 0; m < 4; ++m)
#pragma unroll
                for (int n = 0; n < 2; ++n) acc[a][b][m][n] = (f32x4){0.f, 0.f, 0.f, 0.f};
    bf16x8 At[4][2], B0[2][2], B1[2][2];
    const char* cA = (const char*)g.A + (size_t)cur.pm * tstep; const char* cB = (const char*)g.Bt + (size_t)cur.pn * tstep;
    S.a_ready(cur);
    if constexpr (SP2) {
        PG8_STAGE(PG8_SB(0, 0), cB, voffB); PG8_STAGE(PG8_SB(0, 1), cB + hstep, voffB); PG8_STAGE(PG8_SA(0, 0), cA, voffA); PG8_STAGE(PG8_SA(0, 1), cA + hstep, voffA);
        if (wr == 1) PG8_BAR;
        PG8_WAIT_V(2); PG8_BAR;
        PG8_STAGE(PG8_SB(1, 0), cB + kstep, voffB); PG8_STAGE(PG8_SA(1, 0), cA + kstep, voffA); PG8_STAGE(PG8_SB(1, 1), cB + hstep + kstep, voffB);
        PG8_WAIT_V(6); PG8_BAR;
    } else {
        PG8_STAGE(PG8_SB(0, 0), cB, voffB); PG8_STAGE(PG8_SA(0, 0), cA, voffA); PG8_STAGE(PG8_SB(0, 1), cB + hstep, voffB); PG8_STAGE(PG8_SA(0, 1), cA + hstep, voffA);
        if (wr == 1) PG8_BAR;
        PG8_WAIT_V(4); PG8_BAR;
        PG8_STAGE(PG8_SB(1, 0), cB + kstep, voffB); PG8_STAGE(PG8_SA(1, 0), cA + kstep, voffA); PG8_STAGE(PG8_SB(1, 1), cB + hstep + kstep, voffB);
        PG8_WAIT_V(6); PG8_BAR;
    }
    for (;;) {
        const bool has_next = S.next(ui + 1, nxt);
        const char* nA = has_next ? (const char*)g.A + (size_t)nxt.pm * tstep : cA; const char* nB = has_next ? (const char*)g.Bt + (size_t)nxt.pn * tstep : cB;
        for (int t = 0; t < nt; t += 2) {
            const bool last = (t == nt - 2);
            const char* a1 = cA + (size_t)(t + 1) * kstep;
            const char* a2 = last ? nA : cA + (size_t)(t + 2) * kstep; const char* b2 = last ? nB : cB + (size_t)(t + 2) * kstep;
            const char* a3 = a2 + kstep; const char* b3 = b2 + kstep;
            if (last && has_next) S.a_ready(nxt);
            if constexpr (SP2) {
            PG8_LDB(B0, 0, 0); PG8_LDB(B1, 0, 1); PG8_SCHED; PG8_LDA(At, 0, 0); PG8_STAGE(PG8_SA(1, 1), a1 + hstep, voffA);
            PG8_WAIT_V(8); PG8_WAIT_L(0); PG8_BAR; PG8_MMA(0, 0, At, B0); PG8_MMA(0, 1, At, B1); PG8_BAR; PG8_SCHED;
            PG8_LDA(At, 0, 1); PG8_STAGE(PG8_SB(0, 0), b2, voffB); PG8_STAGE(PG8_SB(0, 1), b2 + hstep, voffB); PG8_STAGE(PG8_SA(0, 0), a2, voffA);
            PG8_WAIT_V(8); PG8_WAIT_L(0); PG8_BAR; PG8_MMA(1, 0, At, B0); PG8_MMA(1, 1, At, B1); PG8_BAR; PG8_SCHED;
            PG8_LDB(B0, 1, 0); PG8_LDB(B1, 1, 1); PG8_SCHED; PG8_LDA(At, 1, 0); PG8_STAGE(PG8_SA(0, 1), a2 + hstep, voffA);
            PG8_WAIT_V(8); PG8_WAIT_L(0); PG8_BAR; PG8_MMA(0, 0, At, B0); PG8_MMA(0, 1, At, B1); PG8_BAR; PG8_SCHED;
            PG8_LDA(At, 1, 1); PG8_STAGE(PG8_SB(1, 0), b3, voffB); PG8_STAGE(PG8_SB(1, 1), b3 + hstep, voffB); PG8_STAGE(PG8_SA(1, 0), a3, voffA);
            PG8_WAIT_V(8); PG8_WAIT_L(0); PG8_BAR; PG8_MMA(1, 0, At, B0); PG8_MMA(1, 1, At, B1); PG8_BAR; PG8_SCHED;
            } else {
            PG8_LDB(B0, 0, 0); PG8_SCHED; PG8_LDA(At, 0, 0); PG8_STAGE(PG8_SA(1, 1), a1 + hstep, voffA);
            PG8_WAIT_L(8); PG8_BAR; PG8_WAIT_L(0); PG8_MMA(0, 0, At, B0); PG8_BAR; PG8_SCHED;
            PG8_LDB(B1, 0, 1); PG8_STAGE(PG8_SB(0, 0), b2, voffB);
            PG8_BAR; PG8_WAIT_L(0); PG8_MMA(0, 1, At, B1); PG8_BAR;
            PG8_LDA(At, 0, 1); PG8_STAGE(PG8_SA(0, 0), a2, voffA);
            PG8_BAR; PG8_WAIT_L(0); PG8_MMA(1, 0, At, B0); PG8_BAR; PG8_SCHED;
            PG8_STAGE(PG8_SB(0, 1), b2 + hstep, voffB);
            PG8_WAIT_V(6); PG8_BAR; PG8_MMA(1, 1, At, B1); PG8_BAR;
            PG8_LDB(B0, 1, 0); PG8_SCHED; PG8_LDA(At, 1, 0); PG8_STAGE(PG8_SA(0, 1), a2 + hstep, voffA);
            PG8_WAIT_L(8); PG8_BAR; PG8_WAIT_L(0); PG8_MMA(0, 0, At, B0); PG8_BAR; PG8_SCHED;
            PG8_LDB(B1, 1, 1); PG8_STAGE(PG8_SB(1, 0), b3, voffB);
            PG8_BAR; PG8_WAIT_L(0); PG8_MMA(0, 1, At, B1); PG8_BAR;
            PG8_LDA(At, 1, 1); PG8_STAGE(PG8_SA(1, 0), a3, voffA);
            PG8_BAR; PG8_WAIT_L(0); PG8_MMA(1, 0, At, B0); PG8_BAR; PG8_SCHED;
            PG8_STAGE(PG8_SB(1, 1), b3 + hstep, voffB);
            PG8_WAIT_V(6); PG8_BAR; PG8_MMA(1, 1, At, B1); PG8_BAR;
            }
        }
        if constexpr (ALIGN_EPI) { if (wr == 0) PG8_BAR; }
        if constexpr (!Epi::AFTER_DRAIN) { E(acc, cur, wr, wc, fr, fq); S.done(cur); }
        if (!has_next) break;
#pragma unroll
        for (int a = 0; a < 2; ++a)
#pragma unroll
            for (int b = 0; b < 2; ++b)
#pragma unroll
                for (int m = 0; m < 4; ++m)
#pragma unroll
                    for (int n = 0; n < 2; ++n) acc[a][b][m][n] = (f32x4){0.f, 0.f, 0.f, 0.f};
        cur = nxt; cA = nA; cB = nB; ++ui;
        if constexpr (ALIGN_EPI) { if (wr == 1) PG8_BAR; }
    }
    PG8_WAIT_V(0);
    if constexpr (!ALIGN_EPI) { if (wr == 0) PG8_BAR; }
    PG8_BAR;
    if constexpr (Epi::AFTER_DRAIN) { E.fused(acc, cur, wr, wc, fr, fq, lds, wid, lane); S.done(cur); }
#undef PG8_SA
#undef PG8_SB
#undef PG8_STAGE
#undef PG8_LDA
#undef PG8_LDB
#undef PG8_MMA
#undef PG8_WAIT_V
#undef PG8_WAIT_L
#undef PG8_BAR
#undef PG8_SCHED
}
}

namespace attn {
typedef unsigned short bf16;
using bf16x8 = __attribute__((ext_vector_type(8))) short;
using s16x4  = __attribute__((ext_vector_type(4))) short;
using f32x16 = __attribute__((ext_vector_type(16))) float;
using u32x4  = __attribute__((ext_vector_type(4))) unsigned;
constexpr int D = 128, NW = 8, QBLK = 32, KVBLK = 64;
constexpr float SCALE = 0.088388347648318440f;
constexpr float THR = 8.f;
constexpr int LDQ = 1024, LDK = 256, LDO = 1024;
constexpr size_t SHM_V = KVBLK * D * 2, SHM_K = KVBLK * D * 2, SHM_ATTN = 2 * SHM_V + 2 * SHM_K + NW * 64 * 4;
#define KSWZ(row, colB) ((row) * 256 + ((colB) ^ (((row) & 7) << 4)))
#define SBAR() __builtin_amdgcn_sched_barrier(0)
__device__ __forceinline__ int crow(int r, int hi) { return (r & 3) + 8 * (r >> 2) + 4 * hi; }
__device__ __forceinline__ unsigned cvtpk(float lo, float hi) { unsigned r; asm volatile("v_cvt_pk_bf16_f32 %0, %1, %2" : "=v"(r) : "v"(lo), "v"(hi)); return r; }
__device__ __forceinline__ bf16x8 ld8(const bf16* p) { return *reinterpret_cast<const bf16x8*>(p); }

__device__ __forceinline__ void partialSM(f32x16& p0, f32x16& p1, float& m_reg, float& mn, float& alpha) {
  constexpr float C = SCALE * 1.4426950408889634f;
  float pmax = p0[0]; for (int r = 1; r < 16; ++r) pmax = fmaxf(pmax, p0[r]); for (int r = 0; r < 16; ++r) pmax = fmaxf(pmax, p1[r]);
  { auto rr = __builtin_amdgcn_permlane32_swap(__float_as_uint(pmax), __float_as_uint(pmax), false, false);
    pmax = fmaxf(__uint_as_float(rr[0]), __uint_as_float(rr[1])); }
  if (__builtin_expect(__all(pmax - m_reg <= THR / SCALE), 1)) { mn = m_reg; alpha = 1.f; }
  else { mn = fmaxf(m_reg, pmax); alpha = __builtin_amdgcn_exp2f((m_reg - mn) * C); m_reg = mn; }
  float mnC = -mn * C;
  for (int r = 0; r < 16; ++r) p0[r] = fmaf(p0[r], C, mnC); for (int r = 0; r < 16; ++r) p1[r] = fmaf(p1[r], C, mnC);
  for (int r = 0; r < 16; ++r) p0[r] = __builtin_amdgcn_exp2f(p0[r]);
}
__device__ __forceinline__ void finishSM(f32x16& p0, f32x16& p1, float alpha, float& l_reg, bf16x8& pa0, bf16x8& pa1, bf16x8& pa2, bf16x8& pa3) {
  for (int r = 0; r < 16; ++r) p1[r] = __builtin_amdgcn_exp2f(p1[r]);
  float ps = 0; for (int r = 0; r < 16; ++r) ps += p0[r]; for (int r = 0; r < 16; ++r) ps += p1[r];
  { auto rr = __builtin_amdgcn_permlane32_swap(__float_as_uint(ps), __float_as_uint(ps), false, false);
    ps = __uint_as_float(rr[0]) + __uint_as_float(rr[1]); }
  l_reg = l_reg * alpha + ps;
#define PK4(P, BASE, OUT) do { unsigned a0 = cvtpk(P[BASE + 0], P[BASE + 1]), a1 = cvtpk(P[BASE + 2], P[BASE + 3]);   \
    unsigned b0 = cvtpk(P[BASE + 4], P[BASE + 5]), b1 = cvtpk(P[BASE + 6], P[BASE + 7]);                              \
    auto r0 = __builtin_amdgcn_permlane32_swap(a0, b0, false, false); auto r1 = __builtin_amdgcn_permlane32_swap(a1, b1, false, false); \
    u32x4 w = {r0[0], r1[0], r0[1], r1[1]}; OUT = *reinterpret_cast<bf16x8*>(&w); } while (0)
  PK4(p0, 0, pa0); PK4(p0, 8, pa1); PK4(p1, 0, pa2); PK4(p1, 8, pa3);
#undef PK4
}
__device__ __forceinline__ void qkt(f32x16& p0, f32x16& p1, const bf16* Ks, const bf16x8* qr, int r32, int hi) {
  p0 = f32x16{}; p1 = f32x16{};
  for (int d0 = 0; d0 < 8; ++d0) { int cb = (d0 * 16 + hi * 8) * 2;
    bf16x8 b0 = *reinterpret_cast<const bf16x8*>((const char*)Ks + KSWZ(r32, cb));
    bf16x8 b1 = *reinterpret_cast<const bf16x8*>((const char*)Ks + KSWZ(32 + r32, cb));
    p0 = __builtin_amdgcn_mfma_f32_32x32x16_bf16(b0, qr[d0], p0, 0, 0, 0);
    p1 = __builtin_amdgcn_mfma_f32_32x32x16_bf16(b1, qr[d0], p1, 0, 0, 0); }
}
__device__ __forceinline__ int v_st(int k, int c) { const int kk = (k & ~0xC) | ((k & 4) << 1) | ((k & 8) >> 1); return ((kk >> 3) * 4 + (c >> 5)) * 512 + ((kk & 7) * 32 + (c & 31)) * 2; }
__device__ __forceinline__ int v_rd_base(int lane) { return ((lane & 3) << 3) | (((lane >> 2) & 3) << 6) | (((lane >> 4) & 1) << 5) | (((lane >> 5) & 1) << 8); }
constexpr int v_rd_off(int d0, int ks, int half) { return d0 * 512 + ks * 4096 + half * 2048; }
template <int OFF> __device__ __forceinline__ s16x4 tr_read(int vb) {
  s16x4 r; asm volatile("ds_read_b64_tr_b16 %0, %1 offset:%2" : "=&v"(r) : "v"(vb), "i"(OFF) : "memory"); return r;
}
template <int D0> __device__ __forceinline__ void pv_one(f32x16& od, int vb, bf16x8 pa0, bf16x8 pa1, bf16x8 pa2, bf16x8 pa3) {
  const s16x4 l0 = tr_read<v_rd_off(D0, 0, 0)>(vb), h0 = tr_read<v_rd_off(D0, 0, 1)>(vb), l1 = tr_read<v_rd_off(D0, 1, 0)>(vb), h1 = tr_read<v_rd_off(D0, 1, 1)>(vb);
  const s16x4 l2 = tr_read<v_rd_off(D0, 2, 0)>(vb), h2 = tr_read<v_rd_off(D0, 2, 1)>(vb), l3 = tr_read<v_rd_off(D0, 3, 0)>(vb), h3 = tr_read<v_rd_off(D0, 3, 1)>(vb);
  asm volatile("s_waitcnt lgkmcnt(0)" ::: "memory"); SBAR();
#define PK(L, H) (bf16x8){L[0], L[1], L[2], L[3], H[0], H[1], H[2], H[3]}
  od = __builtin_amdgcn_mfma_f32_32x32x16_bf16(pa0, PK(l0, h0), od, 0, 0, 0);
  od = __builtin_amdgcn_mfma_f32_32x32x16_bf16(pa1, PK(l1, h1), od, 0, 0, 0);
  od = __builtin_amdgcn_mfma_f32_32x32x16_bf16(pa2, PK(l2, h2), od, 0, 0, 0);
  od = __builtin_amdgcn_mfma_f32_32x32x16_bf16(pa3, PK(l3, h3), od, 0, 0, 0);
#undef PK
}
__device__ __forceinline__ void pv_d0(f32x16* o, int vb, bf16x8 pa0, bf16x8 pa1, bf16x8 pa2, bf16x8 pa3) {
  pv_one<0>(o[0], vb, pa0, pa1, pa2, pa3); pv_one<1>(o[1], vb, pa0, pa1, pa2, pa3); pv_one<2>(o[2], vb, pa0, pa1, pa2, pa3); pv_one<3>(o[3], vb, pa0, pa1, pa2, pa3);
}
__device__ __forceinline__ void attn_dense_body(const bf16* __restrict__ Qb, const bf16* __restrict__ Kh, const bf16* __restrict__ Vh,
                                                bf16* __restrict__ Ob, int seq, char* lds) {
  constexpr int SDEPTH = 2;
  const int tid = threadIdx.x, wid = tid >> 6, lane = tid & 63, r32 = lane & 31, hi = lane >> 5;
  bf16* V_lds = (bf16*)lds; bf16* K_lds = (bf16*)(lds + 2 * SHM_V);
  float* ws = (float*)(lds + 2 * SHM_V + 2 * SHM_K) + wid * 64; float* li_l = ws; float* al_l = ws + 32;
  float m_reg = -1e30f, l_reg = 0; f32x16 o[4] = {}; bf16x8 qr[8];
  const bf16* Qw = Qb + (long)(wid * QBLK + r32) * LDQ + hi * 8;
#pragma unroll
  for (int d0 = 0; d0 < 8; ++d0) qr[d0] = ld8(Qw + d0 * 16);
  const int sr = tid >> 4, sc = (tid & 15) * 8, vst0 = v_st(sr, sc), vst1 = v_st(32 + sr, sc);
  const int vb0 = (int)(uintptr_t)V_lds + v_rd_base(lane);
  struct { bf16x8 vs0, vs1, ks0, ks1; } sr_[SDEPTH];
#define SLOAD(i, k0) do { sr_[i].vs0 = ld8(&Vh[(long)((k0) + sr) * LDK + sc]); sr_[i].vs1 = ld8(&Vh[(long)((k0) + 32 + sr) * LDK + sc]); \
    sr_[i].ks0 = ld8(&Kh[(long)((k0) + sr) * LDK + sc]); sr_[i].ks1 = ld8(&Kh[(long)((k0) + 32 + sr) * LDK + sc]); } while (0)
#define SWRITE(b, i) do { *(bf16x8*)((char*)V_lds + (b) * SHM_V + vst0) = sr_[i].vs0;          \
    *(bf16x8*)((char*)V_lds + (b) * SHM_V + vst1) = sr_[i].vs1; int kc = sc * 2;               \
    *(bf16x8*)((char*)K_lds + (b) * SHM_K + KSWZ(sr, kc)) = sr_[i].ks0;                       \
    *(bf16x8*)((char*)K_lds + (b) * SHM_K + KSWZ(32 + sr, kc)) = sr_[i].ks1; } while (0)
#define SWAIT() do { asm volatile("s_waitcnt vmcnt(4)" ::: "memory"); } while (0)
#define RESC(a) do { if (__any((a) < 1.f)) { if (hi == 0) al_l[r32] = (a); asm volatile("s_waitcnt lgkmcnt(0)" ::: "memory"); \
    for (int d = 0; d < 4; ++d) for (int r = 0; r < 16; ++r) o[d][r] *= al_l[crow(r, hi)]; } } while (0)
  f32x16 pA0, pA1, pB0, pB1; float mnA, mnB, alA, alB; bf16x8 pa0, pa1, pa2, pa3; const int NT = seq / KVBLK;
  constexpr int SE = 0, SO = SDEPTH - 1;
  SLOAD(SE, 0); asm volatile("s_waitcnt vmcnt(0)" ::: "memory"); SWRITE(0, SE); __syncthreads();
  qkt(pA0, pA1, K_lds, qr, r32, hi); partialSM(pA0, pA1, m_reg, mnA, alA);
  SLOAD(SO, KVBLK); if (2 < NT) SLOAD(SE, 2 * KVBLK);
  SWAIT(); SWRITE(1, SO); __syncthreads();
  for (int j = 1; j + 1 < NT; j += 2) {
    SBAR(); qkt(pB0, pB1, (bf16*)((char*)K_lds + SHM_K), qr, r32, hi);
    finishSM(pA0, pA1, alA, l_reg, pa0, pa1, pa2, pa3); SBAR();
    SLOAD(SO, (j + SDEPTH) * KVBLK); SBAR();
    pv_d0(o, vb0, pa0, pa1, pa2, pa3); partialSM(pB0, pB1, m_reg, mnB, alB);
    __syncthreads(); SWAIT(); SWRITE(0, SE);
    RESC(alB); __syncthreads();
    SBAR(); qkt(pA0, pA1, K_lds, qr, r32, hi);
    finishSM(pB0, pB1, alB, l_reg, pa0, pa1, pa2, pa3); SBAR();
    if (j + 3 < NT) SLOAD(SE, (j + 1 + SDEPTH) * KVBLK); SBAR();
    pv_d0(o, vb0 + (int)SHM_V, pa0, pa1, pa2, pa3); partialSM(pA0, pA1, m_reg, mnA, alA);
    __syncthreads(); SWAIT(); SWRITE(1, SO);
    RESC(alA); __syncthreads();
  }
  SBAR(); qkt(pB0, pB1, (bf16*)((char*)K_lds + SHM_K), qr, r32, hi);
  finishSM(pA0, pA1, alA, l_reg, pa0, pa1, pa2, pa3); SBAR();
  pv_d0(o, vb0, pa0, pa1, pa2, pa3); partialSM(pB0, pB1, m_reg, mnB, alB);
  __syncthreads(); RESC(alB);
  finishSM(pB0, pB1, alB, l_reg, pa0, pa1, pa2, pa3); SBAR();
  pv_d0(o, vb0 + (int)SHM_V, pa0, pa1, pa2, pa3);
  if (hi == 0) li_l[r32] = l_reg; asm volatile("s_waitcnt lgkmcnt(0)" ::: "memory");
  float rli[16];
#pragma unroll
  for (int r = 0; r < 16; ++r) rli[r] = __builtin_amdgcn_rcpf(li_l[crow(r, hi)]);
  bf16* Ow = Ob + (long)(wid * QBLK) * LDO;
#pragma unroll
  for (int r = 0; r < 16; ++r) { int orow = crow(r, hi);
    for (int d0 = 0; d0 < 4; ++d0) { const float v = o[d0][r] * rli[r]; const unsigned u = __float_as_uint(v);
      Ow[(long)orow * LDO + d0 * 32 + r32] = (bf16)((u + 0x7fffu + ((u >> 16) & 1u)) >> 16); } }
#undef SLOAD
#undef SWRITE
#undef SWAIT
#undef RESC
}
#undef KSWZ
#undef SBAR
}

#define LAS __attribute__((address_space(3)))
typedef unsigned short bf16;
typedef unsigned v4u __attribute__((ext_vector_type(4)));
typedef unsigned v2u __attribute__((ext_vector_type(2)));
typedef float f32x4 __attribute__((ext_vector_type(4)));
typedef float f32x2 __attribute__((ext_vector_type(2)));

constexpr size_t HM = 1u << 19;
constexpr size_t WS_MOD = 2 * HM;
constexpr size_t WS_WAB = 4 * HM, WS_WABO = 21 * HM, WS_WFI0 = 25 * HM, WS_WFI1 = 47 * HM, WS_WFO0 = 69 * HM, WS_WFO1 = 80 * HM, WS_WQKV = 91 * HM, WS_WAO = 97 * HM;
constexpr size_t WS_XCTX = 102 * HM;
constexpr size_t WS_H = 110 * HM;
constexpr size_t WS_PROJ = 178 * HM;
constexpr size_t SEG = (size_t)M * 512;
constexpr size_t WS_ACT = 178 * HM;
constexpr size_t WS_Q = 178 * HM, WS_K = 246 * HM, WS_V = 263 * HM;
constexpr size_t WS_OG = 280 * HM;
constexpr size_t WS_Y = 382 * HM;
constexpr size_t WS_BG = 450 * HM;
constexpr size_t WS_SXH = 456 * HM, WS_SXM = 469 * HM, WS_GXH = 476 * HM, WS_NXM = 477 * HM, WS_MXM = 478 * HM;
constexpr size_t WS_END = 512 * HM;
static_assert(WS_BG + (size_t)M * 16 * 4 <= WS_END && WS_Y + (size_t)M * DM * 2 <= WS_BG && WS_PROJ + 8 * SEG * 2 == WS_BG, "ws map");
static_assert(WS_ACT + (size_t)M * DFF * 2 <= WS_Y && WS_V + (size_t)M * 256 * 2 <= WS_OG && WS_OG + (size_t)M * DM * 2 <= WS_Y, "ws map 2");

constexpr int LDS_BYTES = 147456;

__device__ __forceinline__ unsigned f2bf(float f) { unsigned u = __builtin_bit_cast(unsigned, f); return (u + 0x7fffu + ((u >> 16) & 1u)) >> 16; }
__device__ __forceinline__ unsigned pk2(float lo, float hi) { return f2bf(lo) | (f2bf(hi) << 16); }
__device__ __forceinline__ float bf2f(unsigned short h) { return __builtin_bit_cast(float, (unsigned)h << 16); }
__device__ __forceinline__ float bflo(unsigned w) { return __builtin_bit_cast(float, w << 16); }
__device__ __forceinline__ float bfhi(unsigned w) { return __builtin_bit_cast(float, w & 0xffff0000u); }
__device__ __forceinline__ float wave_sum(float v) {
#pragma unroll
    for (int o = 1; o < 64; o <<= 1) v += __shfl_xor(v, o);
    return v;
}
__device__ __forceinline__ float sigmoidf_(float x) { return 1.0f / (1.0f + __expf(-x)); }

struct Frame {
    LAS unsigned char* lds;
    int tid, lane, wave, G;
    const float* in[18]; float* out; unsigned char* ws;
    float* MOD; float* XCTX; bf16* H; bf16* PROJ; float* BG; bf16* OG; bf16* Y; bf16* ACT; bf16 *Q, *K, *V;
    bf16 *WAB, *WABO, *WFI0, *WFI1, *WFO0, *WFO1, *WQKV, *WAO;
};
enum { I_X = 0, I_C, I_CTX, I_CCTX, I_ADAW, I_ADAB, I_NORMG, I_FWIN, I_FWOUT, I_ABWIN, I_CONV, I_GATEB, I_LB, I_OUTG, I_ABWOUT, I_WQKV, I_QKG, I_AWOUT };

__device__ __forceinline__ int drow_of(int mode, int n0) { if (mode == 0) return n0; const int j = n0 < DFF ? n0 : n0 - DFF; return (j >> 7) * 256 + (n0 < DFF ? 0 : 128) + (j & 127); }
__device__ __forceinline__ void p0_transpose_item(const float* W, int K, int N, bf16* WT, int mode, LAS float* scr, int item, int lane) {
    const int nblk = (N + 31) / 32, kb = item / nblk, nb = item % nblk, k0 = 64 * kb, n0 = 32 * nb;
    const int n = n0 + (lane & 31); const bool ok = n < N;
    float tv[32];
#pragma unroll
    for (int i = 0; i < 32; ++i) { const int kk = 2 * i + (lane >> 5); tv[i] = ok ? W[(size_t)(k0 + kk) * N + n] : 0.f; }
#pragma unroll
    for (int i = 0; i < 32; ++i) { const int kk = 2 * i + (lane >> 5); scr[kk * 33 + (lane & 31)] = tv[i]; }
    asm volatile("s_waitcnt lgkmcnt(0)" ::: "memory");
    const int c = lane & 7; const int dr = drow_of(mode, n0);
#pragma unroll
    for (int j = 0; j < 4; ++j) { const int nn = (lane >> 3) + 8 * j; const LAS float* s = scr + (8 * c) * 33 + nn;
        v4u o; o.x = pk2(s[0 * 33], s[1 * 33]); o.y = pk2(s[2 * 33], s[3 * 33]); o.z = pk2(s[4 * 33], s[5 * 33]); o.w = pk2(s[6 * 33], s[7 * 33]);
        *(v4u*)(WT + (size_t)(dr + nn) * K + k0 + 8 * c) = o; }
    asm volatile("s_waitcnt lgkmcnt(0)" ::: "memory");
}
__device__ __forceinline__ void p0_prologue(Frame& F) {
    const int tid = F.tid, lane = F.lane, w = F.wave;
    if (blockIdx.x < 96) {
        LAS float* sc = (LAS float*)F.lds; LAS float* part = sc + 5120;
        for (int i = tid; i < 5120; i += 512) { const int j = i >> 10, k = i & 1023; const float v = j < 4 ? F.in[I_C][j * 1024 + k] : F.in[I_CCTX][k]; sc[i] = v * sigmoidf_(v); }
        __syncthreads();
        const int l = blockIdx.x / 48, col0 = (blockIdx.x % 48) * 128;
        const float* wp = F.in[I_ADAW] + ((size_t)l * 1024 + 128 * w) * 6144 + col0 + 2 * lane;
        float acc[5][2];
#pragma unroll
        for (int j = 0; j < 5; ++j) { acc[j][0] = 0.f; acc[j][1] = 0.f; }
        for (int k0 = 0; k0 < 128; k0 += 32) { f32x2 wv[32];
#pragma unroll
            for (int kk = 0; kk < 32; ++kk) wv[kk] = *(const f32x2*)(wp + (size_t)(k0 + kk) * 6144);
#pragma unroll
            for (int kk = 0; kk < 32; ++kk) {
#pragma unroll
                for (int j = 0; j < 5; ++j) { const float s = sc[j * 1024 + 128 * w + k0 + kk]; acc[j][0] += s * wv[kk].x; acc[j][1] += s * wv[kk].y; } } }
#pragma unroll
        for (int j = 0; j < 5; ++j) { part[(w * 5 + j) * 128 + 2 * lane] = acc[j][0]; part[(w * 5 + j) * 128 + 2 * lane + 1] = acc[j][1]; }
        __syncthreads();
        for (int i = tid; i < 640; i += 512) { const int j = i >> 7, cc = i & 127; float s = 0.f;
#pragma unroll
            for (int ww = 0; ww < 8; ++ww) s += part[(ww * 5 + j) * 128 + cc];
            F.MOD[(size_t)(l * 5 + j) * 6144 + col0 + cc] = s + F.in[I_ADAB][l * 6144 + col0 + cc]; }
        __syncthreads();
    }
    LAS float* scr = (LAS float*)(F.lds + w * 16384);
    const int gw = blockIdx.x * 8 + w, NGW = F.G * 8;
    constexpr int I_AB = 16 * 129, I_ABO = 16 * 32, I_FI = 16 * 176, I_FO = 44 * 32, I_QK = 16 * 48, I_AO = 16 * 32;
    constexpr int NITEMS = I_AB + I_ABO + 2 * I_FI + 2 * I_FO + I_QK + I_AO;
    for (int it = gw; it < NITEMS; it += NGW) {
        int r = it;
        if (r < I_AB) { p0_transpose_item(F.in[I_ABWIN], 1024, NAB, F.WAB, 0, scr, r, lane); continue; } r -= I_AB;
        if (r < I_ABO) { p0_transpose_item(F.in[I_ABWOUT], 1024, 1024, F.WABO, 0, scr, r, lane); continue; } r -= I_ABO;
        if (r < I_FI) { p0_transpose_item(F.in[I_FWIN], 1024, 2 * DFF, F.WFI0, 1, scr, r, lane); continue; } r -= I_FI;
        if (r < I_FI) { p0_transpose_item(F.in[I_FWIN] + (size_t)1024 * 2 * DFF, 1024, 2 * DFF, F.WFI1, 1, scr, r, lane); continue; } r -= I_FI;
        if (r < I_FO) { p0_transpose_item(F.in[I_FWOUT], DFF, 1024, F.WFO0, 0, scr, r, lane); continue; } r -= I_FO;
        if (r < I_FO) { p0_transpose_item(F.in[I_FWOUT] + (size_t)DFF * 1024, DFF, 1024, F.WFO1, 0, scr, r, lane); continue; } r -= I_FO;
        if (r < I_QK) { p0_transpose_item(F.in[I_WQKV], 1024, NQKV, F.WQKV, 0, scr, r, lane); continue; } r -= I_QK;
        p0_transpose_item(F.in[I_AWOUT], 1024, 1024, F.WAO, 0, scr, r, lane);
    }
    { const int gt = blockIdx.x * 512 + tid, NT_ = F.G * 512; const int n16 = (NABP - 4128) * 1024 * 2 / 16; v4u z = {0u, 0u, 0u, 0u};
      for (int i = gt; i < n16; i += NT_) *((v4u*)(F.WAB + (size_t)4128 * 1024) + i) = z; }
}

constexpr int RB = 4;
template <bool HAS_Y, bool WRITE_X, bool HAS_NEXT, bool LAT_ONLY>
__device__ __forceinline__ void rowpass(const Frame& F, const float* xs_lat, const float* xs_ctx, float* xd_lat, float* xd_ctx,
                                        const float* mod_y, int gate_off, const float* gn_y, const float* mod_n, int sh_off, int sc_off, const float* gn_n) {
    const int lane = F.lane, gw = blockIdx.x * 8 + F.wave, NGW = F.G * 8;
    constexpr int NR = LAT_ONLY ? NB * SEQ : M;
    for (int r0 = gw; r0 < NR; r0 += RB * NGW) {
        f32x4 x[RB][4]; v2u yw[RB][4]; int rr[RB], jv[RB]; size_t xo[RB]; bool ok[RB], ic[RB];
#pragma unroll
        for (int q = 0; q < RB; ++q) { const int li = r0 + q * NGW; ok[q] = li < NR; const int lr = ok[q] ? li : r0;
            const int r = LAT_ONLY ? lr + (lr >> 12) * CTX + CTX : lr; const int b = r / TT, tt = r - b * TT; ic[q] = tt < CTX; rr[q] = r; jv[q] = ic[q] ? 4 : b;
            xo[q] = ic[q] ? (size_t)(b * CTX + tt) * DM : (size_t)(b * SEQ + tt - CTX) * DM;
            const float* xs = (ic[q] ? xs_ctx : xs_lat) + xo[q];
            if (ok[q]) {
#pragma unroll
                for (int jj = 0; jj < 4; ++jj) x[q][jj] = *(const f32x4*)(xs + 4 * lane + 256 * jj);
                if (HAS_Y) {
#pragma unroll
                    for (int jj = 0; jj < 4; ++jj) yw[q][jj] = *(const v2u*)(F.Y + (size_t)r * DM + 4 * lane + 256 * jj); } } }
#pragma unroll
        for (int q = 0; q < RB; ++q) { if (!ok[q]) continue;
            const int r = rr[q], j = jv[q];
            if (HAS_Y) {
                f32x4 y[4]; float ss = 0.f;
#pragma unroll
                for (int jj = 0; jj < 4; ++jj) { const v2u w = yw[q][jj];
                    y[jj] = (f32x4){bflo(w.x), bfhi(w.x), bflo(w.y), bfhi(w.y)}; ss += (y[jj][0] * y[jj][0] + y[jj][1] * y[jj][1]) + (y[jj][2] * y[jj][2] + y[jj][3] * y[jj][3]); }
                const float rstd = rsqrtf(wave_sum(ss) * (1.f / DM) + EPS);
#pragma unroll
                for (int jj = 0; jj < 4; ++jj) { const int c = 4 * lane + 256 * jj;
                    const f32x4 g = *(const f32x4*)(mod_y + (size_t)j * 6144 + gate_off + c), gn = *(const f32x4*)(gn_y + c);
                    x[q][jj] = x[q][jj] + g * (y[jj] * rstd * gn); }
            }
            if (WRITE_X) { float* xd = (ic[q] ? xd_ctx : xd_lat) + xo[q];
#pragma unroll
                for (int jj = 0; jj < 4; ++jj) *(f32x4*)(xd + 4 * lane + 256 * jj) = x[q][jj]; }
            if (HAS_NEXT) {
                float ss = 0.f;
#pragma unroll
                for (int jj = 0; jj < 4; ++jj) ss += (x[q][jj][0] * x[q][jj][0] + x[q][jj][1] * x[q][jj][1]) + (x[q][jj][2] * x[q][jj][2] + x[q][jj][3] * x[q][jj][3]);
                const float rstd = rsqrtf(wave_sum(ss) * (1.f / DM) + EPS);
#pragma unroll
                for (int jj = 0; jj < 4; ++jj) { const int c = 4 * lane + 256 * jj;
                    const f32x4 sh = *(const f32x4*)(mod_n + (size_t)j * 6144 + sh_off + c), sc = *(const f32x4*)(mod_n + (size_t)j * 6144 + sc_off + c), gn = *(const f32x4*)(gn_n + c);
                    const f32x4 hv = (x[q][jj] * rstd * gn) * (sc + 1.0f) + sh;
                    v2u o; o.x = pk2(hv[0], hv[1]); o.y = pk2(hv[2], hv[3]);
                    *(v2u*)(F.H + (size_t)r * DM + c) = o; }
            }
        }
    }
}

__device__ __forceinline__ void og_pass(const Frame& F, const bf16* OF, const bf16* OB) {
    const int lane = F.lane, gw = blockIdx.x * 8 + F.wave, NGW = F.G * 8;
    const bf16* GA = F.PROJ + 2 * SEG; const bf16* GB = F.PROJ + 7 * SEG;
    const int c0 = 16 * lane;
    float ogv[16];
#pragma unroll
    for (int i = 0; i < 16; ++i) ogv[i] = F.in[I_OUTG][c0 + i];
    for (int r0 = gw; r0 < M; r0 += RB * NGW) {
        v4u a0[RB], a1[RB], b0[RB], b1[RB], g0[RB], g1[RB]; bool ok[RB];
#pragma unroll
        for (int q = 0; q < RB; ++q) { const int r = r0 + q * NGW; ok[q] = r < M;
            if (ok[q]) { a0[q] = *(const v4u*)(OF + (size_t)r * DM + c0); a1[q] = *(const v4u*)(OF + (size_t)r * DM + c0 + 8);
                b0[q] = *(const v4u*)(OB + (size_t)r * DM + c0); b1[q] = *(const v4u*)(OB + (size_t)r * DM + c0 + 8);
                const bf16* gp = c0 < 512 ? GA + (size_t)r * 512 + c0 : GB + (size_t)r * 512 + (c0 - 512);
                g0[q] = *(const v4u*)gp; g1[q] = *(const v4u*)(gp + 8); } }
#pragma unroll
        for (int q = 0; q < RB; ++q) { if (!ok[q]) continue; const int r = r0 + q * NGW;
            float v[16], gt[16];
#pragma unroll
            for (int i = 0; i < 4; ++i) { v[2 * i] = bflo(a0[q][i]) + bflo(b0[q][i]); v[2 * i + 1] = bfhi(a0[q][i]) + bfhi(b0[q][i]); v[8 + 2 * i] = bflo(a1[q][i]) + bflo(b1[q][i]); v[8 + 2 * i + 1] = bfhi(a1[q][i]) + bfhi(b1[q][i]);
                gt[2 * i] = bflo(g0[q][i]); gt[2 * i + 1] = bfhi(g0[q][i]); gt[8 + 2 * i] = bflo(g1[q][i]); gt[8 + 2 * i + 1] = bfhi(g1[q][i]); }
            float ss = 0.f;
#pragma unroll
            for (int i = 0; i < 16; ++i) ss += v[i] * v[i];
            ss += __shfl_xor(ss, 1); ss += __shfl_xor(ss, 2); ss += __shfl_xor(ss, 4);
            const float rstd = rsqrtf(ss * (1.f / 128.f) + EPS);
            unsigned o[8];
#pragma unroll
            for (int i = 0; i < 8; ++i) o[i] = pk2(v[2 * i] * rstd * ogv[2 * i] * gt[2 * i], v[2 * i + 1] * rstd * ogv[2 * i + 1] * gt[2 * i + 1]);
            *(v4u*)(F.OG + (size_t)r * DM + c0) = (v4u){o[0], o[1], o[2], o[3]}; *(v4u*)(F.OG + (size_t)r * DM + c0 + 8) = (v4u){o[4], o[5], o[6], o[7]};
        }
    }
}

__device__ __forceinline__ void qknorm_pass(const Frame& F) {
    const int lane = F.lane, gw = blockIdx.x * 8 + F.wave, NGW = F.G * 8;
    const float inv = exp2f(-(float)(2 * (lane & 31)) * (13.287712379549449f / 64.f));
    for (int r = gw; r < M; r += NGW) {
        const int b = r / TT, tt = r - b * TT; const bool isctx = tt < CTX;
        float c0 = 1.f, s0 = 0.f, c1 = 1.f, s1 = 0.f;
        if (!isctx) { const int t = tt - CTX; sincosf((float)(t >> 6) * inv, &s0, &c0); sincosf((float)(t & 63) * inv, &s1, &c1); }
        for (int hh = (isctx ? 8 : 0); hh < 10; ++hh) {
            bf16* p = hh < 8 ? F.Q + (size_t)r * 1024 + hh * 128 : F.K + (size_t)r * 256 + (hh - 8) * 128;
            const float* g = F.in[I_QKG] + (hh < 8 ? 0 : 128);
            const float x0 = bf2f(p[lane]), x1 = bf2f(p[64 + lane]);
            const float rstd = rsqrtf(wave_sum(x0 * x0 + x1 * x1) * (1.f / 128.f) + EPS);
            float y0 = x0 * rstd * g[lane], y1 = x1 * rstd * g[64 + lane];
            if (!isctx) { const float p0 = __shfl_xor(y0, 32), p1 = __shfl_xor(y1, 32);
                y0 = lane < 32 ? y0 * c0 - p0 * s0 : y0 * c0 + p0 * s0;
                y1 = lane < 32 ? y1 * c1 - p1 * s1 : y1 * c1 + p1 * s1; }
            p[lane] = (bf16)f2bf(y0); p[64 + lane] = (bf16)f2bf(y1);
        }
    }
}

namespace scan {
typedef short bf16x8 __attribute__((ext_vector_type(8)));
typedef float f32x16 __attribute__((ext_vector_type(16)));
typedef float f32x4 __attribute__((ext_vector_type(4)));
typedef unsigned u32x4 __attribute__((ext_vector_type(4)));
typedef unsigned u32x2 __attribute__((ext_vector_type(2)));
constexpr int NCH = TT / 32;
constexpr int TS = 80;
__device__ __forceinline__ int crow(int r, int hi) { return (r & 3) + 8 * (r >> 2) + 4 * hi; }
__device__ __forceinline__ int kpos(int x) { return (x & ~12) | ((x & 4) << 1) | ((x & 8) >> 1); }
__device__ __forceinline__ unsigned cvtpk(float lo, float hi) { unsigned r; asm volatile("v_cvt_pk_bf16_f32 %0, %1, %2" : "=v"(r) : "v"(lo), "v"(hi)); return r; }
__device__ __forceinline__ bf16x8 pack8(const f32x16& v, int base) {
    u32x4 w; w.x = cvtpk(v[base + 0], v[base + 1]); w.y = cvtpk(v[base + 2], v[base + 3]); w.z = cvtpk(v[base + 4], v[base + 5]); w.w = cvtpk(v[base + 6], v[base + 7]);
    return __builtin_bit_cast(bf16x8, w); }
__device__ __forceinline__ float lo16(unsigned w) { return __builtin_bit_cast(float, w << 16); }
__device__ __forceinline__ float hi16(unsigned w) { return __builtin_bit_cast(float, w & 0xffff0000u); }
__device__ __forceinline__ float xhalf_sum(float v) { auto rr = __builtin_amdgcn_permlane32_swap(__float_as_uint(v), __float_as_uint(v), false, false); return __uint_as_float(rr[0]) + __uint_as_float(rr[1]); }
__device__ __forceinline__ int chunk_row0(int b, int dir, int c) {
    if (c < CTX / 32) return b * TT + (dir ? CTX - 1 - 32 * c : 32 * c);
    const int cc = c - CTX / 32; return b * TT + CTX + (dir ? SEQ - 1 - 32 * cc : 32 * cc);
}
template <int DK> struct Lay {
    static constexpr int RS = DK * 2 + 16;
    static constexpr int Q1 = 0, K1 = 32 * RS, Q2 = 64 * RS, K2T = 96 * RS, VT = K2T + DK * TS, SC = VT + 128 * TS, BYTES = SC + 1024;
};

template <int DK, bool ML, bool STATE_ONLY>
__device__ __forceinline__ void consume(const LAS unsigned char* buf, f32x16 (&S)[DK / 32], LAS float* wpriv, int w, int r32, int hi,
                                        unsigned short* O, int row0, int rstep, int colbase) {
    using L = Lay<DK>; constexpr int DT = DK / 32, NK = DK / 16;
    const LAS unsigned char* q1 = buf + L::Q1 + r32 * L::RS + hi * 16;
    const LAS unsigned char* k1 = buf + L::K1 + r32 * L::RS + hi * 16;
    const LAS unsigned char* q2 = buf + L::Q2 + r32 * L::RS + hi * 16;
    const LAS float* sc = (const LAS float*)(buf + L::SC);
    f32x16 X = {}, o = {};
    float rden[16];
    if (!STATE_ONLY) {
    bf16x8 q2f[NK];
#pragma unroll
    for (int ks = 0; ks < NK; ++ks) { const bf16x8 a = *(const LAS bf16x8*)(k1 + ks * 32), bq = *(const LAS bf16x8*)(q1 + ks * 32);
        X = __builtin_amdgcn_mfma_f32_32x32x16_bf16(a, bq, X, 0, 0, 0); }
#pragma unroll
    for (int ks = 0; ks < NK; ++ks) { q2f[ks] = *(const LAS bf16x8*)(q2 + ks * 32);
        o = __builtin_amdgcn_mfma_f32_32x32x16_bf16(q2f[ks], pack8(S[ks >> 1], (ks & 1) * 8), o, 0, 0, 0); }
    if (ML) {
        const float ct = sc[32 + r32];
        float colsum = 0.f;
#pragma unroll
        for (int g = 0; g < 4; ++g) { const f32x4 av = *(const LAS f32x4*)(sc + 8 * g + 4 * hi);
#pragma unroll
            for (int i = 0; i < 4; ++i) { const int r = 4 * g + i, s = 8 * g + 4 * hi + i; const float p = (s <= r32) ? __expf(av[i] - ct) : 0.f; X[r] *= p; colsum += X[r]; } }
        float qn = 0.f;
#pragma unroll
        for (int ks = 0; ks < NK; ++ks) { const u32x4 qa = __builtin_bit_cast(u32x4, q2f[ks]);
            const f32x4 n0 = *(const LAS f32x4*)(wpriv + 16 * ks + 4 * hi), n1 = *(const LAS f32x4*)(wpriv + 16 * ks + 8 + 4 * hi);
            qn += lo16(qa.x) * n0[0] + hi16(qa.x) * n0[1] + lo16(qa.y) * n0[2] + hi16(qa.y) * n0[3] + lo16(qa.z) * n1[0] + hi16(qa.z) * n1[1] + lo16(qa.w) * n1[2] + hi16(qa.w) * n1[3]; }
        const float den = xhalf_sum(colsum + qn);
        const float rd = 1.0f / fmaxf(fabsf(den), sc[64 + r32]);
        if (hi == 0) wpriv[64 + r32] = rd;
#pragma unroll
        for (int g = 0; g < 4; ++g) { const f32x4 dv = *(const LAS f32x4*)(wpriv + 64 + 8 * g + 4 * hi);
#pragma unroll
            for (int i = 0; i < 4; ++i) rden[4 * g + i] = dv[i]; }
    } else {
#pragma unroll
        for (int r = 0; r < 16; ++r) { if (crow(r, hi) > r32) X[r] = 0.f; }
    }
    }
    const LAS unsigned char* vt = buf + L::VT + (32 * w + r32) * TS + hi * 16;
    const bf16x8 v0 = *(const LAS bf16x8*)(vt), v1 = *(const LAS bf16x8*)(vt + 32);
    if (!STATE_ONLY) {
    o = __builtin_amdgcn_mfma_f32_32x32x16_bf16(pack8(X, 0), v0, o, 0, 0, 0);
    o = __builtin_amdgcn_mfma_f32_32x32x16_bf16(pack8(X, 8), v1, o, 0, 0, 0); }
    const LAS unsigned char* k2 = buf + L::K2T + r32 * TS + hi * 16;
    const float decay = ML ? sc[96] : 1.f;
#pragma unroll
    for (int dt = 0; dt < DT; ++dt) {
        if (ML) { S[dt] = S[dt] * decay; }
        else {
#pragma unroll
            for (int g = 0; g < 4; ++g) { const f32x4 gv = *(const LAS f32x4*)(sc + 32 * dt + 8 * g + 4 * hi);
#pragma unroll
                for (int i = 0; i < 4; ++i) S[dt][4 * g + i] *= gv[i]; } }
        const bf16x8 a0 = *(const LAS bf16x8*)(k2 + dt * 32 * TS), a1 = *(const LAS bf16x8*)(k2 + dt * 32 * TS + 32);
        S[dt] = __builtin_amdgcn_mfma_f32_32x32x16_bf16(a0, v0, S[dt], 0, 0, 0);
        S[dt] = __builtin_amdgcn_mfma_f32_32x32x16_bf16(a1, v1, S[dt], 0, 0, 0);
        if (ML) {
            const u32x4 ua = __builtin_bit_cast(u32x4, a0), ub = __builtin_bit_cast(u32x4, a1);
            float ksum = (lo16(ua.x) + hi16(ua.x)) + (lo16(ua.y) + hi16(ua.y)) + (lo16(ua.z) + hi16(ua.z)) + (lo16(ua.w) + hi16(ua.w))
                       + (lo16(ub.x) + hi16(ub.x)) + (lo16(ub.y) + hi16(ub.y)) + (lo16(ub.z) + hi16(ub.z)) + (lo16(ub.w) + hi16(ub.w));
            ksum = xhalf_sum(ksum);
            if (hi == 0) wpriv[32 * dt + r32] = decay * wpriv[32 * dt + r32] + ksum;
        }
    }
    if (STATE_ONLY) return;
    unsigned short* op = O + colbase + 32 * w + r32;
#pragma unroll
    for (int r = 0; r < 16; ++r) { const float v = ML ? o[r] * rden[r] : o[r]; const unsigned u = __float_as_uint(v);
        op[(long)(row0 + rstep * crow(r, hi)) * DM] = (unsigned short)((u + 0x7fffu + ((u >> 16) & 1u)) >> 16); }
}

struct HgPre { unsigned z[8], q[8], v[8]; };
template <bool LIGHT> __device__ __forceinline__ void hg_load(HgPre& P, const unsigned short* Z, const unsigned short* QA, const unsigned short* VA, int row0, int rstep, int colg, int qd) {
#pragma unroll
    for (int ii = 0; ii < 8; ++ii) { const size_t off = (size_t)(row0 + rstep * (8 * qd + ii)) * 512 + colg;
        P.z[ii] = *(const unsigned*)(Z + off); P.q[ii] = LIGHT ? 0u : *(const unsigned*)(QA + off); P.v[ii] = *(const unsigned*)(VA + off); }
}
template <bool LIGHT> __device__ __forceinline__ void hg_produce(LAS unsigned char* buf, const HgPre& P, float lb0, float lb1, int pw, int cp, int qd, float& gam0, float& gam1) {
    using L = Lay<128>;
    const int d0 = 32 * pw + 2 * cp;
    float q[2][8], k[2][8], Pc[2][8], RP[2][8];
#pragma unroll
    for (int x = 0; x < 2; ++x) { const float lb = x ? lb1 : lb0; float p = 1.f, rp = 1.f;
#pragma unroll
        for (int ii = 0; ii < 8; ++ii) { const float z = x ? hi16(P.z[ii]) : lo16(P.z[ii]); q[x][ii] = x ? hi16(P.q[ii]) : lo16(P.q[ii]);
            const float sg = __builtin_amdgcn_rcpf(1.f + __expf(-z)); const float f = lb + (1.f - lb) * sg; k[x][ii] = (1.f - lb) * (1.f - sg);
            p *= f; rp *= __builtin_amdgcn_rcpf(f); Pc[x][ii] = p; RP[x][ii] = rp; } }
    const int lane = cp + 16 * qd;
    unsigned k2lo[2][2], k2hi[2][2];
#pragma unroll
    for (int x = 0; x < 2; ++x) {
        const float T = Pc[x][7];
        const float T0 = __shfl(T, cp), T1 = __shfl(T, cp + 16), T2 = __shfl(T, cp + 32), T3 = __shfl(T, cp + 48);
        const float emid = T0 * T1, elast = T2 * T3;
        const float scale = qd == 0 ? __builtin_amdgcn_rcpf(emid) : (qd == 1 ? __builtin_amdgcn_rcpf(T1) : (qd == 2 ? 1.f : T2));
        const float rscale = qd == 0 ? emid : (qd == 1 ? T1 : (qd == 2 ? 1.f : __builtin_amdgcn_rcpf(T2)));
#pragma unroll
        for (int ii = 0; ii < 8; ++ii) { const float qt = q[x][ii] * (Pc[x][ii] * scale), kt = k[x][ii] * (RP[x][ii] * rscale);
            q[x][ii] = qt; k[x][ii] = kt; Pc[x][ii] = qt * emid; RP[x][ii] = kt * elast; }
        k2lo[x][0] = cvtpk(RP[x][0], RP[x][1]); k2lo[x][1] = cvtpk(RP[x][2], RP[x][3]); k2hi[x][0] = cvtpk(RP[x][4], RP[x][5]); k2hi[x][1] = cvtpk(RP[x][6], RP[x][7]);
        if (qd == 0) ((LAS float*)(buf + L::SC))[d0 + x] = emid * elast;
        if (x == 0) gam0 *= emid * elast; else gam1 *= emid * elast;
    }
    (void)lane;
    const int pd = ((d0 & ~15) | kpos(d0 & 15)) * 2;
    if (!LIGHT) {
#pragma unroll
    for (int ii = 0; ii < 8; ++ii) { const int i = 8 * qd + ii;
        *(LAS unsigned*)(buf + L::Q1 + i * L::RS + pd) = cvtpk(q[0][ii], q[1][ii]);
        *(LAS unsigned*)(buf + L::K1 + i * L::RS + pd) = cvtpk(k[0][ii], k[1][ii]);
        *(LAS unsigned*)(buf + L::Q2 + i * L::RS + pd) = cvtpk(Pc[0][ii], Pc[1][ii]); } }
    const int ps = (16 * (qd >> 1) + 4 * (qd & 1)) * 2;
#pragma unroll
    for (int x = 0; x < 2; ++x) {
        *(LAS u32x2*)(buf + L::K2T + (d0 + x) * TS + ps) = (u32x2){k2lo[x][0], k2lo[x][1]};
        *(LAS u32x2*)(buf + L::K2T + (d0 + x) * TS + ps + 16) = (u32x2){k2hi[x][0], k2hi[x][1]};
        unsigned a, b2, c2, d2;
        if (x == 0) { a = (P.v[0] & 0xffffu) | (P.v[1] << 16); b2 = (P.v[2] & 0xffffu) | (P.v[3] << 16); c2 = (P.v[4] & 0xffffu) | (P.v[5] << 16); d2 = (P.v[6] & 0xffffu) | (P.v[7] << 16); }
        else { a = (P.v[0] >> 16) | (P.v[1] & 0xffff0000u); b2 = (P.v[2] >> 16) | (P.v[3] & 0xffff0000u); c2 = (P.v[4] >> 16) | (P.v[5] & 0xffff0000u); d2 = (P.v[6] >> 16) | (P.v[7] & 0xffff0000u); }
        *(LAS u32x2*)(buf + L::VT + (d0 + x) * TS + ps) = (u32x2){a, b2};
        *(LAS u32x2*)(buf + L::VT + (d0 + x) * TS + ps + 16) = (u32x2){c2, d2};
    }
}

struct MlPre { unsigned x[10], v[8]; float ig, fg; };
__device__ __forceinline__ void ml_load(MlPre& P, const unsigned short* BQK, const unsigned short* VB, const float* BG, int segrow0, int L, int tq0, int colq, int colv,
                                        int row0, int rstep, int qd, int i32, int gi_i, int gi_f, float gb_i, float gb_f) {
#pragma unroll
    for (int jj = 0; jj < 10; ++jj) { const int t = tq0 - 1 + jj; P.x[jj] = (t >= 0 && t < L) ? *(const unsigned*)(BQK + (size_t)(segrow0 + t) * 512 + colq) : 0u; }
#pragma unroll
    for (int ii = 0; ii < 8; ++ii) P.v[ii] = *(const unsigned*)(VB + (size_t)(row0 + rstep * (8 * qd + ii)) * 512 + colv);
    const size_t gr = (size_t)(row0 + rstep * i32) * 16;
    P.ig = BG[gr + gi_i] + gb_i; P.fg = BG[gr + gi_f] + gb_f;
}
template <bool LIGHT> __device__ __forceinline__ void ml_produce(LAS unsigned char* buf, const MlPre& P, LAS float* ppriv, float& m, float& Bacc, int dir, int pw, int cp, int qd, int lane,
                                           float w00, float w01, float w02, float w10, float w11, float w12) {
    using L = Lay<64>;
    const int i32 = lane & 31;
    const float logf = fminf(P.fg, 0.f) - log1pf(__expf(-fabsf(P.fg)));
    float bh = logf;
#pragma unroll
    for (int o = 1; o < 32; o <<= 1) { const float t = __shfl_up(bh, o, 32); if (i32 >= o) bh += t; }
    const float a = P.ig - bh;
    float pm = a;
#pragma unroll
    for (int o = 1; o < 32; o <<= 1) { const float t = __shfl_up(pm, o, 32); if (i32 >= o) pm = fmaxf(pm, t); }
    const float c = fmaxf(pm, m);
    const float c31 = __shfl(c, 31, 32), bh31 = __shfl(bh, 31, 32);
    const float winter = __expf(m - c), wk = __expf(a - c31), decay = __expf(m - c31), flo = __expf(-(bh + c));
    if (lane < 32) { ppriv[i32] = winter; ppriv[32 + i32] = wk; }
    if (pw == 0 && lane < 32) { LAS float* sc = (LAS float*)(buf + L::SC); sc[i32] = a; sc[32 + i32] = c; sc[64 + i32] = flo; if (i32 == 0) sc[96] = decay; }
    m = bh31 + c31; Bacc += bh31;
    const bool isk = pw >= 2;
    float y[2][8];
    if (!LIGHT || isk) {
#pragma unroll
    for (int mm = 0; mm < 8; ++mm) {
        const float c0v = w00 * lo16(P.x[mm]) + w01 * lo16(P.x[mm + 1]) + w02 * lo16(P.x[mm + 2]);
        const float c1v = w10 * hi16(P.x[mm]) + w11 * hi16(P.x[mm + 1]) + w12 * hi16(P.x[mm + 2]);
        const float s0 = c0v * __builtin_amdgcn_rcpf(1.f + __expf(-c0v)), s1 = c1v * __builtin_amdgcn_rcpf(1.f + __expf(-c1v));
        const int ii = dir ? 7 - mm : mm;
        y[0][ii] = isk ? s0 : s0 * 0.125f; y[1][ii] = isk ? s1 : s1 * 0.125f; } }
    const LAS float* wp = ppriv + (isk ? 32 : 0) + 8 * qd;
    const f32x4 wa = *(const LAS f32x4*)wp, wb = *(const LAS f32x4*)(wp + 4);
    float ws[8] = {wa[0], wa[1], wa[2], wa[3], wb[0], wb[1], wb[2], wb[3]};
    const int cc = (32 * pw + 2 * cp) & 63;
    const int ps = (16 * (qd >> 1) + 4 * (qd & 1)) * 2;
    if (!isk) {
      if (!LIGHT) {
        const int pd = ((cc & ~15) | kpos(cc & 15)) * 2;
#pragma unroll
        for (int ii = 0; ii < 8; ++ii) { const int i = 8 * qd + ii;
            *(LAS unsigned*)(buf + L::Q1 + i * L::RS + pd) = cvtpk(y[0][ii], y[1][ii]);
            *(LAS unsigned*)(buf + L::Q2 + i * L::RS + pd) = cvtpk(y[0][ii] * ws[ii], y[1][ii] * ws[ii]); } }
    } else {
        const int pd = ((cc & ~15) | kpos(cc & 15)) * 2;
#pragma unroll
        for (int ii = 0; ii < 8; ++ii) { const int i = 8 * qd + ii; if (!LIGHT) *(LAS unsigned*)(buf + L::K1 + i * L::RS + pd) = cvtpk(y[0][ii], y[1][ii]); }
#pragma unroll
        for (int x = 0; x < 2; ++x) {
            *(LAS u32x2*)(buf + L::K2T + (cc + x) * TS + ps) = (u32x2){cvtpk(y[x][0] * ws[0], y[x][1] * ws[1]), cvtpk(y[x][2] * ws[2], y[x][3] * ws[3])};
            *(LAS u32x2*)(buf + L::K2T + (cc + x) * TS + ps + 16) = (u32x2){cvtpk(y[x][4] * ws[4], y[x][5] * ws[5]), cvtpk(y[x][6] * ws[6], y[x][7] * ws[7])}; }
    }
    const int e0 = 32 * pw + 2 * cp;
#pragma unroll
    for (int x = 0; x < 2; ++x) {
        unsigned a2, b2, c2, d2;
        if (x == 0) { a2 = (P.v[0] & 0xffffu) | (P.v[1] << 16); b2 = (P.v[2] & 0xffffu) | (P.v[3] << 16); c2 = (P.v[4] & 0xffffu) | (P.v[5] << 16); d2 = (P.v[6] & 0xffffu) | (P.v[7] << 16); }
        else { a2 = (P.v[0] >> 16) | (P.v[1] & 0xffff0000u); b2 = (P.v[2] >> 16) | (P.v[3] & 0xffff0000u); c2 = (P.v[4] >> 16) | (P.v[5] & 0xffff0000u); d2 = (P.v[6] >> 16) | (P.v[7] & 0xffff0000u); }
        *(LAS u32x2*)(buf + L::VT + (e0 + x) * TS + ps) = (u32x2){a2, b2};
        *(LAS u32x2*)(buf + L::VT + (e0 + x) * TS + ps + 16) = (u32x2){c2, d2};
    }
}

#define SCAN_BAR() do { asm volatile("s_waitcnt lgkmcnt(0)" ::: "memory"); __builtin_amdgcn_s_barrier(); asm volatile("" ::: "memory"); } while (0)

constexpr int NSEG = 4, CPS = NCH / NSEG;
static_assert(NCH % NSEG == 0 && (CPS - 1) % 3 == 0 && CPS % 2 == 0, "segment geometry");
struct Xch { float* SXH; float* GXH; float* SXM; float* NXM; float* MXM; };
template <int PASS>
__device__ __forceinline__ void run_hgrn(LAS unsigned char* lds, int ch, int seg, const unsigned short* PROJ, const float* hgrn_lb, unsigned short* OF, unsigned short* OB, const Xch X) {
    using L = Lay<128>;
    if (PASS == 0 && seg == NSEG - 1) return;
    const int tid = threadIdx.x, wave = __builtin_amdgcn_readfirstlane(tid >> 6), lane = tid & 63;
    const int b = ch >> 3, h = (ch >> 1) & 3, dir = ch & 1, rstep = dir ? -1 : 1;
    const int c0 = seg * CPS;
    const unsigned short* QA = PROJ; const unsigned short* VA = PROJ + SEG; const unsigned short* Z = PROJ + (3 + dir) * SEG;
    unsigned short* O = dir ? OB : OF;
    if (wave < 4) {
        f32x16 S[4] = {};
        const int r32 = lane & 31, hi = lane >> 5;
        if (PASS == 1 && seg > 0) {
            const float* sx = X.SXH + ((size_t)(ch * 3) * 4 + wave) * 4096 + lane;
#pragma unroll
            for (int dt = 0; dt < 4; ++dt)
#pragma unroll
                for (int r = 0; r < 16; ++r) S[dt][r] = sx[(dt * 16 + r) * 64];
            for (int i = 1; i < seg; ++i) { const float* gam = X.GXH + (size_t)(ch * 3 + i) * 128;
#pragma unroll
                for (int dt = 0; dt < 4; ++dt)
#pragma unroll
                    for (int r = 0; r < 16; ++r) S[dt][r] = S[dt][r] * gam[32 * dt + crow(r, hi)] + sx[(size_t)i * 16384 + (dt * 16 + r) * 64]; }
        }
        SCAN_BAR();
        for (int c = c0; c < c0 + CPS; ++c) {
            consume<128, false, PASS == 0>(lds + (c & 1) * L::BYTES, S, nullptr, wave, r32, hi, O, chunk_row0(b, dir, c), rstep, h * 128);
            SCAN_BAR();
        }
        if (PASS == 0) { float* sx = X.SXH + ((size_t)(ch * 3 + seg) * 4 + wave) * 4096 + lane;
#pragma unroll
            for (int dt = 0; dt < 4; ++dt)
#pragma unroll
                for (int r = 0; r < 16; ++r) sx[(dt * 16 + r) * 64] = S[dt][r]; }
    } else {
        const int pw = wave - 4, cp = lane & 15, qd = lane >> 4, d0 = 32 * pw + 2 * cp, colg = h * 128 + d0;
        float lbv[2];
#pragma unroll
        for (int x = 0; x < 2; ++x) { const float* p = hgrn_lb + (size_t)dir * 3 * 512 + h * 128 + d0 + x; const float a0 = p[0], a1 = p[512], a2 = p[1024];
            const float mx = fmaxf(a0, fmaxf(a1, a2)); const float e0 = __expf(a0 - mx), e1 = __expf(a1 - mx), e2 = __expf(a2 - mx); lbv[x] = e0 / (e0 + e1 + e2); }
        float gam0 = 1.f, gam1 = 1.f;
        HgPre P0, P1, P2;
#define HG_LD(P_, j_) hg_load<PASS == 0>(P_, Z, QA, VA, chunk_row0(b, dir, c0 + (j_)), rstep, colg, qd)
#define HG_STEP(j_, LS, PS) do { if ((j_) + 3 < CPS) HG_LD(LS, (j_) + 3); if ((j_) + 1 < CPS) hg_produce<PASS == 0>(lds + (((j_) + 1) & 1) * L::BYTES, PS, lbv[0], lbv[1], pw, cp, qd, gam0, gam1); SCAN_BAR(); } while (0)
        HG_LD(P0, 0); HG_LD(P1, 1); HG_LD(P2, 2);
        hg_produce<PASS == 0>(lds, P0, lbv[0], lbv[1], pw, cp, qd, gam0, gam1);
        SCAN_BAR();
        for (int j = 0; j < CPS - 1; j += 3) { HG_STEP(j, P0, P1); HG_STEP(j + 1, P1, P2); HG_STEP(j + 2, P2, P0); }
        SCAN_BAR();
#undef HG_LD
#undef HG_STEP
        if (PASS == 0 && qd == 0) { float* g = X.GXH + (size_t)(ch * 3 + seg) * 128 + d0; g[0] = gam0; g[1] = gam1; }
    }
}
template <int PASS>
__device__ __forceinline__ void run_mlstm(LAS unsigned char* lds, int ch, int seg, const unsigned short* PROJ, const float* BG, const float* conv, const float* gate_b, unsigned short* OF, unsigned short* OB, const Xch X) {
    using L = Lay<64>;
    if (PASS == 0 && seg == NSEG - 1) return;
    const int tid = threadIdx.x, wave = __builtin_amdgcn_readfirstlane(tid >> 6), lane = tid & 63;
    const int b = ch >> 3, h = (ch >> 1) & 3, dir = ch & 1, rstep = dir ? -1 : 1;
    const int c0 = seg * CPS;
    const unsigned short* BQK = PROJ + 5 * SEG; const unsigned short* VB = PROJ + 6 * SEG;
    unsigned short* O = dir ? OB : OF;
    LAS float* priv = (LAS float*)(lds + 2 * L::BYTES) + wave * 128;
    float mstart = (PASS == 0) ? (seg == 0 ? 0.f : -1e30f) : 0.f;
    float fa1 = 0.f, fb1 = 0.f, fa2 = 0.f, fb2 = 0.f;
    if (PASS == 1 && seg > 0) { const float* mx = X.MXM + (size_t)(ch * 3) * 2;
        float m = mx[0];
        if (seg > 1) { const float ml = mx[2], B = mx[3]; const float mn = fmaxf(B + m, ml); fa1 = __expf(B + m - mn); fb1 = __expf(ml - mn); m = mn; }
        if (seg > 2) { const float ml = mx[4], B = mx[5]; const float mn = fmaxf(B + m, ml); fa2 = __expf(B + m - mn); fb2 = __expf(ml - mn); m = mn; }
        mstart = m; }
    if (wave < 4) {
        f32x16 S[2] = {};
        const int r32 = lane & 31, hi = lane >> 5;
        float nv = 0.f;
        if (PASS == 1 && seg > 0) {
            const float* sx = X.SXM + ((size_t)(ch * 3) * 4 + wave) * 2048 + lane;
            const float* nx = X.NXM + (size_t)(ch * 3) * 64 + lane;
#pragma unroll
            for (int dt = 0; dt < 2; ++dt)
#pragma unroll
                for (int r = 0; r < 16; ++r) S[dt][r] = sx[(dt * 16 + r) * 64];
            nv = nx[0];
            if (seg > 1) {
#pragma unroll
                for (int dt = 0; dt < 2; ++dt)
#pragma unroll
                    for (int r = 0; r < 16; ++r) S[dt][r] = fa1 * S[dt][r] + fb1 * sx[8192 + (dt * 16 + r) * 64];
                nv = fa1 * nv + fb1 * nx[64]; }
            if (seg > 2) {
#pragma unroll
                for (int dt = 0; dt < 2; ++dt)
#pragma unroll
                    for (int r = 0; r < 16; ++r) S[dt][r] = fa2 * S[dt][r] + fb2 * sx[16384 + (dt * 16 + r) * 64];
                nv = fa2 * nv + fb2 * nx[128]; }
        }
        priv[lane] = nv;
        SCAN_BAR();
        for (int c = c0; c < c0 + CPS; ++c) {
            consume<64, true, PASS == 0>(lds + (c & 1) * L::BYTES, S, priv, wave, r32, hi, O, chunk_row0(b, dir, c), rstep, 512 + h * 128);
            SCAN_BAR();
        }
        if (PASS == 0) { float* sx = X.SXM + ((size_t)(ch * 3 + seg) * 4 + wave) * 2048 + lane;
#pragma unroll
            for (int dt = 0; dt < 2; ++dt)
#pragma unroll
                for (int r = 0; r < 16; ++r) sx[(dt * 16 + r) * 64] = S[dt][r];
            if (wave == 0) X.NXM[(size_t)(ch * 3 + seg) * 64 + lane] = priv[lane]; }
    } else {
        const int pw = wave - 4, cp = lane & 15, qd = lane >> 4, i32 = lane & 31;
        const int cc = 32 * pw + 2 * cp;
        const int colq = cc < 64 ? h * 64 + cc : 256 + h * 64 + (cc - 64);
        const int colv = h * 128 + cc;
        const float w00 = conv[colq], w01 = conv[512 + colq], w02 = conv[1024 + colq], w10 = conv[colq + 1], w11 = conv[512 + colq + 1], w12 = conv[1024 + colq + 1];
        const int gi_i = 4 * (2 * dir) + h, gi_f = 4 * (2 * dir + 1) + h; const float gb_i = gate_b[gi_i], gb_f = gate_b[gi_f];
        float m = mstart, Bacc = 0.f;
        MlPre P0, P1, P2;
#define ML_LOADC(P, j_) do { const int c__ = c0 + (j_); const bool lat = c__ >= CTX / 32; const int Lg = lat ? SEQ : CTX; const int segrow0 = b * TT + (lat ? CTX : 0); \
        const int i0 = 32 * (lat ? c__ - CTX / 32 : c__) + 8 * qd; const int tq0 = dir ? Lg - 1 - (i0 + 7) : i0; \
        ml_load(P, BQK, VB, BG, segrow0, Lg, tq0, colq, colv, chunk_row0(b, dir, c__), rstep, qd, i32, gi_i, gi_f, gb_i, gb_f); } while (0)
#define ML_STEP(j_, LS, PS) do { if ((j_) + 3 < CPS) ML_LOADC(LS, (j_) + 3); if ((j_) + 1 < CPS) ml_produce<PASS == 0>(lds + (((j_) + 1) & 1) * L::BYTES, PS, priv, m, Bacc, dir, pw, cp, qd, lane, w00, w01, w02, w10, w11, w12); SCAN_BAR(); } while (0)
        ML_LOADC(P0, 0); ML_LOADC(P1, 1); ML_LOADC(P2, 2);
        ml_produce<PASS == 0>(lds, P0, priv, m, Bacc, dir, pw, cp, qd, lane, w00, w01, w02, w10, w11, w12);
        SCAN_BAR();
        for (int j = 0; j < CPS - 1; j += 3) { ML_STEP(j, P0, P1); ML_STEP(j + 1, P1, P2); ML_STEP(j + 2, P2, P0); }
        SCAN_BAR();
#undef ML_STEP
#undef ML_LOADC
        if (PASS == 0 && pw == 0 && lane == 0) { float* mx = X.MXM + (size_t)(ch * 3 + seg) * 2; mx[0] = m; mx[1] = Bacc; }
    }
}
#undef SCAN_BAR
}

enum { PH_PRO = 0, PH_MOD0, PH_INPROJ, PH_SCANA, PH_SCAN, PH_OG, PH_OUT0, PH_ROW0A, PH_FFI0, PH_FFO0, PH_ROW0B, PH_QKV, PH_QKN, PH_ATTN, PH_OUT1, PH_ROW1A, PH_FFI1, PH_FFO1, PH_ROW1B, NPH };
struct Args { const float* in[18]; float* out; unsigned char* ws; int ph_lo, ph_hi, variant, pad; };

template <class FN> __device__ __forceinline__ void run_gemm(Frame& F, const bf16* A, const bf16* Bt, int N, int K, int skipctx, const FN& fn) {
    pg8::Gemm g{A, Bt, M, N, K}; pg8::TileOrder S; S.init(skipctx ? 64 : 68, N, F.G, (int)blockIdx.x, skipctx);
    pg8::Epi8<FN> E{fn};
    pg8::gemm_phase<pg8::Epi8<FN>, pg8::TileOrder, true, true>(F.lds, g, S, E);
}

__global__ void __launch_bounds__(512, 2) mk_fwd(Args args) {
    extern __shared__ __attribute__((aligned(16))) unsigned char lds[];
    cg::grid_group grid = cg::this_grid();
    Frame F;
    F.lds = (LAS unsigned char*)lds;
    F.tid = threadIdx.x; F.lane = F.tid & 63; F.wave = __builtin_amdgcn_readfirstlane(F.tid >> 6); F.G = gridDim.x;
#pragma unroll
    for (int i = 0; i < 18; ++i) F.in[i] = args.in[i];
    F.out = args.out; F.ws = args.ws;
    unsigned char* ws = args.ws;
    F.MOD = (float*)(ws + WS_MOD); F.XCTX = (float*)(ws + WS_XCTX); F.H = (bf16*)(ws + WS_H); F.PROJ = (bf16*)(ws + WS_PROJ); F.BG = (float*)(ws + WS_BG);
    F.OG = (bf16*)(ws + WS_OG); F.Y = (bf16*)(ws + WS_Y); F.ACT = (bf16*)(ws + WS_ACT); F.Q = (bf16*)(ws + WS_Q); F.K = (bf16*)(ws + WS_K); F.V = (bf16*)(ws + WS_V);
    F.WAB = (bf16*)(ws + WS_WAB); F.WABO = (bf16*)(ws + WS_WABO); F.WFI0 = (bf16*)(ws + WS_WFI0); F.WFI1 = (bf16*)(ws + WS_WFI1); F.WFO0 = (bf16*)(ws + WS_WFO0); F.WFO1 = (bf16*)(ws + WS_WFO1);
    F.WQKV = (bf16*)(ws + WS_WQKV); F.WAO = (bf16*)(ws + WS_WAO);
    bf16* OF = (bf16*)F.out;
    bf16* OB = F.H;
    const float* MOD0 = F.MOD; const float* MOD1 = F.MOD + 5 * 6144;
    const float* NG = F.in[I_NORMG];
    const int lo = args.ph_lo, hi = args.ph_hi;
#define IN(k) (lo <= (k) && (k) < hi)
#define SEAM(k) do { if (IN(k) && IN((k) + 1)) grid.sync(); } while (0)
#define NREP(k) 1
#define PH(k) for (int rep_ = 0; IN(k) && rep_ < NREP(k); (++rep_ < NREP(k)) ? grid.sync() : (void)0)

    PH(PH_PRO) p0_prologue(F);
    SEAM(PH_PRO);
    PH(PH_MOD0) rowpass<false, false, true, false>(F, F.in[I_X], F.in[I_CTX], nullptr, nullptr, nullptr, 0, nullptr, MOD0, 0, 1024, NG + 0);
    SEAM(PH_MOD0);
    PH(PH_INPROJ) run_gemm(F, F.H, F.WAB, NABP, 1024, 0, pg8::FProj{F.PROJ, F.BG});
    SEAM(PH_INPROJ);
    const scan::Xch XC{(float*)(ws + WS_SXH), (float*)(ws + WS_GXH), (float*)(ws + WS_SXM), (float*)(ws + WS_NXM), (float*)(ws + WS_MXM)};
    PH(PH_SCANA) for (int it = blockIdx.x; it < 256; it += F.G) { const int ch = it >> 2, sg = it & 3;
        if (ch < 32) scan::run_hgrn<0>(F.lds, ch, sg, F.PROJ, F.in[I_LB], OF, OB, XC);
        else if (ch < 64) scan::run_mlstm<0>(F.lds, ch - 32, sg, F.PROJ, F.BG, F.in[I_CONV], F.in[I_GATEB], OF, OB, XC); }
    SEAM(PH_SCANA);
    PH(PH_SCAN) for (int it = blockIdx.x; it < 256; it += F.G) { const int ch = it >> 2, sg = it & 3;
        if (ch < 32) scan::run_hgrn<1>(F.lds, ch, sg, F.PROJ, F.in[I_LB], OF, OB, XC);
        else if (ch < 64) scan::run_mlstm<1>(F.lds, ch - 32, sg, F.PROJ, F.BG, F.in[I_CONV], F.in[I_GATEB], OF, OB, XC); }
    SEAM(PH_SCAN);
    PH(PH_OG) og_pass(F, OF, OB);
    SEAM(PH_OG);
    PH(PH_OUT0) run_gemm(F, F.OG, F.WABO, 1024, 1024, 0, pg8::FStore{F.Y, 1024});
    SEAM(PH_OUT0);
    PH(PH_ROW0A) rowpass<true, true, true, false>(F, F.in[I_X], F.in[I_CTX], F.out, F.XCTX, MOD0, 2048, NG + 1024, MOD0, 3072, 4096, NG + 2048);
    SEAM(PH_ROW0A);
    PH(PH_FFI0) run_gemm(F, F.H, F.WFI0, 2 * DFF, 1024, 0, pg8::FSwiglu{F.ACT});
    SEAM(PH_FFI0);
    PH(PH_FFO0) run_gemm(F, F.ACT, F.WFO0, 1024, DFF, 0, pg8::FStore{F.Y, 1024});
    SEAM(PH_FFO0);
    PH(PH_ROW0B) rowpass<true, true, true, false>(F, F.out, F.XCTX, F.out, F.XCTX, MOD0, 5120, NG + 3072, MOD1, 0, 1024, NG + 4096);
    SEAM(PH_ROW0B);
    PH(PH_QKV) run_gemm(F, F.H, F.WQKV, NQKV, 1024, 0, pg8::FQkv{F.Q, F.K, F.V});
    SEAM(PH_QKV);
    PH(PH_QKN) qknorm_pass(F);
    SEAM(PH_QKN);
    PH(PH_ATTN) {
        const int bx = blockIdx.x, vcu = (F.G % 8 == 0) ? (bx % 8) * (F.G / 8) + bx / 8 : bx;
        for (int u = vcu; u < 512; u += F.G) {
            const int uu = (u % 256) * 2 + u / 256;
            const int g = uu & 3, qb = (uu >> 2) & 15, kvh = (uu >> 6) & 1, b = uu >> 7, head = kvh * 4 + g;
            const size_t qrow = (size_t)b * TT + CTX + qb * 256;
            attn::attn_dense_body(F.Q + qrow * 1024 + head * 128, F.K + (size_t)b * TT * 256 + kvh * 128, F.V + (size_t)b * TT * 256 + kvh * 128,
                                  F.OG + qrow * 1024 + head * 128, TT, (char*)lds);
            __syncthreads();
        }
    }
    SEAM(PH_ATTN);
    PH(PH_OUT1) run_gemm(F, F.OG, F.WAO, 1024, 1024, 1, pg8::FStore{F.Y, 1024});
    SEAM(PH_OUT1);
    PH(PH_ROW1A) rowpass<true, true, true, true>(F, F.out, F.XCTX, F.out, F.XCTX, MOD1, 2048, NG + 5120, MOD1, 3072, 4096, NG + 6144);
    SEAM(PH_ROW1A);
    PH(PH_FFI1) run_gemm(F, F.H, F.WFI1, 2 * DFF, 1024, 1, pg8::FSwiglu{F.ACT});
    SEAM(PH_FFI1);
    PH(PH_FFO1) run_gemm(F, F.ACT, F.WFO1, 1024, DFF, 1, pg8::FStore{F.Y, 1024});
    SEAM(PH_FFO1);
    PH(PH_ROW1B) rowpass<true, true, false, true>(F, F.out, F.XCTX, F.out, F.XCTX, MOD1, 5120, NG + 7168, nullptr, 0, 0, nullptr);
#undef IN
#undef SEAM
#undef PH
#undef NREP
}

extern "C" void kernel_launch(void* const* d_in, const int* in_sizes, int n_in, void* d_out, int out_size, void* d_ws, size_t ws_size, hipStream_t stream) {
    static int grid = 0;
    if (grid == 0) {
        if (n_in != 18 || in_sizes[0] != NB * SEQ * DM || out_size != NB * SEQ * DM || ws_size < WS_END) {
            fprintf(stderr, "kernel_launch: unexpected shapes (n_in %d, in0 %d, out %d, ws %zu)\n", n_in, n_in > 0 ? in_sizes[0] : -1, out_size, ws_size); grid = -1; return; }
        int dev = 0, cus = 0, per_cu = 0;
        if (hipGetDevice(&dev) != hipSuccess || hipDeviceGetAttribute(&cus, hipDeviceAttributeMultiprocessorCount, dev) != hipSuccess) { grid = -1; return; }
        if (hipFuncSetAttribute((const void*)mk_fwd, hipFuncAttributeMaxDynamicSharedMemorySize, LDS_BYTES) != hipSuccess) { fprintf(stderr, "kernel_launch: hipFuncSetAttribute failed\n"); grid = -1; return; }
        if (hipOccupancyMaxActiveBlocksPerMultiprocessor(&per_cu, (const void*)mk_fwd, 512, LDS_BYTES) != hipSuccess || per_cu < 1) { fprintf(stderr, "kernel_launch: occupancy query says %d blocks per CU\n", per_cu); per_cu = 1; }
        (void)hipGetLastError();
        grid = cus;
        fprintf(stderr, "kernel_launch: grid %d (occupancy query %d per CU)\n", grid, per_cu);
    }
    if (grid < 0) return;
    Args a{};
    for (int i = 0; i < 18; ++i) a.in[i] = (const float*)d_in[i];
    a.out = (float*)d_out; a.ws = (unsigned char*)d_ws;
#if MK_ONE
    a.ph_lo = 0; a.ph_hi = NPH;
    void* kargs[] = {&a};
    hipError_t e = hipLaunchCooperativeKernel((const void*)mk_fwd, dim3(grid), dim3(512), kargs, LDS_BYTES, stream);
    if (e != hipSuccess) fprintf(stderr, "kernel_launch: cooperative launch failed: %s (grid %d)\n", hipGetErrorString(e), grid);
#else
    for (int p = 0; p < NPH; ++p) for (int rep = 0; rep < ((((PROBE_REP) >> p) & 1) ? 2 : 1); ++rep) { a.ph_lo = p; a.ph_hi = p + 1; a.variant = rep ? (PROBE_VAR) : 0; hipLaunchKernelGGL(mk_fwd, dim3(grid), dim3(512), LDS_BYTES, stream, a); }
    const hipError_t le = hipPeekAtLastError();
    if (le != hipSuccess) fprintf(stderr, "kernel_launch: launch failed: %s\n", hipGetErrorName(le));
#endif
}
```

```cpp
#include <hip/hip_runtime.h>
#include <hip/hip_cooperative_groups.h>
#include <cstdio>
#include <cstdint>
namespace cg = cooperative_groups;

constexpr int DM = 1024, NB = 4, SEQ = 4096, CTX = 256, TT = SEQ + CTX, M = NB * TT;
constexpr int DFF = 2816, NAB = 4112, NABP = 4352, NQKV = 1536;
constexpr float EPS = 1e-6f;
#ifndef MK_ONE
#define MK_ONE 1
#endif
#ifndef PROBE_REP
#define PROBE_REP 0
#endif
#ifndef PROBE_VAR
#define PROBE_VAR 0
#endif
#ifndef SCAN_NAIVE
#define SCAN_NAIVE 0
#endif

namespace pg8 {
#define PG8_LAS __attribute__((address_space(3)))
typedef unsigned short bf16_t;
typedef short bf16x8 __attribute__((ext_vector_type(8)));
typedef float f32x4 __attribute__((ext_vector_type(4)));
typedef unsigned u32x4 __attribute__((ext_vector_type(4)));
constexpr int BM = 256, BK = 64, HALF = 128, HTB = HALF * BK * 2  , STAGE_BYTES = 8 * HTB, NXCD = 8, WGM = 8;

__host__ __device__ __forceinline__ int lds_byte(int r, int c) { const int st = (r >> 4) * 2 + (c >> 5), rr = r & 15, cc = c & 31, ob = rr * 64 + cc * 2; return st * 1024 + (ob ^ (((ob >> 9) & 1) << 5)); }
__host__ __device__ __forceinline__ void stage_rc(int b, int& R, int& C) { const int st = b / 1024, sb = b % 1024, swz = sb ^ (((sb >> 9) & 1) << 5); R = (st >> 1) * 16 + swz / 64; C = (st & 1) * 32 + (swz % 64) / 2; }
__host__ __device__ __forceinline__ int perm32(int rho) { const int n = rho >> 4, i = rho & 15; return 8 * (i >> 2) + 4 * n + (i & 3); }

struct Unit { int pm, pn; };
struct Gemm { const bf16_t* A; const bf16_t* Bt; int M, N, K; };

struct TileOrder {
    int nM, nN, nwg, G, c, skip;
    __device__ void init(int nM_, int N, int G_, int c_, int skip_) { nM = nM_; nN = N / BM; nwg = nM * nN; G = G_; c = c_; skip = skip_; }
    __device__ bool next(int i, Unit& u) const {
        const long L = (long)i * G + c; if (L >= nwg) return false;
        int wgid = (int)L; { const int q = nwg / NXCD, r = nwg % NXCD, xcd = wgid % NXCD, off = wgid / NXCD; wgid = (xcd < r ? xcd * (q + 1) : r * (q + 1) + (xcd - r) * q) + off; }
        const int nig = WGM * nN, gid = wgid / nig, fm = gid * WGM, gsz = (nM - fm) < WGM ? (nM - fm) : WGM;
        int pm = fm + ((wgid % nig) % gsz); u.pn = (wgid % nig) / gsz;
        if (skip) pm = pm + (pm >> 4) + 1;
        u.pm = pm; return true;
    }
    __device__ __forceinline__ void a_ready(const Unit&) const {}
    __device__ __forceinline__ void done(const Unit&) const {}
};

__device__ __forceinline__ unsigned cvt_pk_bf16(float lo, float hi) { unsigned r; asm volatile("v_cvt_pk_bf16_f32 %0, %1, %2" : "=v"(r) : "v"(lo), "v"(hi)); return r; }
__device__ __forceinline__ u32x4 pack8(const f32x4 a, const f32x4 b) { u32x4 w; w.x = cvt_pk_bf16(a[0], a[1]); w.y = cvt_pk_bf16(a[2], a[3]); w.z = cvt_pk_bf16(b[0], b[1]); w.w = cvt_pk_bf16(b[2], b[3]); return w; }
__device__ __forceinline__ float fsigmoid(float x) { return __builtin_amdgcn_rcpf(1.0f + __expf(-x)); }
__device__ __forceinline__ f32x4 silu4(f32x4 v) { f32x4 o; o[0] = v[0] * fsigmoid(v[0]); o[1] = v[1] * fsigmoid(v[1]); o[2] = v[2] * fsigmoid(v[2]); o[3] = v[3] * fsigmoid(v[3]); return o; }
__device__ __forceinline__ f32x4 sigm4(f32x4 v) { f32x4 o; o[0] = fsigmoid(v[0]); o[1] = fsigmoid(v[1]); o[2] = fsigmoid(v[2]); o[3] = fsigmoid(v[3]); return o; }

template <class F> struct Epi8 {
    static constexpr bool PERM = true, AFTER_DRAIN = false;
    F f;
    __device__ __forceinline__ void operator()(const f32x4 (&acc)[2][2][4][2], const Unit& u, int wr, int wc, int fr, int fq) const {
        const int col = u.pn * BM + wc * 32 + 8 * fq;
#pragma unroll
        for (int ai = 0; ai < 2; ++ai)
#pragma unroll
            for (int m = 0; m < 4; ++m) { const int row = u.pm * BM + ai * HALF + wr * 64 + m * 16 + fr;
                f.apply(row, col, acc[ai][0][m][0], acc[ai][0][m][1], acc[ai][1][m][0], acc[ai][1][m][1]); }
    }
};
struct FProj {
    bf16_t* proj; float* bg;
    __device__ __forceinline__ void one(int row, int c, f32x4 v0, f32x4 v1) const {
        if (c >= 4096) { if (c < 4112) { float* p = bg + (size_t)row * 16 + (c - 4096); *(f32x4*)p = v0; *(f32x4*)(p + 4) = v1; } return; }
        const int seg = c >> 9, cs = c & 511;
        if (seg == 2) { v0 = silu4(v0); v1 = silu4(v1); }
        if (seg == 7) { v0 = sigm4(v0); v1 = sigm4(v1); }
        *(u32x4*)(proj + (size_t)seg * ((size_t)M * 512) + (size_t)row * 512 + cs) = pack8(v0, v1);
    }
    __device__ __forceinline__ void apply(int row, int col, f32x4 a0, f32x4 a1, f32x4 b0, f32x4 b1) const { one(row, col, a0, a1); one(row, col + 128, b0, b1); }
};
struct FStore {
    bf16_t* O; int ld;
    __device__ __forceinline__ void apply(int row, int col, f32x4 a0, f32x4 a1, f32x4 b0, f32x4 b1) const {
        bf16_t* p = O + (size_t)row * ld + col; *(u32x4*)p = pack8(a0, a1); *(u32x4*)(p + 128) = pack8(b0, b1); }
};
struct FSwiglu {
    bf16_t* act;
    __device__ __forceinline__ void apply(int row, int col, f32x4 a0, f32x4 a1, f32x4 b0, f32x4 b1) const {
        const int hc = (col >> 8) * 128 + (col & 255);
        *(u32x4*)(act + (size_t)row * DFF + hc) = pack8(silu4(a0) * b0, silu4(a1) * b1); }
};
struct FQkv {
    bf16_t *q, *k, *v;
    __device__ __forceinline__ void one(int row, int c, f32x4 v0, f32x4 v1) const {
        bf16_t* p = c < 1024 ? q + (size_t)row * 1024 + c : (c < 1280 ? k + (size_t)row * 256 + (c - 1024) : v + (size_t)row * 256 + (c - 1280));
        *(u32x4*)p = pack8(v0, v1); }
    __device__ __forceinline__ void apply(int row, int col, f32x4 a0, f32x4 a1, f32x4 b0, f32x4 b1) const { one(row, col, a0, a1); one(row, col + 128, b0, b1); }
};

template <class Epi, class Sched, bool ALIGN_EPI = false, bool SP2 = false>
__device__ __forceinline__ void gemm_phase(PG8_LAS unsigned char* lds, const Gemm g, const Sched& S, const Epi& E) {
    const int tid = threadIdx.x, wid = __builtin_amdgcn_readfirstlane(tid >> 6), lane = tid & 63, wr = wid >> 2, wc = wid & 3, fr = lane & 15, fq = lane >> 4;
    const int K = g.K, nt = K / BK;
    unsigned voffA[2], voffB[2];
#pragma unroll
    for (int i = 0; i < 2; ++i) { int R, C; stage_rc(tid * 16 + i * 8192, R, C); const int Rb = Epi::PERM ? ((R & ~31) + perm32(R & 31)) : R;
        voffA[i] = (unsigned)(R * K + C) * 2u; voffB[i] = (unsigned)(Rb * K + C) * 2u; }
    const size_t kstep = (size_t)(BK * 2);
    const size_t hstep = (size_t)HALF * K * 2;
    const size_t tstep = 2 * hstep;
    const unsigned ldsw = (unsigned)wid * 1024u;
    const int aoff = lds_byte(wr * 64 + fr, fq * 8), boff = lds_byte(wc * 32 + fr, fq * 8);
#define PG8_SA(b, h) (((b) * 2 + (h)) * HTB)
#define PG8_SB(b, h) ((4 + (b) * 2 + (h)) * HTB)
#define PG8_STAGE(bufoff, gbase, voff) do { _Pragma("unroll") for (int _i = 0; _i < 2; ++_i) \
        __builtin_amdgcn_global_load_lds((const unsigned*)((const char*)(gbase) + (voff)[_i]), (PG8_LAS unsigned*)(lds + (bufoff) + ldsw + _i * 8192), 16, 0, 0); } while (0)
#define PG8_LDA(dst, b, h) do { _Pragma("unroll") for (int m = 0; m < 4; ++m) _Pragma("unroll") for (int k = 0; k < 2; ++k) dst[m][k] = *(const PG8_LAS bf16x8*)(lds + PG8_SA(b, h) + aoff + m * 2048 + k * 1024); } while (0)
#define PG8_LDB(dst, b, h) do { _Pragma("unroll") for (int n = 0; n < 2; ++n) _Pragma("unroll") for (int k = 0; k < 2; ++k) dst[n][k] = *(const PG8_LAS bf16x8*)(lds + PG8_SB(b, h) + boff + n * 2048 + k * 1024); } while (0)
#define PG8_MMA(ai, bj, At, Bt) do { __builtin_amdgcn_s_setprio(1); _Pragma("unroll") for (int m = 0; m < 4; ++m) _Pragma("unroll") for (int n = 0; n < 2; ++n) _Pragma("unroll") for (int k = 0; k < 2; ++k) \
        acc[ai][bj][m][n] = __builtin_amdgcn_mfma_f32_16x16x32_bf16(Bt[n][k], At[m][k], acc[ai][bj][m][n], 0, 0, 0); __builtin_amdgcn_s_setprio(0); } while (0)
#define PG8_WAIT_V(n) asm volatile("s_waitcnt vmcnt(" #n ")" ::: "memory")
#define PG8_WAIT_L(n) asm volatile("s_waitcnt lgkmcnt(" #n ")" ::: "memory")
#define PG8_BAR __builtin_amdgcn_s_barrier()
#define PG8_SCHED __builtin_amdgcn_sched_barrier(0)
    Unit cur, nxt; int ui = 0;
    if (!S.next(0, cur)) return;
    f32x4 acc[2][2][4][2];
#pragma unroll
    for (int a = 0; a < 2; ++a)
#pragma unroll
        for (int b = 0; b < 2; ++b)
#pragma unroll
            for (int m = 0; m < 4; ++m)
#pragma unroll
                for (int n = 0; n < 2; ++n) acc[a][b][m][n] = (f32x4){0.f, 0.f, 0.f, 0.f};
    bf16x8 At[4][2], B0[2][2], B1[2][2];
    const char* cA = (const char*)g.A + (size_t)cur.pm * tstep; const char* cB = (const char*)g.Bt + (size_t)cur.pn * tstep;
    S.a_ready(cur);
    if constexpr (SP2) {
        PG8_STAGE(PG8_SB(0, 0), cB, voffB); PG8_STAGE(PG8_SB(0, 1), cB + hstep, voffB); PG8_STAGE(PG8_SA(0, 0), cA, voffA); PG8_STAGE(PG8_SA(0, 1), cA + hstep, voffA);
        if (wr == 1) PG8_BAR;
        PG8_WAIT_V(2); PG8_BAR;
        PG8_STAGE(PG8_SB(1, 0), cB + kstep, voffB); PG8_STAGE(PG8_SA(1, 0), cA + kstep, voffA); PG8_STAGE(PG8_SB(1, 1), cB + hstep + kstep, voffB);
        PG8_WAIT_V(6); PG8_BAR;
    } else {
        PG8_STAGE(PG8_SB(0, 0), cB, voffB); PG8_STAGE(PG8_SA(0, 0), cA, voffA); PG8_STAGE(PG8_SB(0, 1), cB + hstep, voffB); PG8_STAGE(PG8_SA(0, 1), cA + hstep, voffA);
        if (wr == 1) PG8_BAR;
        PG8_WAIT_V(4); PG8_BAR;
        PG8_STAGE(PG8_SB(1, 0), cB + kstep, voffB); PG8_STAGE(PG8_SA(1, 0), cA + kstep, voffA); PG8_STAGE(PG8_SB(1, 1), cB + hstep + kstep, voffB);
        PG8_WAIT_V(6); PG8_BAR;
    }
    for (;;) {
        const bool has_next = S.next(ui + 1, nxt);
        const char* nA = has_next ? (const char*)g.A + (size_t)nxt.pm * tstep : cA; const char* nB = has_next ? (const char*)g.Bt + (size_t)nxt.pn * tstep : cB;
        for (int t = 0; t < nt; t += 2) {
            const bool last = (t == nt - 2);
            const char* a1 = cA + (size_t)(t + 1) * kstep;
            const char* a2 = last ? nA : cA + (size_t)(t + 2) * kstep; const char* b2 = last ? nB : cB + (size_t)(t + 2) * kstep;
            const char* a3 = a2 + kstep; const char* b3 = b2 + kstep;
            if (last && has_next) S.a_ready(nxt);
            if constexpr (SP2) {
            PG8_LDB(B0, 0, 0); PG8_LDB(B1, 0, 1); PG8_SCHED; PG8_LDA(At, 0, 0); PG8_STAGE(PG8_SA(1, 1), a1 + hstep, voffA);
            PG8_WAIT_V(8); PG8_WAIT_L(0); PG8_BAR; PG8_MMA(0, 0, At, B0); PG8_MMA(0, 1, At, B1); PG8_BAR; PG8_SCHED;
            PG8_LDA(At, 0, 1); PG8_STAGE(PG8_SB(0, 0), b2, voffB); PG8_STAGE(PG8_SB(0, 1), b2 + hstep, voffB); PG8_STAGE(PG8_SA(0, 0), a2, voffA);
            PG8_WAIT_V(8); PG8_WAIT_L(0); PG8_BAR; PG8_MMA(1, 0, At, B0); PG8_MMA(1, 1, At, B1); PG8_BAR; PG8_SCHED;
            PG8_LDB(B0, 1, 0); PG8_LDB(B1, 1, 1); PG8_SCHED; PG8_LDA(At, 1, 0); PG8_STAGE(PG8_SA(0, 1), a2 + hstep, voffA);
            PG8_WAIT_V(8); PG8_WAIT_L(0); PG8_BAR; PG8_MMA(0, 0, At, B0); PG8_MMA(0, 1, At, B1); PG8_BAR; PG8_SCHED;
            PG8_LDA(At, 1, 1); PG8_STAGE(PG8_SB(1, 0), b3, voffB); PG8_STAGE(PG8_SB(1, 1), b3 + hstep, voffB); PG8_STAGE(PG8_SA(1, 0), a3, voffA);
            PG8_WAIT_V(8); PG8_WAIT_L(0); PG8_BAR; PG8_MMA(1, 0, At, B0); PG8_MMA(1, 1, At, B1); PG8_BAR; PG8_SCHED;
            } else {
            PG8_LDB(B0, 0, 0); PG8_SCHED; PG8_LDA(At, 0, 0); PG8_STAGE(PG8_SA(1, 1), a1 + hstep, voffA);
            PG8_WAIT_L(8); PG8_BAR; PG8_WAIT_L(0); PG8_MMA(0, 0, At, B0); PG8_BAR; PG8_SCHED;
            PG8_LDB(B1, 0, 1); PG8_STAGE(PG8_SB(0, 0), b2, voffB);
            PG8_BAR; PG8_WAIT_L(0); PG8_MMA(0, 1, At, B1); PG8_BAR;
            PG8_LDA(At, 0, 1); PG8_STAGE(PG8_SA(0, 0), a2, voffA);
            PG8_BAR; PG8_WAIT_L(0); PG8_MMA(1, 0, At, B0); PG8_BAR; PG8_SCHED;
            PG8_STAGE(PG8_SB(0, 1), b2 + hstep, voffB);
            PG8_WAIT_V(6); PG8_BAR; PG8_MMA(1, 1, At, B1); PG8_BAR;
            PG8_LDB(B0, 1, 0); PG8_SCHED; PG8_LDA(At, 1, 0); PG8_STAGE(PG8_SA(0, 1), a2 + hstep, voffA);
            PG8_WAIT_L(8); PG8_BAR; PG8_WAIT_L(0); PG8_MMA(0, 0, At, B0); PG8_BAR; PG8_SCHED;
            PG8_LDB(B1, 1, 1); PG8_STAGE(PG8_SB(1, 0), b3, voffB);
            PG8_BAR; PG8_WAIT_L(0); PG8_MMA(0, 1, At, B1); PG8_BAR;
            PG8_LDA(At, 1, 1); PG8_STAGE(PG8_SA(1, 0), a3, voffA);
            PG8_BAR; PG8_WAIT_L(0); PG8_MMA(1, 0, At, B0); PG8_BAR; PG8_SCHED;
            PG8_STAGE(PG8_SB(1, 1), b3 + hstep, voffB);
            PG8_WAIT_V(6); PG8_BAR; PG8_MMA(1, 1, At, B1); PG8_BAR;
            }
        }
        if constexpr (ALIGN_EPI) { if (wr == 0) PG8_BAR; }
        if constexpr (!Epi::AFTER_DRAIN) { E(acc, cur, wr, wc, fr, fq); S.done(cur); }
        if (!has_next) break;
#pragma unroll
        for (int a = 0; a < 2; ++a)
#pragma unroll
            for (int b = 0; b < 2; ++b)
#pragma unroll
                for (int m = 0; m < 4; ++m)
#pragma unroll
                    for (int n = 0; n < 2; ++n) acc[a][b][m][n] = (f32x4){0.f, 0.f, 0.f, 0.f};
        cur = nxt; cA = nA; cB = nB; ++ui;
        if constexpr (ALIGN_EPI) { if (wr == 1) PG8_BAR; }
    }
    PG8_WAIT_V(0);
    if constexpr (!ALIGN_EPI) { if (wr == 0) PG8_BAR; }
    PG8_BAR;
    if constexpr (Epi::AFTER_DRAIN) { E.fused(acc, cur, wr, wc, fr, fq, lds, wid, lane); S.done(cur); }
#undef PG8_SA
#undef PG8_SB
#undef PG8_STAGE
#undef PG8_LDA
#undef PG8_LDB
#undef PG8_MMA
#undef PG8_WAIT_V
#undef PG8_WAIT_L
#undef PG8_BAR
#undef PG8_SCHED
}
}

namespace attn {
typedef unsigned short bf16;
using bf16x8 = __attribute__((ext_vector_type(8))) short;
using s16x4  = __attribute__((ext_vector_type(4))) short;
using f32x16 = __attribute__((ext_vector_type(16))) float;
using u32x4  = __attribute__((ext_vector_type(4))) unsigned;
constexpr int D = 128, NW = 8, QBLK = 32, KVBLK = 64;
constexpr float SCALE = 0.088388347648318440f;
constexpr float THR = 8.f;
constexpr int LDQ = 1024, LDK = 256, LDO = 1024;
constexpr size_t SHM_V = KVBLK * D * 2, SHM_K = KVBLK * D * 2, SHM_ATTN = 2 * SHM_V + 2 * SHM_K + NW * 64 * 4;
#define KSWZ(row, colB) ((row) * 256 + ((colB) ^ (((row) & 7) << 4)))
#define SBAR() __builtin_amdgcn_sched_barrier(0)
__device__ __forceinline__ int crow(int r, int hi) { return (r & 3) + 8 * (r >> 2) + 4 * hi; }
__device__ __forceinline__ unsigned cvtpk(float lo, float hi) { unsigned r; asm volatile("v_cvt_pk_bf16_f32 %0, %1, %2" : "=v"(r) : "v"(lo), "v"(hi)); return r; }
__device__ __forceinline__ bf16x8 ld8(const bf16* p) { return *reinterpret_cast<const bf16x8*>(p); }

__device__ __forceinline__ void partialSM(f32x16& p0, f32x16& p1, float& m_reg, float& mn, float& alpha) {
  constexpr float C = SCALE * 1.4426950408889634f;
  float pmax = p0[0]; for (int r = 1; r < 16; ++r) pmax = fmaxf(pmax, p0[r]); for (int r = 0; r < 16; ++r) pmax = fmaxf(pmax, p1[r]);
  { auto rr = __builtin_amdgcn_permlane32_swap(__float_as_uint(pmax), __float_as_uint(pmax), false, false);
    pmax = fmaxf(__uint_as_float(rr[0]), __uint_as_float(rr[1])); }
  if (__builtin_expect(__all(pmax - m_reg <= THR / SCALE), 1)) { mn = m_reg; alpha = 1.f; }
  else { mn = fmaxf(m_reg, pmax); alpha = __builtin_amdgcn_exp2f((m_reg - mn) * C); m_reg = mn; }
  float mnC = -mn * C;
  for (int r = 0; r < 16; ++r) p0[r] = fmaf(p0[r], C, mnC); for (int r = 0; r < 16; ++r) p1[r] = fmaf(p1[r], C, mnC);
  for (int r = 0; r < 16; ++r) p0[r] = __builtin_amdgcn_exp2f(p0[r]);
}
__device__ __forceinline__ void finishSM(f32x16& p0, f32x16& p1, float alpha, float& l_reg, bf16x8& pa0, bf16x8& pa1, bf16x8& pa2, bf16x8& pa3) {
  for (int r = 0; r < 16; ++r) p1[r] = __builtin_amdgcn_exp2f(p1[r]);
  float ps = 0; for (int r = 0; r < 16; ++r) ps += p0[r]; for (int r = 0; r < 16; ++r) ps += p1[r];
  { auto rr = __builtin_amdgcn_permlane32_swap(__float_as_uint(ps), __float_as_uint(ps), false, false);
    ps = __uint_as_float(rr[0]) + __uint_as_float(rr[1]); }
  l_reg = l_reg * alpha + ps;
#define PK4(P, BASE, OUT) do { unsigned a0 = cvtpk(P[BASE + 0], P[BASE + 1]), a1 = cvtpk(P[BASE + 2], P[BASE + 3]);   \
    unsigned b0 = cvtpk(P[BASE + 4], P[BASE + 5]), b1 = cvtpk(P[BASE + 6], P[BASE + 7]);                              \
    auto r0 = __builtin_amdgcn_permlane32_swap(a0, b0, false, false); auto r1 = __builtin_amdgcn_permlane32_swap(a1, b1, false, false); \
    u32x4 w = {r0[0], r1[0], r0[1], r1[1]}; OUT = *reinterpret_cast<bf16x8*>(&w); } while (0)
  PK4(p0, 0, pa0); PK4(p0, 8, pa1); PK4(p1, 0, pa2); PK4(p1, 8, pa3);
#undef PK4
}
__device__ __forceinline__ void qkt(f32x16& p0, f32x16& p1, const bf16* Ks, const bf16x8* qr, int r32, int hi) {
  p0 = f32x16{}; p1 = f32x16{};
  for (int d0 = 0; d0 < 8; ++d0) { int cb = (d0 * 16 + hi * 8) * 2;
    bf16x8 b0 = *reinterpret_cast<const bf16x8*>((const char*)Ks + KSWZ(r32, cb));
    bf16x8 b1 = *reinterpret_cast<const bf16x8*>((const char*)Ks + KSWZ(32 + r32, cb));
    p0 = __builtin_amdgcn_mfma_f32_32x32x16_bf16(b0, qr[d0], p0, 0, 0, 0);
    p1 = __builtin_amdgcn_mfma_f32_32x32x16_bf16(b1, qr[d0], p1, 0, 0, 0); }
}
__device__ __forceinline__ int v_st(int k, int c) { const int kk = (k & ~0xC) | ((k & 4) << 1) | ((k & 8) >> 1); return ((kk >> 3) * 4 + (c >> 5)) * 512 + ((kk & 7) * 32 + (c & 31)) * 2; }
__device__ __forceinline__ int v_rd_base(int lane) { return ((lane & 3) << 3) | (((lane >> 2) & 3) << 6) | (((lane >> 4) & 1) << 5) | (((lane >> 5) & 1) << 8); }
constexpr int v_rd_off(int d0, int ks, int half) { return d0 * 512 + ks * 4096 + half * 2048; }
template <int OFF> __device__ __forceinline__ s16x4 tr_read(int vb) {
  s16x4 r; asm volatile("ds_read_b64_tr_b16 %0, %1 offset:%2" : "=&v"(r) : "v"(vb), "i"(OFF) : "memory"); return r;
}
template <int D0> __device__ __forceinline__ void pv_one(f32x16& od, int vb, bf16x8 pa0, bf16x8 pa1, bf16x8 pa2, bf16x8 pa3) {
  const s16x4 l0 = tr_read<v_rd_off(D0, 0, 0)>(vb), h0 = tr_read<v_rd_off(D0, 0, 1)>(vb), l1 = tr_read<v_rd_off(D0, 1, 0)>(vb), h1 = tr_read<v_rd_off(D0, 1, 1)>(vb);
  const s16x4 l2 = tr_read<v_rd_off(D0, 2, 0)>(vb), h2 = tr_read<v_rd_off(D0, 2, 1)>(vb), l3 = tr_read<v_rd_off(D0, 3, 0)>(vb), h3 = tr_read<v_rd_off(D0, 3, 1)>(vb);
  asm volatile("s_waitcnt lgkmcnt(0)" ::: "memory"); SBAR();
#define PK(L, H) (bf16x8){L[0], L[1], L[2], L[3], H[0], H[1], H[2], H[3]}
  od = __builtin_amdgcn_mfma_f32_32x32x16_bf16(pa0, PK(l0, h0), od, 0, 0, 0);
  od = __builtin_amdgcn_mfma_f32_32x32x16_bf16(pa1, PK(l1, h1), od, 0, 0, 0);
  od = __builtin_amdgcn_mfma_f32_32x32x16_bf16(pa2, PK(l2, h2), od, 0, 0, 0);
  od = __builtin_amdgcn_mfma_f32_32x32x16_bf16(pa3, PK(l3, h3), od, 0, 0, 0);
#undef PK
}
__device__ __forceinline__ void pv_d0(f32x16* o, int vb, bf16x8 pa0, bf16x8 pa1, bf16x8 pa2, bf16x8 pa3) {
  pv_one<0>(o[0], vb, pa0, pa1, pa2, pa3); pv_one<1>(o[1], vb, pa0, pa1, pa2, pa3); pv_one<2>(o[2], vb, pa0, pa1, pa2, pa3); pv_one<3>(o[3], vb, pa0, pa1, pa2, pa3);
}
__device__ __forceinline__ void attn_dense_body(const bf16* __restrict__ Qb, const bf16* __restrict__ Kh, const bf16* __restrict__ Vh,
                                                bf16* __restrict__ Ob, int seq, char* lds) {
  constexpr int SDEPTH = 2;
  const int tid = threadIdx.x, wid = tid >> 6, lane = tid & 63, r32 = lane & 31, hi = lane >> 5;
  bf16* V_lds = (bf16*)lds; bf16* K_lds = (bf16*)(lds + 2 * SHM_V);
  float* ws = (float*)(lds + 2 * SHM_V + 2 * SHM_K) + wid * 64; float* li_l = ws; float* al_l = ws + 32;
  float m_reg = -1e30f, l_reg = 0; f32x16 o[4] = {}; bf16x8 qr[8];
  const bf16* Qw = Qb + (long)(wid * QBLK + r32) * LDQ + hi * 8;
#pragma unroll
  for (int d0 = 0; d0 < 8; ++d0) qr[d0] = ld8(Qw + d0 * 16);
  const int sr = tid >> 4, sc = (tid & 15) * 8, vst0 = v_st(sr, sc), vst1 = v_st(32 + sr, sc);
  const int vb0 = (int)(uintptr_t)V_lds + v_rd_base(lane);
  struct { bf16x8 vs0, vs1, ks0, ks1; } sr_[SDEPTH];
#define SLOAD(i, k0) do { sr_[i].vs0 = ld8(&Vh[(long)((k0) + sr) * LDK + sc]); sr_[i].vs1 = ld8(&Vh[(long)((k0) + 32 + sr) * LDK + sc]); \
    sr_[i].ks0 = ld8(&Kh[(long)((k0) + sr) * LDK + sc]); sr_[i].ks1 = ld8(&Kh[(long)((k0) + 32 + sr) * LDK + sc]); } while (0)
#define SWRITE(b, i) do { *(bf16x8*)((char*)V_lds + (b) * SHM_V + vst0) = sr_[i].vs0;          \
    *(bf16x8*)((char*)V_lds + (b) * SHM_V + vst1) = sr_[i].vs1; int kc = sc * 2;               \
    *(bf16x8*)((char*)K_lds + (b) * SHM_K + KSWZ(sr, kc)) = sr_[i].ks0;                       \
    *(bf16x8*)((char*)K_lds + (b) * SHM_K + KSWZ(32 + sr, kc)) = sr_[i].ks1; } while (0)
#define SWAIT() do { asm volatile("s_waitcnt vmcnt(4)" ::: "memory"); } while (0)
#define RESC(a) do { if (__any((a) < 1.f)) { if (hi == 0) al_l[r32] = (a); asm volatile("s_waitcnt lgkmcnt(0)" ::: "memory"); \
    for (int d = 0; d < 4; ++d) for (int r = 0; r < 16; ++r) o[d][r] *= al_l[crow(r, hi)]; } } while (0)
  f32x16 pA0, pA1, pB0, pB1; float mnA, mnB, alA, alB; bf16x8 pa0, pa1, pa2, pa3; const int NT = seq / KVBLK;
  constexpr int SE = 0, SO = SDEPTH - 1;
  SLOAD(SE, 0); asm volatile("s_waitcnt vmcnt(0)" ::: "memory"); SWRITE(0, SE); __syncthreads();
  qkt(pA0, pA1, K_lds, qr, r32, hi); partialSM(pA0, pA1, m_reg, mnA, alA);
  SLOAD(SO, KVBLK); if (2 < NT) SLOAD(SE, 2 * KVBLK);
  SWAIT(); SWRITE(1, SO); __syncthreads();
  for (int j = 1; j + 1 < NT; j += 2) {
    SBAR(); qkt(pB0, pB1, (bf16*)((char*)K_lds + SHM_K), qr, r32, hi);
    finishSM(pA0, pA1, alA, l_reg, pa0, pa1, pa2, pa3); SBAR();
    SLOAD(SO, (j + SDEPTH) * KVBLK); SBAR();
    pv_d0(o, vb0, pa0, pa1, pa2, pa3); partialSM(pB0, pB1, m_reg, mnB, alB);
    __syncthreads(); SWAIT(); SWRITE(0, SE);
    RESC(alB); __syncthreads();
    SBAR(); qkt(pA0, pA1, K_lds, qr, r32, hi);
    finishSM(pB0, pB1, alB, l_reg, pa0, pa1, pa2, pa3); SBAR();
    if (j + 3 < NT) SLOAD(SE, (j + 1 + SDEPTH) * KVBLK); SBAR();
    pv_d0(o, vb0 + (int)SHM_V, pa0, pa1, pa2, pa3); partialSM(pA0, pA1, m_reg, mnA, alA);
    __syncthreads(); SWAIT(); SWRITE(1, SO);
    RESC(alA); __syncthreads();
  }
  SBAR(); qkt(pB0, pB1, (bf16*)((char*)K_lds + SHM_K), qr, r32, hi);
  finishSM(pA0, pA1, alA, l_reg, pa0, pa1, pa2, pa3); SBAR();
  pv_d0(o, vb0, pa0, pa1, pa2, pa3); partialSM(pB0, pB1, m_reg, mnB, alB);
  __syncthreads(); RESC(alB);
  finishSM(pB0, pB1, alB, l_reg, pa0, pa1, pa2, pa3); SBAR();
  pv_d0(o, vb0 + (int)SHM_V, pa0, pa1, pa2, pa3);
  if (hi == 0) li_l[r32] = l_reg; asm volatile("s_waitcnt lgkmcnt(0)" ::: "memory");
  float rli[16];
#pragma unroll
  for (int r = 0; r < 16; ++r) rli[r] = __builtin_amdgcn_rcpf(li_l[crow(r, hi)]);
  bf16* Ow = Ob + (long)(wid * QBLK) * LDO;
#pragma unroll
  for (int r = 0; r < 16; ++r) { int orow = crow(r, hi);
    for (int d0 = 0; d0 < 4; ++d0) { const float v = o[d0][r] * rli[r]; const unsigned u = __float_as_uint(v);
      Ow[(long)orow * LDO + d0 * 32 + r32] = (bf16)((u + 0x7fffu + ((u >> 16) & 1u)) >> 16); } }
#undef SLOAD
#undef SWRITE
#undef SWAIT
#undef RESC
}
#undef KSWZ
#undef SBAR
}

#define LAS __attribute__((address_space(3)))
typedef unsigned short bf16;
typedef unsigned v4u __attribute__((ext_vector_type(4)));
typedef unsigned v2u __attribute__((ext_vector_type(2)));
typedef float f32x4 __attribute__((ext_vector_type(4)));
typedef float f32x2 __attribute__((ext_vector_type(2)));

constexpr size_t HM = 1u << 19;
constexpr size_t WS_MOD = 2 * HM;
constexpr size_t WS_WAB = 4 * HM, WS_WABO = 21 * HM, WS_WFI0 = 25 * HM, WS_WFI1 = 47 * HM, WS_WFO0 = 69 * HM, WS_WFO1 = 80 * HM, WS_WQKV = 91 * HM, WS_WAO = 97 * HM;
constexpr size_t WS_XCTX = 102 * HM;
constexpr size_t WS_H = 110 * HM;
constexpr size_t WS_PROJ = 178 * HM;
constexpr size_t SEG = (size_t)M * 512;
constexpr size_t WS_ACT = 178 * HM;
constexpr size_t WS_Q = 178 * HM, WS_K = 246 * HM, WS_V = 263 * HM;
constexpr size_t WS_OG = 280 * HM;
constexpr size_t WS_Y = 382 * HM;
constexpr size_t WS_BG = 450 * HM;
constexpr size_t WS_SXH = 456 * HM, WS_SXM = 469 * HM, WS_GXH = 476 * HM, WS_NXM = 477 * HM, WS_MXM = 478 * HM;
constexpr size_t WS_END = 512 * HM;
static_assert(WS_BG + (size_t)M * 16 * 4 <= WS_END && WS_Y + (size_t)M * DM * 2 <= WS_BG && WS_PROJ + 8 * SEG * 2 == WS_BG, "ws map");
static_assert(WS_ACT + (size_t)M * DFF * 2 <= WS_Y && WS_V + (size_t)M * 256 * 2 <= WS_OG && WS_OG + (size_t)M * DM * 2 <= WS_Y, "ws map 2");

constexpr int LDS_BYTES = 147456;

__device__ __forceinline__ unsigned f2bf(float f) { unsigned u = __builtin_bit_cast(unsigned, f); return (u + 0x7fffu + ((u >> 16) & 1u)) >> 16; }
__device__ __forceinline__ unsigned pk2(float lo, float hi) { return f2bf(lo) | (f2bf(hi) << 16); }
__device__ __forceinline__ float bf2f(unsigned short h) { return __builtin_bit_cast(float, (unsigned)h << 16); }
__device__ __forceinline__ float bflo(unsigned w) { return __builtin_bit_cast(float, w << 16); }
__device__ __forceinline__ float bfhi(unsigned w) { return __builtin_bit_cast(float, w & 0xffff0000u); }
__device__ __forceinline__ float wave_sum(float v) {
#pragma unroll
    for (int o = 1; o < 64; o <<= 1) v += __shfl_xor(v, o);
    return v;
}
__device__ __forceinline__ float sigmoidf_(float x) { return 1.0f / (1.0f + __expf(-x)); }

typedef __attribute__((address_space(1))) unsigned gu32;
#define RLX_AGENT __ATOMIC_RELAXED, __HIP_MEMORY_SCOPE_AGENT
constexpr int MISC_OFF = 131072 + 320;
constexpr size_t WS_CTL = 0, CTL_ZERO_BYTES = 65536;
constexpr int CW_BAR = 1024;
#define XB_TMO      128
#define XB_XCNT(j)  (256  + 64 * (j))
#define XB_XSUB(j)  (1280 + 64 * (j))
#define XB_XGEN(j)  (2304 + 64 * (j))
#define XB_TOP      3328
#define XB_TOPGEN   3392
#define XCD_BAR_WORDS 3456
#define XB_SPIN_CAP (1u << 18)

__device__ __forceinline__ unsigned xb_ld(unsigned* p)              { return __hip_atomic_load(p, __ATOMIC_RELAXED, __HIP_MEMORY_SCOPE_AGENT); }
__device__ __forceinline__ unsigned xb_add(unsigned* p, unsigned v) { return __hip_atomic_fetch_add(p, v, __ATOMIC_RELAXED, __HIP_MEMORY_SCOPE_AGENT); }
__device__ __forceinline__ unsigned xb_xcc_id() { return (unsigned)__builtin_amdgcn_s_getreg((3 << 11) | 20) & 0xFu; }
#define XB_SPIN(cond, bar) do { unsigned _sp = 0; while (cond) { __builtin_amdgcn_s_sleep(1); \
    if ((++_sp & 255u) == 0u) { if (xb_ld(&(bar)[XB_TMO])) break; if (_sp > XB_SPIN_CAP) { atomicAdd(&(bar)[XB_TMO], 1u); break; } } } } while (0)

struct XcdBarrier {
    unsigned* bar; unsigned x;
    volatile LAS unsigned* st;
};

__device__ __forceinline__ XcdBarrier xcd_barrier_post(unsigned* bar, volatile LAS unsigned* st) {
    XcdBarrier b; b.bar = bar; b.x = xb_xcc_id(); b.st = st;
    if (threadIdx.x == 0) (void)xb_add(&bar[XB_XCNT(b.x)], 1u);
    return b;
}
__device__ __forceinline__ void xcd_barrier_complete(unsigned* bar, unsigned x, unsigned& nloc, unsigned& nx) {
    const unsigned G = gridDim.x * gridDim.y * gridDim.z;
    unsigned sum, cnt, mine, sp = 0u;
    for (;;) {
        sum = 0u; cnt = 0u; mine = 0u;
#pragma unroll
        for (unsigned j = 0; j < 16; ++j) { const unsigned c = xb_ld(&bar[XB_XCNT(j)]); sum += c; cnt += (c > 0u) ? 1u : 0u; mine = (j == x) ? c : mine; }
        if (sum == G) break;
        __builtin_amdgcn_s_sleep(1);
        if ((++sp & 255u) == 0u) { if (xb_ld(&bar[XB_TMO])) break; if (sp > XB_SPIN_CAP) { atomicAdd(&bar[XB_TMO], 1u); break; } }
    }
    nloc = mine > 0u ? mine : 1u; nx = cnt > 0u ? cnt : 1u;
}

__device__ __forceinline__ void xcd_barrier(const XcdBarrier& b) {
    asm volatile("s_waitcnt vmcnt(0)" ::: "memory");
    __syncthreads();
    if (threadIdx.x == 0) {
        unsigned* bar = b.bar;
        __builtin_amdgcn_s_waitcnt(0);
        unsigned nloc = b.st[0], nx = b.st[1];
        if (nloc == 0u) { xcd_barrier_complete(bar, b.x, nloc, nx); b.st[0] = nloc; b.st[1] = nx; }
        const unsigned old = xb_add(&bar[XB_XSUB(b.x)], 1u);
        const unsigned gen = old / nloc;
        if (old + 1u == (gen + 1u) * nloc) {
            __builtin_amdgcn_fence(__ATOMIC_RELEASE, "agent");
            asm volatile("s_waitcnt vmcnt(0)" ::: "memory");
            const unsigned og = xb_add(&bar[XB_TOP], 1u);
            const unsigned tg = og / nx;
            if (og + 1u == (tg + 1u) * nx) xb_add(&bar[XB_TOPGEN], 1u);
            else XB_SPIN(xb_ld(&bar[XB_TOPGEN]) == tg, bar);
            __builtin_amdgcn_fence(__ATOMIC_ACQUIRE, "agent");
            xb_add(&bar[XB_XGEN(b.x)], 1u);
            asm volatile("s_waitcnt vmcnt(0)" ::: "memory");
        } else {
            XB_SPIN(xb_ld(&bar[XB_XGEN(b.x)]) == gen, bar);
            __builtin_amdgcn_fence(__ATOMIC_ACQUIRE, "agent");
            asm volatile("s_waitcnt vmcnt(0)" ::: "memory");
        }
    }
    __syncthreads();
}

struct Frame {
    LAS unsigned char* lds;
    int tid, lane, wave, G;
    const float* in[18]; float* out; unsigned char* ws;
    float* MOD; float* XCTX; bf16* H; bf16* PROJ; float* BG; bf16* OG; bf16* Y; bf16* ACT; bf16 *Q, *K, *V;
    bf16 *WAB, *WABO, *WFI0, *WFI1, *WFO0, *WFO1, *WQKV, *WAO;
};
enum { I_X = 0, I_C, I_CTX, I_CCTX, I_ADAW, I_ADAB, I_NORMG, I_FWIN, I_FWOUT, I_ABWIN, I_CONV, I_GATEB, I_LB, I_OUTG, I_ABWOUT, I_WQKV, I_QKG, I_AWOUT };

__device__ __forceinline__ int drow_of(int mode, int n0) { if (mode == 0) return n0; const int j = n0 < DFF ? n0 : n0 - DFF; return (j >> 7) * 256 + (n0 < DFF ? 0 : 128) + (j & 127); }
__device__ __forceinline__ void p0_transpose_item(const float* W, int K, int N, bf16* WT, int mode, LAS float* scr, int item, int lane) {
    const int nblk = (N + 31) / 32, kb = item / nblk, nb = item % nblk, k0 = 64 * kb, n0 = 32 * nb;
    const int n = n0 + (lane & 31); const bool ok = n < N;
    float tv[32];
#pragma unroll
    for (int i = 0; i < 32; ++i) { const int kk = 2 * i + (lane >> 5); tv[i] = ok ? W[(size_t)(k0 + kk) * N + n] : 0.f; }
#pragma unroll
    for (int i = 0; i < 32; ++i) { const int kk = 2 * i + (lane >> 5); scr[kk * 33 + (lane & 31)] = tv[i]; }
    asm volatile("s_waitcnt lgkmcnt(0)" ::: "memory");
    const int c = lane & 7; const int dr = drow_of(mode, n0);
#pragma unroll
    for (int j = 0; j < 4; ++j) { const int nn = (lane >> 3) + 8 * j; const LAS float* s = scr + (8 * c) * 33 + nn;
        v4u o; o.x = pk2(s[0 * 33], s[1 * 33]); o.y = pk2(s[2 * 33], s[3 * 33]); o.z = pk2(s[4 * 33], s[5 * 33]); o.w = pk2(s[6 * 33], s[7 * 33]);
        *(v4u*)(WT + (size_t)(dr + nn) * K + k0 + 8 * c) = o; }
    asm volatile("s_waitcnt lgkmcnt(0)" ::: "memory");
}
__device__ __forceinline__ void p0_prologue(Frame& F) {
    const int tid = F.tid, lane = F.lane, w = F.wave;
    if (blockIdx.x < 96) {
        LAS float* sc = (LAS float*)F.lds; LAS float* part = sc + 5120;
        for (int i = tid; i < 5120; i += 512) { const int j = i >> 10, k = i & 1023; const float v = j < 4 ? F.in[I_C][j * 1024 + k] : F.in[I_CCTX][k]; sc[i] = v * sigmoidf_(v); }
        __syncthreads();
        const int l = blockIdx.x / 48, col0 = (blockIdx.x % 48) * 128;
        const float* wp = F.in[I_ADAW] + ((size_t)l * 1024 + 128 * w) * 6144 + col0 + 2 * lane;
        float acc[5][2];
#pragma unroll
        for (int j = 0; j < 5; ++j) { acc[j][0] = 0.f; acc[j][1] = 0.f; }
        for (int k0 = 0; k0 < 128; k0 += 32) { f32x2 wv[32];
#pragma unroll
            for (int kk = 0; kk < 32; ++kk) wv[kk] = *(const f32x2*)(wp + (size_t)(k0 + kk) * 6144);
#pragma unroll
            for (int kk = 0; kk < 32; ++kk) {
#pragma unroll
                for (int j = 0; j < 5; ++j) { const float s = sc[j * 1024 + 128 * w + k0 + kk]; acc[j][0] += s * wv[kk].x; acc[j][1] += s * wv[kk].y; } } }
#pragma unroll
        for (int j = 0; j < 5; ++j) { part[(w * 5 + j) * 128 + 2 * lane] = acc[j][0]; part[(w * 5 + j) * 128 + 2 * lane + 1] = acc[j][1]; }
        __syncthreads();
        for (int i = tid; i < 640; i += 512) { const int j = i >> 7, cc = i & 127; float s = 0.f;
#pragma unroll
            for (int ww = 0; ww < 8; ++ww) s += part[(ww * 5 + j) * 128 + cc];
            F.MOD[(size_t)(l * 5 + j) * 6144 + col0 + cc] = s + F.in[I_ADAB][l * 6144 + col0 + cc]; }
        __syncthreads();
    }
    LAS float* scr = (LAS float*)(F.lds + w * 16384);
    const int gw = blockIdx.x * 8 + w, NGW = F.G * 8;
    constexpr int I_AB = 16 * 129, I_ABO = 16 * 32, I_FI = 16 * 176, I_FO = 44 * 32, I_QK = 16 * 48, I_AO = 16 * 32;
    constexpr int NITEMS = I_AB + I_ABO + 2 * I_FI + 2 * I_FO + I_QK + I_AO;
    for (int it = gw; it < NITEMS; it += NGW) {
        int r = it;
        if (r < I_AB) { p0_transpose_item(F.in[I_ABWIN], 1024, NAB, F.WAB, 0, scr, r, lane); continue; } r -= I_AB;
        if (r < I_ABO) { p0_transpose_item(F.in[I_ABWOUT], 1024, 1024, F.WABO, 0, scr, r, lane); continue; } r -= I_ABO;
        if (r < I_FI) { p0_transpose_item(F.in[I_FWIN], 1024, 2 * DFF, F.WFI0, 1, scr, r, lane); continue; } r -= I_FI;
        if (r < I_FI) { p0_transpose_item(F.in[I_FWIN] + (size_t)1024 * 2 * DFF, 1024, 2 * DFF, F.WFI1, 1, scr, r, lane); continue; } r -= I_FI;
        if (r < I_FO) { p0_transpose_item(F.in[I_FWOUT], DFF, 1024, F.WFO0, 0, scr, r, lane); continue; } r -= I_FO;
        if (r < I_FO) { p0_transpose_item(F.in[I_FWOUT] + (size_t)DFF * 1024, DFF, 1024, F.WFO1, 0, scr, r, lane); continue; } r -= I_FO;
        if (r < I_QK) { p0_transpose_item(F.in[I_WQKV], 1024, NQKV, F.WQKV, 0, scr, r, lane); continue; } r -= I_QK;
        p0_transpose_item(F.in[I_AWOUT], 1024, 1024, F.WAO, 0, scr, r, lane);
    }
    { const int gt = blockIdx.x * 512 + tid, NT_ = F.G * 512; const int n16 = (NABP - 4128) * 1024 * 2 / 16; v4u z = {0u, 0u, 0u, 0u};
      for (int i = gt; i < n16; i += NT_) *((v4u*)(F.WAB + (size_t)4128 * 1024) + i) = z; }
}

constexpr int RB = 4;
template <bool HAS_Y, bool WRITE_X, bool HAS_NEXT, bool LAT_ONLY>
__device__ __forceinline__ void rowpass(const Frame& F, const float* xs_lat, const float* xs_ctx, float* xd_lat, float* xd_ctx,
                                        const float* mod_y, int gate_off, const float* gn_y, const float* mod_n, int sh_off, int sc_off, const float* gn_n) {
    const int lane = F.lane, gw = blockIdx.x * 8 + F.wave, NGW = F.G * 8;
    constexpr int NR = LAT_ONLY ? NB * SEQ : M;
    for (int r0 = gw; r0 < NR; r0 += RB * NGW) {
        f32x4 x[RB][4]; v2u yw[RB][4]; int rr[RB], jv[RB]; size_t xo[RB]; bool ok[RB], ic[RB];
#pragma unroll
        for (int q = 0; q < RB; ++q) { const int li = r0 + q * NGW; ok[q] = li < NR; const int lr = ok[q] ? li : r0;
            const int r = LAT_ONLY ? lr + (lr >> 12) * CTX + CTX : lr; const int b = r / TT, tt = r - b * TT; ic[q] = tt < CTX; rr[q] = r; jv[q] = ic[q] ? 4 : b;
            xo[q] = ic[q] ? (size_t)(b * CTX + tt) * DM : (size_t)(b * SEQ + tt - CTX) * DM;
            const float* xs = (ic[q] ? xs_ctx : xs_lat) + xo[q];
            if (ok[q]) {
#pragma unroll
                for (int jj = 0; jj < 4; ++jj) x[q][jj] = *(const f32x4*)(xs + 4 * lane + 256 * jj);
                if (HAS_Y) {
#pragma unroll
                    for (int jj = 0; jj < 4; ++jj) yw[q][jj] = *(const v2u*)(F.Y + (size_t)r * DM + 4 * lane + 256 * jj); } } }
#pragma unroll
        for (int q = 0; q < RB; ++q) { if (!ok[q]) continue;
            const int r = rr[q], j = jv[q];
            if (HAS_Y) {
                f32x4 y[4]; float ss = 0.f;
#pragma unroll
                for (int jj = 0; jj < 4; ++jj) { const v2u w = yw[q][jj];
                    y[jj] = (f32x4){bflo(w.x), bfhi(w.x), bflo(w.y), bfhi(w.y)}; ss += (y[jj][0] * y[jj][0] + y[jj][1] * y[jj][1]) + (y[jj][2] * y[jj][2] + y[jj][3] * y[jj][3]); }
                const float rstd = rsqrtf(wave_sum(ss) * (1.f / DM) + EPS);
#pragma unroll
                for (int jj = 0; jj < 4; ++jj) { const int c = 4 * lane + 256 * jj;
                    const f32x4 g = *(const f32x4*)(mod_y + (size_t)j * 6144 + gate_off + c), gn = *(const f32x4*)(gn_y + c);
                    x[q][jj] = x[q][jj] + g * (y[jj] * rstd * gn); }
            }
            if (WRITE_X) { float* xd = (ic[q] ? xd_ctx : xd_lat) + xo[q];
#pragma unroll
                for (int jj = 0; jj < 4; ++jj) *(f32x4*)(xd + 4 * lane + 256 * jj) = x[q][jj]; }
            if (HAS_NEXT) {
                float ss = 0.f;
#pragma unroll
                for (int jj = 0; jj < 4; ++jj) ss += (x[q][jj][0] * x[q][jj][0] + x[q][jj][1] * x[q][jj][1]) + (x[q][jj][2] * x[q][jj][2] + x[q][jj][3] * x[q][jj][3]);
                const float rstd = rsqrtf(wave_sum(ss) * (1.f / DM) + EPS);
#pragma unroll
                for (int jj = 0; jj < 4; ++jj) { const int c = 4 * lane + 256 * jj;
                    const f32x4 sh = *(const f32x4*)(mod_n + (size_t)j * 6144 + sh_off + c), sc = *(const f32x4*)(mod_n + (size_t)j * 6144 + sc_off + c), gn = *(const f32x4*)(gn_n + c);
                    const f32x4 hv = (x[q][jj] * rstd * gn) * (sc + 1.0f) + sh;
                    v2u o; o.x = pk2(hv[0], hv[1]); o.y = pk2(hv[2], hv[3]);
                    *(v2u*)(F.H + (size_t)r * DM + c) = o; }
            }
        }
    }
}

__device__ __forceinline__ void og_pass(const Frame& F, const bf16* OF, const bf16* OB) {
    const int lane = F.lane, gw = blockIdx.x * 8 + F.wave, NGW = F.G * 8;
    const bf16* GA = F.PROJ + 2 * SEG; const bf16* GB = F.PROJ + 7 * SEG;
    const int c0 = 16 * lane;
    float ogv[16];
#pragma unroll
    for (int i = 0; i < 16; ++i) ogv[i] = F.in[I_OUTG][c0 + i];
    for (int r0 = gw; r0 < M; r0 += RB * NGW) {
        v4u a0[RB], a1[RB], b0[RB], b1[RB], g0[RB], g1[RB]; bool ok[RB];
#pragma unroll
        for (int q = 0; q < RB; ++q) { const int r = r0 + q * NGW; ok[q] = r < M;
            if (ok[q]) { a0[q] = *(const v4u*)(OF + (size_t)r * DM + c0); a1[q] = *(const v4u*)(OF + (size_t)r * DM + c0 + 8);
                b0[q] = *(const v4u*)(OB + (size_t)r * DM + c0); b1[q] = *(const v4u*)(OB + (size_t)r * DM + c0 + 8);
                const bf16* gp = c0 < 512 ? GA + (size_t)r * 512 + c0 : GB + (size_t)r * 512 + (c0 - 512);
                g0[q] = *(const v4u*)gp; g1[q] = *(const v4u*)(gp + 8); } }
#pragma unroll
        for (int q = 0; q < RB; ++q) { if (!ok[q]) continue; const int r = r0 + q * NGW;
            float v[16], gt[16];
#pragma unroll
            for (int i = 0; i < 4; ++i) { v[2 * i] = bflo(a0[q][i]) + bflo(b0[q][i]); v[2 * i + 1] = bfhi(a0[q][i]) + bfhi(b0[q][i]); v[8 + 2 * i] = bflo(a1[q][i]) + bflo(b1[q][i]); v[8 + 2 * i + 1] = bfhi(a1[q][i]) + bfhi(b1[q][i]);
                gt[2 * i] = bflo(g0[q][i]); gt[2 * i + 1] = bfhi(g0[q][i]); gt[8 + 2 * i] = bflo(g1[q][i]); gt[8 + 2 * i + 1] = bfhi(g1[q][i]); }
            float ss = 0.f;
#pragma unroll
            for (int i = 0; i < 16; ++i) ss += v[i] * v[i];
            ss += __shfl_xor(ss, 1); ss += __shfl_xor(ss, 2); ss += __shfl_xor(ss, 4);
            const float rstd = rsqrtf(ss * (1.f / 128.f) + EPS);
            unsigned o[8];
#pragma unroll
            for (int i = 0; i < 8; ++i) o[i] = pk2(v[2 * i] * rstd * ogv[2 * i] * gt[2 * i], v[2 * i + 1] * rstd * ogv[2 * i + 1] * gt[2 * i + 1]);
            *(v4u*)(F.OG + (size_t)r * DM + c0) = (v4u){o[0], o[1], o[2], o[3]}; *(v4u*)(F.OG + (size_t)r * DM + c0 + 8) = (v4u){o[4], o[5], o[6], o[7]};
        }
    }
}

__device__ __forceinline__ void qknorm_pass(const Frame& F) {
    const int lane = F.lane, gw = blockIdx.x * 8 + F.wave, NGW = F.G * 8;
    const float inv = exp2f(-(float)(2 * (lane & 31)) * (13.287712379549449f / 64.f));
    for (int r = gw; r < M; r += NGW) {
        const int b = r / TT, tt = r - b * TT; const bool isctx = tt < CTX;
        float c0 = 1.f, s0 = 0.f, c1 = 1.f, s1 = 0.f;
        if (!isctx) { const int t = tt - CTX; sincosf((float)(t >> 6) * inv, &s0, &c0); sincosf((float)(t & 63) * inv, &s1, &c1); }
        for (int hh = (isctx ? 8 : 0); hh < 10; ++hh) {
            bf16* p = hh < 8 ? F.Q + (size_t)r * 1024 + hh * 128 : F.K + (size_t)r * 256 + (hh - 8) * 128;
            const float* g = F.in[I_QKG] + (hh < 8 ? 0 : 128);
            const float x0 = bf2f(p[lane]), x1 = bf2f(p[64 + lane]);
            const float rstd = rsqrtf(wave_sum(x0 * x0 + x1 * x1) * (1.f / 128.f) + EPS);
            float y0 = x0 * rstd * g[lane], y1 = x1 * rstd * g[64 + lane];
            if (!isctx) { const float p0 = __shfl_xor(y0, 32), p1 = __shfl_xor(y1, 32);
                y0 = lane < 32 ? y0 * c0 - p0 * s0 : y0 * c0 + p0 * s0;
                y1 = lane < 32 ? y1 * c1 - p1 * s1 : y1 * c1 + p1 * s1; }
            p[lane] = (bf16)f2bf(y0); p[64 + lane] = (bf16)f2bf(y1);
        }
    }
}

namespace scan {
typedef short bf16x8 __attribute__((ext_vector_type(8)));
typedef float f32x16 __attribute__((ext_vector_type(16)));
typedef float f32x4 __attribute__((ext_vector_type(4)));
typedef unsigned u32x4 __attribute__((ext_vector_type(4)));
typedef unsigned u32x2 __attribute__((ext_vector_type(2)));
constexpr int NCH = TT / 32;
constexpr int TS = 80;
__device__ __forceinline__ int crow(int r, int hi) { return (r & 3) + 8 * (r >> 2) + 4 * hi; }
__device__ __forceinline__ int kpos(int x) { return (x & ~12) | ((x & 4) << 1) | ((x & 8) >> 1); }
__device__ __forceinline__ unsigned cvtpk(float lo, float hi) { unsigned r; asm volatile("v_cvt_pk_bf16_f32 %0, %1, %2" : "=v"(r) : "v"(lo), "v"(hi)); return r; }
__device__ __forceinline__ bf16x8 pack8(const f32x16& v, int base) {
    u32x4 w; w.x = cvtpk(v[base + 0], v[base + 1]); w.y = cvtpk(v[base + 2], v[base + 3]); w.z = cvtpk(v[base + 4], v[base + 5]); w.w = cvtpk(v[base + 6], v[base + 7]);
    return __builtin_bit_cast(bf16x8, w); }
__device__ __forceinline__ float lo16(unsigned w) { return __builtin_bit_cast(float, w << 16); }
__device__ __forceinline__ float hi16(unsigned w) { return __builtin_bit_cast(float, w & 0xffff0000u); }
__device__ __forceinline__ float xhalf_sum(float v) { auto rr = __builtin_amdgcn_permlane32_swap(__float_as_uint(v), __float_as_uint(v), false, false); return __uint_as_float(rr[0]) + __uint_as_float(rr[1]); }
__device__ __forceinline__ int chunk_row0(int b, int dir, int c) {
    if (c < CTX / 32) return b * TT + (dir ? CTX - 1 - 32 * c : 32 * c);
    const int cc = c - CTX / 32; return b * TT + CTX + (dir ? SEQ - 1 - 32 * cc : 32 * cc);
}
template <int DK> struct Lay {
    static constexpr int RS = DK * 2 + 16;
    static constexpr int Q1 = 0, K1 = 32 * RS, Q2 = 64 * RS, K2T = 96 * RS, VT = K2T + DK * TS, SC = VT + 128 * TS, BYTES = SC + 1024;
};

template <int DK, bool ML, bool STATE_ONLY>
__device__ __forceinline__ void consume(const LAS unsigned char* buf, f32x16 (&S)[DK / 32], LAS float* wpriv, int w, int r32, int hi,
                                        unsigned short* O, int row0, int rstep, int colbase) {
    using L = Lay<DK>; constexpr int DT = DK / 32, NK = DK / 16;
    const LAS unsigned char* q1 = buf + L::Q1 + r32 * L::RS + hi * 16;
    const LAS unsigned char* k1 = buf + L::K1 + r32 * L::RS + hi * 16;
    const LAS unsigned char* q2 = buf + L::Q2 + r32 * L::RS + hi * 16;
    const LAS float* sc = (const LAS float*)(buf + L::SC);
    f32x16 X = {}, o = {};
    float rden[16];
    if (!STATE_ONLY) {
    bf16x8 q2f[NK];
#pragma unroll
    for (int ks = 0; ks < NK; ++ks) { const bf16x8 a = *(const LAS bf16x8*)(k1 + ks * 32), bq = *(const LAS bf16x8*)(q1 + ks * 32);
        X = __builtin_amdgcn_mfma_f32_32x32x16_bf16(a, bq, X, 0, 0, 0); }
#pragma unroll
    for (int ks = 0; ks < NK; ++ks) { q2f[ks] = *(const LAS bf16x8*)(q2 + ks * 32);
        o = __builtin_amdgcn_mfma_f32_32x32x16_bf16(q2f[ks], pack8(S[ks >> 1], (ks & 1) * 8), o, 0, 0, 0); }
    if (ML) {
        const float ct = sc[32 + r32];
        float colsum = 0.f;
#pragma unroll
        for (int g = 0; g < 4; ++g) { const f32x4 av = *(const LAS f32x4*)(sc + 8 * g + 4 * hi);
#pragma unroll
            for (int i = 0; i < 4; ++i) { const int r = 4 * g + i, s = 8 * g + 4 * hi + i; const float p = (s <= r32) ? __expf(av[i] - ct) : 0.f; X[r] *= p; colsum += X[r]; } }
        float qn = 0.f;
#pragma unroll
        for (int ks = 0; ks < NK; ++ks) { const u32x4 qa = __builtin_bit_cast(u32x4, q2f[ks]);
            const f32x4 n0 = *(const LAS f32x4*)(wpriv + 16 * ks + 4 * hi), n1 = *(const LAS f32x4*)(wpriv + 16 * ks + 8 + 4 * hi);
            qn += lo16(qa.x) * n0[0] + hi16(qa.x) * n0[1] + lo16(qa.y) * n0[2] + hi16(qa.y) * n0[3] + lo16(qa.z) * n1[0] + hi16(qa.z) * n1[1] + lo16(qa.w) * n1[2] + hi16(qa.w) * n1[3]; }
        const float den = xhalf_sum(colsum + qn);
        const float rd = 1.0f / fmaxf(fabsf(den), sc[64 + r32]);
        if (hi == 0) wpriv[64 + r32] = rd;
#pragma unroll
        for (int g = 0; g < 4; ++g) { const f32x4 dv = *(const LAS f32x4*)(wpriv + 64 + 8 * g + 4 * hi);
#pragma unroll
            for (int i = 0; i < 4; ++i) rden[4 * g + i] = dv[i]; }
    } else {
#pragma unroll
        for (int r = 0; r < 16; ++r) { if (crow(r, hi) > r32) X[r] = 0.f; }
    }
    }
    const LAS unsigned char* vt = buf + L::VT + (32 * w + r32) * TS + hi * 16;
    const bf16x8 v0 = *(const LAS bf16x8*)(vt), v1 = *(const LAS bf16x8*)(vt + 32);
    if (!STATE_ONLY) {
    o = __builtin_amdgcn_mfma_f32_32x32x16_bf16(pack8(X, 0), v0, o, 0, 0, 0);
    o = __builtin_amdgcn_mfma_f32_32x32x16_bf16(pack8(X, 8), v1, o, 0, 0, 0); }
    const LAS unsigned char* k2 = buf + L::K2T + r32 * TS + hi * 16;
    const float decay = ML ? sc[96] : 1.f;
#pragma unroll
    for (int dt = 0; dt < DT; ++dt) {
        if (ML) { S[dt] = S[dt] * decay; }
        else {
#pragma unroll
            for (int g = 0; g < 4; ++g) { const f32x4 gv = *(const LAS f32x4*)(sc + 32 * dt + 8 * g + 4 * hi);
#pragma unroll
                for (int i = 0; i < 4; ++i) S[dt][4 * g + i] *= gv[i]; } }
        const bf16x8 a0 = *(const LAS bf16x8*)(k2 + dt * 32 * TS), a1 = *(const LAS bf16x8*)(k2 + dt * 32 * TS + 32);
        S[dt] = __builtin_amdgcn_mfma_f32_32x32x16_bf16(a0, v0, S[dt], 0, 0, 0);
        S[dt] = __builtin_amdgcn_mfma_f32_32x32x16_bf16(a1, v1, S[dt], 0, 0, 0);
        if (ML) {
            const u32x4 ua = __builtin_bit_cast(u32x4, a0), ub = __builtin_bit_cast(u32x4, a1);
            float ksum = (lo16(ua.x) + hi16(ua.x)) + (lo16(ua.y) + hi16(ua.y)) + (lo16(ua.z) + hi16(ua.z)) + (lo16(ua.w) + hi16(ua.w))
                       + (lo16(ub.x) + hi16(ub.x)) + (lo16(ub.y) + hi16(ub.y)) + (lo16(ub.z) + hi16(ub.z)) + (lo16(ub.w) + hi16(ub.w));
            ksum = xhalf_sum(ksum);
            if (hi == 0) wpriv[32 * dt + r32] = decay * wpriv[32 * dt + r32] + ksum;
        }
    }
    if (STATE_ONLY) return;
    unsigned short* op = O + colbase + 32 * w + r32;
#pragma unroll
    for (int r = 0; r < 16; ++r) { const float v = ML ? o[r] * rden[r] : o[r]; const unsigned u = __float_as_uint(v);
        op[(long)(row0 + rstep * crow(r, hi)) * DM] = (unsigned short)((u + 0x7fffu + ((u >> 16) & 1u)) >> 16); }
}

struct HgPre { unsigned z[8], q[8], v[8]; };
template <bool LIGHT> __device__ __forceinline__ void hg_load(HgPre& P, const unsigned short* Z, const unsigned short* QA, const unsigned short* VA, int row0, int rstep, int colg, int qd) {
#pragma unroll
    for (int ii = 0; ii < 8; ++ii) { const size_t off = (size_t)(row0 + rstep * (8 * qd + ii)) * 512 + colg;
        P.z[ii] = *(const unsigned*)(Z + off); P.q[ii] = LIGHT ? 0u : *(const unsigned*)(QA + off); P.v[ii] = *(const unsigned*)(VA + off); }
}
template <bool LIGHT> __device__ __forceinline__ void hg_produce(LAS unsigned char* buf, const HgPre& P, float lb0, float lb1, int pw, int cp, int qd, float& gam0, float& gam1) {
    using L = Lay<128>;
    const int d0 = 32 * pw + 2 * cp;
    float q[2][8], k[2][8], Pc[2][8], RP[2][8];
#pragma unroll
    for (int x = 0; x < 2; ++x) { const float lb = x ? lb1 : lb0; float p = 1.f, rp = 1.f;
#pragma unroll
        for (int ii = 0; ii < 8; ++ii) { const float z = x ? hi16(P.z[ii]) : lo16(P.z[ii]); q[x][ii] = x ? hi16(P.q[ii]) : lo16(P.q[ii]);
            const float sg = __builtin_amdgcn_rcpf(1.f + __expf(-z)); const float f = lb + (1.f - lb) * sg; k[x][ii] = (1.f - lb) * (1.f - sg);
            p *= f; rp *= __builtin_amdgcn_rcpf(f); Pc[x][ii] = p; RP[x][ii] = rp; } }
    const int lane = cp + 16 * qd;
    unsigned k2lo[2][2], k2hi[2][2];
#pragma unroll
    for (int x = 0; x < 2; ++x) {
        const float T = Pc[x][7];
        const float T0 = __shfl(T, cp), T1 = __shfl(T, cp + 16), T2 = __shfl(T, cp + 32), T3 = __shfl(T, cp + 48);
        const float emid = T0 * T1, elast = T2 * T3;
        const float scale = qd == 0 ? __builtin_amdgcn_rcpf(emid) : (qd == 1 ? __builtin_amdgcn_rcpf(T1) : (qd == 2 ? 1.f : T2));
        const float rscale = qd == 0 ? emid : (qd == 1 ? T1 : (qd == 2 ? 1.f : __builtin_amdgcn_rcpf(T2)));
#pragma unroll
        for (int ii = 0; ii < 8; ++ii) { const float qt = q[x][ii] * (Pc[x][ii] * scale), kt = k[x][ii] * (RP[x][ii] * rscale);
            q[x][ii] = qt; k[x][ii] = kt; Pc[x][ii] = qt * emid; RP[x][ii] = kt * elast; }
        k2lo[x][0] = cvtpk(RP[x][0], RP[x][1]); k2lo[x][1] = cvtpk(RP[x][2], RP[x][3]); k2hi[x][0] = cvtpk(RP[x][4], RP[x][5]); k2hi[x][1] = cvtpk(RP[x][6], RP[x][7]);
        if (qd == 0) ((LAS float*)(buf + L::SC))[d0 + x] = emid * elast;
        if (x == 0) gam0 *= emid * elast; else gam1 *= emid * elast;
    }
    (void)lane;
    const int pd = ((d0 & ~15) | kpos(d0 & 15)) * 2;
    if (!LIGHT) {
#pragma unroll
    for (int ii = 0; ii < 8; ++ii) { const int i = 8 * qd + ii;
        *(LAS unsigned*)(buf + L::Q1 + i * L::RS + pd) = cvtpk(q[0][ii], q[1][ii]);
        *(LAS unsigned*)(buf + L::K1 + i * L::RS + pd) = cvtpk(k[0][ii], k[1][ii]);
        *(LAS unsigned*)(buf + L::Q2 + i * L::RS + pd) = cvtpk(Pc[0][ii], Pc[1][ii]); } }
    const int ps = (16 * (qd >> 1) + 4 * (qd & 1)) * 2;
#pragma unroll
    for (int x = 0; x < 2; ++x) {
        *(LAS u32x2*)(buf + L::K2T + (d0 + x) * TS + ps) = (u32x2){k2lo[x][0], k2lo[x][1]};
        *(LAS u32x2*)(buf + L::K2T + (d0 + x) * TS + ps + 16) = (u32x2){k2hi[x][0], k2hi[x][1]};
        unsigned a, b2, c2, d2;
        if (x == 0) { a = (P.v[0] & 0xffffu) | (P.v[1] << 16); b2 = (P.v[2] & 0xffffu) | (P.v[3] << 16); c2 = (P.v[4] & 0xffffu) | (P.v[5] << 16); d2 = (P.v[6] & 0xffffu) | (P.v[7] << 16); }
        else { a = (P.v[0] >> 16) | (P.v[1] & 0xffff0000u); b2 = (P.v[2] >> 16) | (P.v[3] & 0xffff0000u); c2 = (P.v[4] >> 16) | (P.v[5] & 0xffff0000u); d2 = (P.v[6] >> 16) | (P.v[7] & 0xffff0000u); }
        *(LAS u32x2*)(buf + L::VT + (d0 + x) * TS + ps) = (u32x2){a, b2};
        *(LAS u32x2*)(buf + L::VT + (d0 + x) * TS + ps + 16) = (u32x2){c2, d2};
    }
}

struct MlPre { unsigned x[10], v[8]; float ig, fg; };
__device__ __forceinline__ void ml_load(MlPre& P, const unsigned short* BQK, const unsigned short* VB, const float* BG, int segrow0, int L, int tq0, int colq, int colv,
                                        int row0, int rstep, int qd, int i32, int gi_i, int gi_f, float gb_i, float gb_f) {
#pragma unroll
    for (int jj = 0; jj < 10; ++jj) { const int t = tq0 - 1 + jj; P.x[jj] = (t >= 0 && t < L) ? *(const unsigned*)(BQK + (size_t)(segrow0 + t) * 512 + colq) : 0u; }
#pragma unroll
    for (int ii = 0; ii < 8; ++ii) P.v[ii] = *(const unsigned*)(VB + (size_t)(row0 + rstep * (8 * qd + ii)) * 512 + colv);
    const size_t gr = (size_t)(row0 + rstep * i32) * 16;
    P.ig = BG[gr + gi_i] + gb_i; P.fg = BG[gr + gi_f] + gb_f;
}
template <bool LIGHT> __device__ __forceinline__ void ml_produce(LAS unsigned char* buf, const MlPre& P, LAS float* ppriv, float& m, float& Bacc, int dir, int pw, int cp, int qd, int lane,
                                           float w00, float w01, float w02, float w10, float w11, float w12) {
    using L = Lay<64>;
    const int i32 = lane & 31;
    const float logf = fminf(P.fg, 0.f) - log1pf(__expf(-fabsf(P.fg)));
    float bh = logf;
#pragma unroll
    for (int o = 1; o < 32; o <<= 1) { const float t = __shfl_up(bh, o, 32); if (i32 >= o) bh += t; }
    const float a = P.ig - bh;
    float pm = a;
#pragma unroll
    for (int o = 1; o < 32; o <<= 1) { const float t = __shfl_up(pm, o, 32); if (i32 >= o) pm = fmaxf(pm, t); }
    const float c = fmaxf(pm, m);
    const float c31 = __shfl(c, 31, 32), bh31 = __shfl(bh, 31, 32);
    const float winter = __expf(m - c), wk = __expf(a - c31), decay = __expf(m - c31), flo = __expf(-(bh + c));
    if (lane < 32) { ppriv[i32] = winter; ppriv[32 + i32] = wk; }
    if (pw == 0 && lane < 32) { LAS float* sc = (LAS float*)(buf + L::SC); sc[i32] = a; sc[32 + i32] = c; sc[64 + i32] = flo; if (i32 == 0) sc[96] = decay; }
    m = bh31 + c31; Bacc += bh31;
    const bool isk = pw >= 2;
    float y[2][8];
    if (!LIGHT || isk) {
#pragma unroll
    for (int mm = 0; mm < 8; ++mm) {
        const float c0v = w00 * lo16(P.x[mm]) + w01 * lo16(P.x[mm + 1]) + w02 * lo16(P.x[mm + 2]);
        const float c1v = w10 * hi16(P.x[mm]) + w11 * hi16(P.x[mm + 1]) + w12 * hi16(P.x[mm + 2]);
        const float s0 = c0v * __builtin_amdgcn_rcpf(1.f + __expf(-c0v)), s1 = c1v * __builtin_amdgcn_rcpf(1.f + __expf(-c1v));
        const int ii = dir ? 7 - mm : mm;
        y[0][ii] = isk ? s0 : s0 * 0.125f; y[1][ii] = isk ? s1 : s1 * 0.125f; } }
    const LAS float* wp = ppriv + (isk ? 32 : 0) + 8 * qd;
    const f32x4 wa = *(const LAS f32x4*)wp, wb = *(const LAS f32x4*)(wp + 4);
    float ws[8] = {wa[0], wa[1], wa[2], wa[3], wb[0], wb[1], wb[2], wb[3]};
    const int cc = (32 * pw + 2 * cp) & 63;
    const int ps = (16 * (qd >> 1) + 4 * (qd & 1)) * 2;
    if (!isk) {
      if (!LIGHT) {
        const int pd = ((cc & ~15) | kpos(cc & 15)) * 2;
#pragma unroll
        for (int ii = 0; ii < 8; ++ii) { const int i = 8 * qd + ii;
            *(LAS unsigned*)(buf + L::Q1 + i * L::RS + pd) = cvtpk(y[0][ii], y[1][ii]);
            *(LAS unsigned*)(buf + L::Q2 + i * L::RS + pd) = cvtpk(y[0][ii] * ws[ii], y[1][ii] * ws[ii]); } }
    } else {
        const int pd = ((cc & ~15) | kpos(cc & 15)) * 2;
#pragma unroll
        for (int ii = 0; ii < 8; ++ii) { const int i = 8 * qd + ii; if (!LIGHT) *(LAS unsigned*)(buf + L::K1 + i * L::RS + pd) = cvtpk(y[0][ii], y[1][ii]); }
#pragma unroll
        for (int x = 0; x < 2; ++x) {
            *(LAS u32x2*)(buf + L::K2T + (cc + x) * TS + ps) = (u32x2){cvtpk(y[x][0] * ws[0], y[x][1] * ws[1]), cvtpk(y[x][2] * ws[2], y[x][3] * ws[3])};
            *(LAS u32x2*)(buf + L::K2T + (cc + x) * TS + ps + 16) = (u32x2){cvtpk(y[x][4] * ws[4], y[x][5] * ws[5]), cvtpk(y[x][6] * ws[6], y[x][7] * ws[7])}; }
    }
    const int e0 = 32 * pw + 2 * cp;
#pragma unroll
    for (int x = 0; x < 2; ++x) {
        unsigned a2, b2, c2, d2;
        if (x == 0) { a2 = (P.v[0] & 0xffffu) | (P.v[1] << 16); b2 = (P.v[2] & 0xffffu) | (P.v[3] << 16); c2 = (P.v[4] & 0xffffu) | (P.v[5] << 16); d2 = (P.v[6] & 0xffffu) | (P.v[7] << 16); }
        else { a2 = (P.v[0] >> 16) | (P.v[1] & 0xffff0000u); b2 = (P.v[2] >> 16) | (P.v[3] & 0xffff0000u); c2 = (P.v[4] >> 16) | (P.v[5] & 0xffff0000u); d2 = (P.v[6] >> 16) | (P.v[7] & 0xffff0000u); }
        *(LAS u32x2*)(buf + L::VT + (e0 + x) * TS + ps) = (u32x2){a2, b2};
        *(LAS u32x2*)(buf + L::VT + (e0 + x) * TS + ps + 16) = (u32x2){c2, d2};
    }
}

#define SCAN_BAR() do { asm volatile("s_waitcnt lgkmcnt(0)" ::: "memory"); __builtin_amdgcn_s_barrier(); asm volatile("" ::: "memory"); } while (0)

constexpr int NSEG = 4, CPS = NCH / NSEG;
static_assert(NCH % NSEG == 0 && (CPS - 1) % 3 == 0 && CPS % 2 == 0, "segment geometry");
struct Xch { float* SXH; float* GXH; float* SXM; float* NXM; float* MXM; };
template <int PASS>
__device__ __forceinline__ void run_hgrn(LAS unsigned char* lds, int ch, int seg, const unsigned short* PROJ, const float* hgrn_lb, unsigned short* OF, unsigned short* OB, const Xch X) {
    using L = Lay<128>;
    if (PASS == 0 && seg == NSEG - 1) return;
    const int tid = threadIdx.x, wave = __builtin_amdgcn_readfirstlane(tid >> 6), lane = tid & 63;
    const int b = ch >> 3, h = (ch >> 1) & 3, dir = ch & 1, rstep = dir ? -1 : 1;
    const int c0 = seg * CPS;
    const unsigned short* QA = PROJ; const unsigned short* VA = PROJ + SEG; const unsigned short* Z = PROJ + (3 + dir) * SEG;
    unsigned short* O = dir ? OB : OF;
    if (wave < 4) {
        f32x16 S[4] = {};
        const int r32 = lane & 31, hi = lane >> 5;
        if (PASS == 1 && seg > 0) {
            const float* sx = X.SXH + ((size_t)(ch * 3) * 4 + wave) * 4096 + lane;
#pragma unroll
            for (int dt = 0; dt < 4; ++dt)
#pragma unroll
                for (int r = 0; r < 16; ++r) S[dt][r] = sx[(dt * 16 + r) * 64];
            for (int i = 1; i < seg; ++i) { const float* gam = X.GXH + (size_t)(ch * 3 + i) * 128;
#pragma unroll
                for (int dt = 0; dt < 4; ++dt)
#pragma unroll
                    for (int r = 0; r < 16; ++r) S[dt][r] = S[dt][r] * gam[32 * dt + crow(r, hi)] + sx[(size_t)i * 16384 + (dt * 16 + r) * 64]; }
        }
        SCAN_BAR();
        for (int c = c0; c < c0 + CPS; ++c) {
            consume<128, false, PASS == 0>(lds + (c & 1) * L::BYTES, S, nullptr, wave, r32, hi, O, chunk_row0(b, dir, c), rstep, h * 128);
            SCAN_BAR();
        }
        if (PASS == 0) { float* sx = X.SXH + ((size_t)(ch * 3 + seg) * 4 + wave) * 4096 + lane;
#pragma unroll
            for (int dt = 0; dt < 4; ++dt)
#pragma unroll
                for (int r = 0; r < 16; ++r) sx[(dt * 16 + r) * 64] = S[dt][r]; }
    } else {
        const int pw = wave - 4, cp = lane & 15, qd = lane >> 4, d0 = 32 * pw + 2 * cp, colg = h * 128 + d0;
        float lbv[2];
#pragma unroll
        for (int x = 0; x < 2; ++x) { const float* p = hgrn_lb + (size_t)dir * 3 * 512 + h * 128 + d0 + x; const float a0 = p[0], a1 = p[512], a2 = p[1024];
            const float mx = fmaxf(a0, fmaxf(a1, a2)); const float e0 = __expf(a0 - mx), e1 = __expf(a1 - mx), e2 = __expf(a2 - mx); lbv[x] = e0 / (e0 + e1 + e2); }
        float gam0 = 1.f, gam1 = 1.f;
        HgPre P0, P1, P2;
#define HG_LD(P_, j_) hg_load<PASS == 0>(P_, Z, QA, VA, chunk_row0(b, dir, c0 + (j_)), rstep, colg, qd)
#define HG_STEP(j_, LS, PS) do { if ((j_) + 3 < CPS) HG_LD(LS, (j_) + 3); if ((j_) + 1 < CPS) hg_produce<PASS == 0>(lds + (((j_) + 1) & 1) * L::BYTES, PS, lbv[0], lbv[1], pw, cp, qd, gam0, gam1); SCAN_BAR(); } while (0)
        HG_LD(P0, 0); HG_LD(P1, 1); HG_LD(P2, 2);
        hg_produce<PASS == 0>(lds, P0, lbv[0], lbv[1], pw, cp, qd, gam0, gam1);
        SCAN_BAR();
        for (int j = 0; j < CPS - 1; j += 3) { HG_STEP(j, P0, P1); HG_STEP(j + 1, P1, P2); HG_STEP(j + 2, P2, P0); }
        SCAN_BAR();
#undef HG_LD
#undef HG_STEP
        if (PASS == 0 && qd == 0) { float* g = X.GXH + (size_t)(ch * 3 + seg) * 128 + d0; g[0] = gam0; g[1] = gam1; }
    }
}
template <int PASS>
__device__ __forceinline__ void run_mlstm(LAS unsigned char* lds, int ch, int seg, const unsigned short* PROJ, const float* BG, const float* conv, const float* gate_b, unsigned short* OF, unsigned short* OB, const Xch X) {
    using L = Lay<64>;
    if (PASS == 0 && seg == NSEG - 1) return;
    const int tid = threadIdx.x, wave = __builtin_amdgcn_readfirstlane(tid >> 6), lane = tid & 63;
    const int b = ch >> 3, h = (ch >> 1) & 3, dir = ch & 1, rstep = dir ? -1 : 1;
    const int c0 = seg * CPS;
    const unsigned short* BQK = PROJ + 5 * SEG; const unsigned short* VB = PROJ + 6 * SEG;
    unsigned short* O = dir ? OB : OF;
    LAS float* priv = (LAS float*)(lds + 2 * L::BYTES) + wave * 128;
    float mstart = (PASS == 0) ? (seg == 0 ? 0.f : -1e30f) : 0.f;
    float fa1 = 0.f, fb1 = 0.f, fa2 = 0.f, fb2 = 0.f;
    if (PASS == 1 && seg > 0) { const float* mx = X.MXM + (size_t)(ch * 3) * 2;
        float m = mx[0];
        if (seg > 1) { const float ml = mx[2], B = mx[3]; const float mn = fmaxf(B + m, ml); fa1 = __expf(B + m - mn); fb1 = __expf(ml - mn); m = mn; }
        if (seg > 2) { const float ml = mx[4], B = mx[5]; const float mn = fmaxf(B + m, ml); fa2 = __expf(B + m - mn); fb2 = __expf(ml - mn); m = mn; }
        mstart = m; }
    if (wave < 4) {
        f32x16 S[2] = {};
        const int r32 = lane & 31, hi = lane >> 5;
        float nv = 0.f;
        if (PASS == 1 && seg > 0) {
            const float* sx = X.SXM + ((size_t)(ch * 3) * 4 + wave) * 2048 + lane;
            const float* nx = X.NXM + (size_t)(ch * 3) * 64 + lane;
#pragma unroll
            for (int dt = 0; dt < 2; ++dt)
#pragma unroll
                for (int r = 0; r < 16; ++r) S[dt][r] = sx[(dt * 16 + r) * 64];
            nv = nx[0];
            if (seg > 1) {
#pragma unroll
                for (int dt = 0; dt < 2; ++dt)
#pragma unroll
                    for (int r = 0; r < 16; ++r) S[dt][r] = fa1 * S[dt][r] + fb1 * sx[8192 + (dt * 16 + r) * 64];
                nv = fa1 * nv + fb1 * nx[64]; }
            if (seg > 2) {
#pragma unroll
                for (int dt = 0; dt < 2; ++dt)
#pragma unroll
                    for (int r = 0; r < 16; ++r) S[dt][r] = fa2 * S[dt][r] + fb2 * sx[16384 + (dt * 16 + r) * 64];
                nv = fa2 * nv + fb2 * nx[128]; }
        }
        priv[lane] = nv;
        SCAN_BAR();
        for (int c = c0; c < c0 + CPS; ++c) {
            consume<64, true, PASS == 0>(lds + (c & 1) * L::BYTES, S, priv, wave, r32, hi, O, chunk_row0(b, dir, c), rstep, 512 + h * 128);
            SCAN_BAR();
        }
        if (PASS == 0) { float* sx = X.SXM + ((size_t)(ch * 3 + seg) * 4 + wave) * 2048 + lane;
#pragma unroll
            for (int dt = 0; dt < 2; ++dt)
#pragma unroll
                for (int r = 0; r < 16; ++r) sx[(dt * 16 + r) * 64] = S[dt][r];
            if (wave == 0) X.NXM[(size_t)(ch * 3 + seg) * 64 + lane] = priv[lane]; }
    } else {
        const int pw = wave - 4, cp = lane & 15, qd = lane >> 4, i32 = lane & 31;
        const int cc = 32 * pw + 2 * cp;
        const int colq = cc < 64 ? h * 64 + cc : 256 + h * 64 + (cc - 64);
        const int colv = h * 128 + cc;
        const float w00 = conv[colq], w01 = conv[512 + colq], w02 = conv[1024 + colq], w10 = conv[colq + 1], w11 = conv[512 + colq + 1], w12 = conv[1024 + colq + 1];
        const int gi_i = 4 * (2 * dir) + h, gi_f = 4 * (2 * dir + 1) + h; const float gb_i = gate_b[gi_i], gb_f = gate_b[gi_f];
        float m = mstart, Bacc = 0.f;
        MlPre P0, P1, P2;
#define ML_LOADC(P, j_) do { const int c__ = c0 + (j_); const bool lat = c__ >= CTX / 32; const int Lg = lat ? SEQ : CTX; const int segrow0 = b * TT + (lat ? CTX : 0); \
        const int i0 = 32 * (lat ? c__ - CTX / 32 : c__) + 8 * qd; const int tq0 = dir ? Lg - 1 - (i0 + 7) : i0; \
        ml_load(P, BQK, VB, BG, segrow0, Lg, tq0, colq, colv, chunk_row0(b, dir, c__), rstep, qd, i32, gi_i, gi_f, gb_i, gb_f); } while (0)
#define ML_STEP(j_, LS, PS) do { if ((j_) + 3 < CPS) ML_LOADC(LS, (j_) + 3); if ((j_) + 1 < CPS) ml_produce<PASS == 0>(lds + (((j_) + 1) & 1) * L::BYTES, PS, priv, m, Bacc, dir, pw, cp, qd, lane, w00, w01, w02, w10, w11, w12); SCAN_BAR(); } while (0)
        ML_LOADC(P0, 0); ML_LOADC(P1, 1); ML_LOADC(P2, 2);
        ml_produce<PASS == 0>(lds, P0, priv, m, Bacc, dir, pw, cp, qd, lane, w00, w01, w02, w10, w11, w12);
        SCAN_BAR();
        for (int j = 0; j < CPS - 1; j += 3) { ML_STEP(j, P0, P1); ML_STEP(j + 1, P1, P2); ML_STEP(j + 2, P2, P0); }
        SCAN_BAR();
#undef ML_STEP
#undef ML_LOADC
        if (PASS == 0 && pw == 0 && lane == 0) { float* mx = X.MXM + (size_t)(ch * 3 + seg) * 2; mx[0] = m; mx[1] = Bacc; }
    }
}
#undef SCAN_BAR
}

enum { PH_PRO = 0, PH_MOD0, PH_INPROJ, PH_SCANA, PH_SCAN, PH_OG, PH_OUT0, PH_ROW0A, PH_FFI0, PH_FFO0, PH_ROW0B, PH_QKV, PH_QKN, PH_ATTN, PH_OUT1, PH_ROW1A, PH_FFI1, PH_FFO1, PH_ROW1B, NPH };
struct Args { const float* in[18]; float* out; unsigned char* ws; int ph_lo, ph_hi, variant, pad; };

template <class FN> __device__ __forceinline__ void run_gemm(Frame& F, const bf16* A, const bf16* Bt, int N, int K, int skipctx, const FN& fn) {
    pg8::Gemm g{A, Bt, M, N, K}; pg8::TileOrder S; S.init(skipctx ? 64 : 68, N, F.G, (int)blockIdx.x, skipctx);
    pg8::Epi8<FN> E{fn};
    pg8::gemm_phase<pg8::Epi8<FN>, pg8::TileOrder, true, true>(F.lds, g, S, E);
}

__global__ void __launch_bounds__(512, 2) mk_fwd(Args args) {
    extern __shared__ __attribute__((aligned(16))) unsigned char lds[];
    cg::grid_group grid = cg::this_grid();
    Frame F;
    F.lds = (LAS unsigned char*)lds;
    F.tid = threadIdx.x; F.lane = F.tid & 63; F.wave = __builtin_amdgcn_readfirstlane(F.tid >> 6); F.G = gridDim.x;
#pragma unroll
    for (int i = 0; i < 18; ++i) F.in[i] = args.in[i];
    F.out = args.out; F.ws = args.ws;
    unsigned char* ws = args.ws;
    F.MOD = (float*)(ws + WS_MOD); F.XCTX = (float*)(ws + WS_XCTX); F.H = (bf16*)(ws + WS_H); F.PROJ = (bf16*)(ws + WS_PROJ); F.BG = (float*)(ws + WS_BG);
    F.OG = (bf16*)(ws + WS_OG); F.Y = (bf16*)(ws + WS_Y); F.ACT = (bf16*)(ws + WS_ACT); F.Q = (bf16*)(ws + WS_Q); F.K = (bf16*)(ws + WS_K); F.V = (bf16*)(ws + WS_V);
    F.WAB = (bf16*)(ws + WS_WAB); F.WABO = (bf16*)(ws + WS_WABO); F.WFI0 = (bf16*)(ws + WS_WFI0); F.WFI1 = (bf16*)(ws + WS_WFI1); F.WFO0 = (bf16*)(ws + WS_WFO0); F.WFO1 = (bf16*)(ws + WS_WFO1);
    F.WQKV = (bf16*)(ws + WS_WQKV); F.WAO = (bf16*)(ws + WS_WAO);
    bf16* OF = (bf16*)F.out;
    bf16* OB = F.H;
    const float* MOD0 = F.MOD; const float* MOD1 = F.MOD + 5 * 6144;
    const float* NG = F.in[I_NORMG];
    const int lo = args.ph_lo, hi = args.ph_hi;
    volatile LAS unsigned* MISC = (volatile LAS unsigned*)(F.lds + MISC_OFF);
    if (F.tid < 32) MISC[F.tid] = 0u;
    __syncthreads();
    XcdBarrier bar; bar.bar = (unsigned*)(ws + WS_CTL) + CW_BAR; bar.x = 0; bar.st = nullptr;
    if (MK_ONE) bar = xcd_barrier_post((unsigned*)(ws + WS_CTL) + CW_BAR, MISC + 8);
#define IN(k) (lo <= (k) && (k) < hi)
#define SEAM(k) do { if (IN(k) && IN((k) + 1)) { if ((k) == PH_PRO) grid.sync(); else xcd_barrier(bar); } } while (0)
#define NREP(k) 1
#define PH(k) for (int rep_ = 0; IN(k) && rep_ < NREP(k); (++rep_ < NREP(k)) ? grid.sync() : (void)0)

    PH(PH_PRO) p0_prologue(F);
    SEAM(PH_PRO);
    PH(PH_MOD0) rowpass<false, false, true, false>(F, F.in[I_X], F.in[I_CTX], nullptr, nullptr, nullptr, 0, nullptr, MOD0, 0, 1024, NG + 0);
    SEAM(PH_MOD0);
    PH(PH_INPROJ) run_gemm(F, F.H, F.WAB, NABP, 1024, 0, pg8::FProj{F.PROJ, F.BG});
    SEAM(PH_INPROJ);
    const scan::Xch XC{(float*)(ws + WS_SXH), (float*)(ws + WS_GXH), (float*)(ws + WS_SXM), (float*)(ws + WS_NXM), (float*)(ws + WS_MXM)};
    PH(PH_SCANA) for (int it = blockIdx.x; it < 256; it += F.G) { const int ch = it >> 2, sg = it & 3;
        if (ch < 32) scan::run_hgrn<0>(F.lds, ch, sg, F.PROJ, F.in[I_LB], OF, OB, XC);
        else if (ch < 64) scan::run_mlstm<0>(F.lds, ch - 32, sg, F.PROJ, F.BG, F.in[I_CONV], F.in[I_GATEB], OF, OB, XC); }
    SEAM(PH_SCANA);
    PH(PH_SCAN) for (int it = blockIdx.x; it < 256; it += F.G) { const int ch = it >> 2, sg = it & 3;
        if (ch < 32) scan::run_hgrn<1>(F.lds, ch, sg, F.PROJ, F.in[I_LB], OF, OB, XC);
        else if (ch < 64) scan::run_mlstm<1>(F.lds, ch - 32, sg, F.PROJ, F.BG, F.in[I_CONV], F.in[I_GATEB], OF, OB, XC); }
    SEAM(PH_SCAN);
    PH(PH_OG) og_pass(F, OF, OB);
    SEAM(PH_OG);
    PH(PH_OUT0) run_gemm(F, F.OG, F.WABO, 1024, 1024, 0, pg8::FStore{F.Y, 1024});
    SEAM(PH_OUT0);
    PH(PH_ROW0A) rowpass<true, true, true, false>(F, F.in[I_X], F.in[I_CTX], F.out, F.XCTX, MOD0, 2048, NG + 1024, MOD0, 3072, 4096, NG + 2048);
    SEAM(PH_ROW0A);
    PH(PH_FFI0) run_gemm(F, F.H, F.WFI0, 2 * DFF, 1024, 0, pg8::FSwiglu{F.ACT});
    SEAM(PH_FFI0);
    PH(PH_FFO0) run_gemm(F, F.ACT, F.WFO0, 1024, DFF, 0, pg8::FStore{F.Y, 1024});
    SEAM(PH_FFO0);
    PH(PH_ROW0B) rowpass<true, true, true, false>(F, F.out, F.XCTX, F.out, F.XCTX, MOD0, 5120, NG + 3072, MOD1, 0, 1024, NG + 4096);
    SEAM(PH_ROW0B);
    PH(PH_QKV) run_gemm(F, F.H, F.WQKV, NQKV, 1024, 0, pg8::FQkv{F.Q, F.K, F.V});
    SEAM(PH_QKV);
    PH(PH_QKN) qknorm_pass(F);
    SEAM(PH_QKN);
    PH(PH_ATTN) {
        const int bx = blockIdx.x, vcu = (F.G % 8 == 0) ? (bx % 8) * (F.G / 8) + bx / 8 : bx;
        for (int u = vcu; u < 512; u += F.G) {
            const int uu = (u % 256) * 2 + u / 256;
            const int g = uu & 3, qb = (uu >> 2) & 15, kvh = (uu >> 6) & 1, b = uu >> 7, head = kvh * 4 + g;
            const size_t qrow = (size_t)b * TT + CTX + qb * 256;
            attn::attn_dense_body(F.Q + qrow * 1024 + head * 128, F.K + (size_t)b * TT * 256 + kvh * 128, F.V + (size_t)b * TT * 256 + kvh * 128,
                                  F.OG + qrow * 1024 + head * 128, TT, (char*)lds);
            __syncthreads();
        }
    }
    SEAM(PH_ATTN);
    PH(PH_OUT1) run_gemm(F, F.OG, F.WAO, 1024, 1024, 1, pg8::FStore{F.Y, 1024});
    SEAM(PH_OUT1);
    PH(PH_ROW1A) rowpass<true, true, true, true>(F, F.out, F.XCTX, F.out, F.XCTX, MOD1, 2048, NG + 5120, MOD1, 3072, 4096, NG + 6144);
    SEAM(PH_ROW1A);
    PH(PH_FFI1) run_gemm(F, F.H, F.WFI1, 2 * DFF, 1024, 1, pg8::FSwiglu{F.ACT});
    SEAM(PH_FFI1);
    PH(PH_FFO1) run_gemm(F, F.ACT, F.WFO1, 1024, DFF, 1, pg8::FStore{F.Y, 1024});
    SEAM(PH_FFO1);
    PH(PH_ROW1B) rowpass<true, true, false, true>(F, F.out, F.XCTX, F.out, F.XCTX, MOD1, 5120, NG + 7168, nullptr, 0, 0, nullptr);
#undef IN
#undef SEAM
#undef PH
#undef NREP
}

extern "C" void kernel_launch(void* const* d_in, const int* in_sizes, int n_in, void* d_out, int out_size, void* d_ws, size_t ws_size, hipStream_t stream) {
    static int grid = 0;
    if (grid == 0) {
        if (n_in != 18 || in_sizes[0] != NB * SEQ * DM || out_size != NB * SEQ * DM || ws_size < WS_END) {
            fprintf(stderr, "kernel_launch: unexpected shapes (n_in %d, in0 %d, out %d, ws %zu)\n", n_in, n_in > 0 ? in_sizes[0] : -1, out_size, ws_size); grid = -1; return; }
        int dev = 0, cus = 0, per_cu = 0;
        if (hipGetDevice(&dev) != hipSuccess || hipDeviceGetAttribute(&cus, hipDeviceAttributeMultiprocessorCount, dev) != hipSuccess) { grid = -1; return; }
        if (hipFuncSetAttribute((const void*)mk_fwd, hipFuncAttributeMaxDynamicSharedMemorySize, LDS_BYTES) != hipSuccess) { fprintf(stderr, "kernel_launch: hipFuncSetAttribute failed\n"); grid = -1; return; }
        if (hipOccupancyMaxActiveBlocksPerMultiprocessor(&per_cu, (const void*)mk_fwd, 512, LDS_BYTES) != hipSuccess || per_cu < 1) { fprintf(stderr, "kernel_launch: occupancy query says %d blocks per CU\n", per_cu); per_cu = 1; }
        (void)hipGetLastError();
        grid = cus;
        fprintf(stderr, "kernel_launch: grid %d (occupancy query %d per CU)\n", grid, per_cu);
    }
    if (grid < 0) return;
    if (MK_ONE) { if (hipMemsetAsync((char*)d_ws + WS_CTL, 0, CTL_ZERO_BYTES, stream) != hipSuccess) { fprintf(stderr, "kernel_launch: memset failed\n"); return; } }
    Args a{};
    for (int i = 0; i < 18; ++i) a.in[i] = (const float*)d_in[i];
    a.out = (float*)d_out; a.ws = (unsigned char*)d_ws;
#if MK_ONE
    a.ph_lo = 0; a.ph_hi = NPH;
    void* kargs[] = {&a};
    hipError_t e = hipLaunchCooperativeKernel((const void*)mk_fwd, dim3(grid), dim3(512), kargs, LDS_BYTES, stream);
    if (e != hipSuccess) fprintf(stderr, "kernel_launch: cooperative launch failed: %s (grid %d)\n", hipGetErrorString(e), grid);
#else
    for (int p = 0; p < NPH; ++p) for (int rep = 0; rep < ((((PROBE_REP) >> p) & 1) ? 2 : 1); ++rep) { a.ph_lo = p; a.ph_hi = p + 1; a.variant = rep ? (PROBE_VAR) : 0; hipLaunchKernelGGL(mk_fwd, dim3(grid), dim3(512), LDS_BYTES, stream, a); }
    const hipError_t le = hipPeekAtLastError();
    if (le != hipSuccess) fprintf(stderr, "kernel_launch: launch failed: %s\n", hipGetErrorName(le));
#endif
}
```

```cpp
#include <hip/hip_runtime.h>
#include <hip/hip_cooperative_groups.h>
#include <cstdio>
#include <cstdint>
namespace cg = cooperative_groups;

constexpr int DM = 1024, NB = 4, SEQ = 4096, CTX = 256, TT = SEQ + CTX, M = NB * TT;
constexpr int DFF = 2816, NAB = 4112, NABP = 4352, NQKV = 1536;
constexpr float EPS = 1e-6f;
#ifndef MK_ONE
#define MK_ONE 1
#endif
#ifndef PROBE_REP
#define PROBE_REP 0
#endif
#ifndef PROBE_VAR
#define PROBE_VAR 0
#endif
#ifndef PROBE_TS
#define PROBE_TS -1
#endif
#ifndef PROBE_SCALE
#define PROBE_SCALE 1e-5f
#endif
#ifndef SCAN_NAIVE
#define SCAN_NAIVE 0
#endif

namespace pg8 {
#define PG8_LAS __attribute__((address_space(3)))
typedef unsigned short bf16_t;
typedef short bf16x8 __attribute__((ext_vector_type(8)));
typedef float f32x4 __attribute__((ext_vector_type(4)));
typedef unsigned u32x4 __attribute__((ext_vector_type(4)));
constexpr int BM = 256, BK = 64, HALF = 128, HTB = HALF * BK * 2  , STAGE_BYTES = 8 * HTB, NXCD = 8, WGM = 8;

__host__ __device__ __forceinline__ int lds_byte(int r, int c) { const int st = (r >> 4) * 2 + (c >> 5), rr = r & 15, cc = c & 31, ob = rr * 64 + cc * 2; return st * 1024 + (ob ^ (((ob >> 9) & 1) << 5)); }
__host__ __device__ __forceinline__ void stage_rc(int b, int& R, int& C) { const int st = b / 1024, sb = b % 1024, swz = sb ^ (((sb >> 9) & 1) << 5); R = (st >> 1) * 16 + swz / 64; C = (st & 1) * 32 + (swz % 64) / 2; }
__host__ __device__ __forceinline__ int perm32(int rho) { const int n = rho >> 4, i = rho & 15; return 8 * (i >> 2) + 4 * n + (i & 3); }

struct Unit { int pm, pn; };
struct Gemm { const bf16_t* A; const bf16_t* Bt; int M, N, K; };

struct TileOrder {
    int nM, nN, nwg, G, c, skip;
    __device__ void init(int nM_, int N, int G_, int c_, int skip_) { nM = nM_; nN = N / BM; nwg = nM * nN; G = G_; c = c_; skip = skip_; }
    __device__ bool next(int i, Unit& u) const {
        const long L = (long)i * G + c; if (L >= nwg) return false;
        int wgid = (int)L; { const int q = nwg / NXCD, r = nwg % NXCD, xcd = wgid % NXCD, off = wgid / NXCD; wgid = (xcd < r ? xcd * (q + 1) : r * (q + 1) + (xcd - r) * q) + off; }
        const int nig = WGM * nN, gid = wgid / nig, fm = gid * WGM, gsz = (nM - fm) < WGM ? (nM - fm) : WGM;
        int pm = fm + ((wgid % nig) % gsz); u.pn = (wgid % nig) / gsz;
        if (skip) pm = pm + (pm >> 4) + 1;
        u.pm = pm; return true;
    }
    __device__ __forceinline__ void a_ready(const Unit&) const {}
    __device__ __forceinline__ void done(const Unit&) const {}
};

__device__ __forceinline__ unsigned cvt_pk_bf16(float lo, float hi) { unsigned r; asm volatile("v_cvt_pk_bf16_f32 %0, %1, %2" : "=v"(r) : "v"(lo), "v"(hi)); return r; }
__device__ __forceinline__ u32x4 pack8(const f32x4 a, const f32x4 b) { u32x4 w; w.x = cvt_pk_bf16(a[0], a[1]); w.y = cvt_pk_bf16(a[2], a[3]); w.z = cvt_pk_bf16(b[0], b[1]); w.w = cvt_pk_bf16(b[2], b[3]); return w; }
__device__ __forceinline__ float fsigmoid(float x) { return __builtin_amdgcn_rcpf(1.0f + __expf(-x)); }
__device__ __forceinline__ f32x4 silu4(f32x4 v) { f32x4 o; o[0] = v[0] * fsigmoid(v[0]); o[1] = v[1] * fsigmoid(v[1]); o[2] = v[2] * fsigmoid(v[2]); o[3] = v[3] * fsigmoid(v[3]); return o; }
__device__ __forceinline__ f32x4 sigm4(f32x4 v) { f32x4 o; o[0] = fsigmoid(v[0]); o[1] = fsigmoid(v[1]); o[2] = fsigmoid(v[2]); o[3] = fsigmoid(v[3]); return o; }

template <class F> struct Epi8 {
    static constexpr bool PERM = true, AFTER_DRAIN = false;
    F f;
    __device__ __forceinline__ void operator()(const f32x4 (&acc)[2][2][4][2], const Unit& u, int wr, int wc, int fr, int fq) const {
        const int col = u.pn * BM + wc * 32 + 8 * fq;
#pragma unroll
        for (int ai = 0; ai < 2; ++ai)
#pragma unroll
            for (int m = 0; m < 4; ++m) { const int row = u.pm * BM + ai * HALF + wr * 64 + m * 16 + fr;
                f.apply(row, col, acc[ai][0][m][0], acc[ai][0][m][1], acc[ai][1][m][0], acc[ai][1][m][1]); }
    }
};
struct FProj {
    bf16_t* proj; float* bg;
    __device__ __forceinline__ void one(int row, int c, f32x4 v0, f32x4 v1) const {
        if (c >= 4096) { if (c < 4112) { float* p = bg + (size_t)row * 16 + (c - 4096); *(f32x4*)p = v0; *(f32x4*)(p + 4) = v1; } return; }
        const int seg = c >> 9, cs = c & 511;
        if (seg == 2) { v0 = silu4(v0); v1 = silu4(v1); }
        if (seg == 7) { v0 = sigm4(v0); v1 = sigm4(v1); }
        *(u32x4*)(proj + (size_t)seg * ((size_t)M * 512) + (size_t)row * 512 + cs) = pack8(v0, v1);
    }
    __device__ __forceinline__ void apply(int row, int col, f32x4 a0, f32x4 a1, f32x4 b0, f32x4 b1) const { one(row, col, a0, a1); one(row, col + 128, b0, b1); }
};
struct FStore {
    bf16_t* O; int ld;
    __device__ __forceinline__ void apply(int row, int col, f32x4 a0, f32x4 a1, f32x4 b0, f32x4 b1) const {
        bf16_t* p = O + (size_t)row * ld + col; *(u32x4*)p = pack8(a0, a1); *(u32x4*)(p + 128) = pack8(b0, b1); }
};
struct FSwiglu {
    bf16_t* act;
    __device__ __forceinline__ void apply(int row, int col, f32x4 a0, f32x4 a1, f32x4 b0, f32x4 b1) const {
        const int hc = (col >> 8) * 128 + (col & 255);
        *(u32x4*)(act + (size_t)row * DFF + hc) = pack8(silu4(a0) * b0, silu4(a1) * b1); }
};
struct FQkv {
    bf16_t *q, *k, *v;
    __device__ __forceinline__ void one(int row, int c, f32x4 v0, f32x4 v1) const {
        bf16_t* p = c < 1024 ? q + (size_t)row * 1024 + c : (c < 1280 ? k + (size_t)row * 256 + (c - 1024) : v + (size_t)row * 256 + (c - 1280));
        *(u32x4*)p = pack8(v0, v1); }
    __device__ __forceinline__ void apply(int row, int col, f32x4 a0, f32x4 a1, f32x4 b0, f32x4 b1) const { one(row, col, a0, a1); one(row, col + 128, b0, b1); }
};

template <class Epi, class Sched, bool ALIGN_EPI = false, bool SP2 = false>
__device__ __forceinline__ void gemm_phase(PG8_LAS unsigned char* lds, const Gemm g, const Sched& S, const Epi& E) {
    const int tid = threadIdx.x, wid = __builtin_amdgcn_readfirstlane(tid >> 6), lane = tid & 63, wr = wid >> 2, wc = wid & 3, fr = lane & 15, fq = lane >> 4;
    const int K = g.K, nt = K / BK;
    unsigned voffA[2], voffB[2];
#pragma unroll
    for (int i = 0; i < 2; ++i) { int R, C; stage_rc(tid * 16 + i * 8192, R, C); const int Rb = Epi::PERM ? ((R & ~31) + perm32(R & 31)) : R;
        voffA[i] = (unsigned)(R * K + C) * 2u; voffB[i] = (unsigned)(Rb * K + C) * 2u; }
    const size_t kstep = (size_t)(BK * 2);
    const size_t hstep = (size_t)HALF * K * 2;
    const size_t tstep = 2 * hstep;
    const unsigned ldsw = (unsigned)wid * 1024u;
    const int aoff = lds_byte(wr * 64 + fr, fq * 8), boff = lds_byte(wc * 32 + fr, fq * 8);
#define PG8_SA(b, h) (((b) * 2 + (h)) * HTB)
#define PG8_SB(b, h) ((4 + (b) * 2 + (h)) * HTB)
#define PG8_STAGE(bufoff, gbase, voff) do { _Pragma("unroll") for (int _i = 0; _i < 2; ++_i) \
        __builtin_amdgcn_global_load_lds((const unsigned*)((const char*)(gbase) + (voff)[_i]), (PG8_LAS unsigned*)(lds + (bufoff) + ldsw + _i * 8192), 16, 0, 0); } while (0)
#define PG8_LDA(dst, b, h) do { _Pragma("unroll") for (int m = 0; m < 4; ++m) _Pragma("unroll") for (int k = 0; k < 2; ++k) dst[m][k] = *(const PG8_LAS bf16x8*)(lds + PG8_SA(b, h) + aoff + m * 2048 + k * 1024); } while (0)
#define PG8_LDB(dst, b, h) do { _Pragma("unroll") for (int n = 0; n < 2; ++n) _Pragma("unroll") for (int k = 0; k < 2; ++k) dst[n][k] = *(const PG8_LAS bf16x8*)(lds + PG8_SB(b, h) + boff + n * 2048 + k * 1024); } while (0)
#define PG8_MMA(ai, bj, At, Bt) do { __builtin_amdgcn_s_setprio(1); _Pragma("unroll") for (int m = 0; m < 4; ++m) _Pragma("unroll") for (int n = 0; n < 2; ++n) _Pragma("unroll") for (int k = 0; k < 2; ++k) \
        acc[ai][bj][m][n] = __builtin_amdgcn_mfma_f32_16x16x32_bf16(Bt[n][k], At[m][k], acc[ai][bj][m][n], 0, 0, 0); __builtin_amdgcn_s_setprio(0); } while (0)
#define PG8_WAIT_V(n) asm volatile("s_waitcnt vmcnt(" #n ")" ::: "memory")
#define PG8_WAIT_L(n) asm volatile("s_waitcnt lgkmcnt(" #n ")" ::: "memory")
#define PG8_BAR __builtin_amdgcn_s_barrier()
#define PG8_SCHED __builtin_amdgcn_sched_barrier(0)
    Unit cur, nxt; int ui = 0;
    if (!S.next(0, cur)) return;
    f32x4 acc[2][2][4][2];
#pragma unroll
    for (int a = 0; a < 2; ++a)
#pragma unroll
        for (int b = 0; b < 2; ++b)
#pragma unroll
            for (int m = 0; m < 4; ++m)
#pragma unroll
                for (int n = 0; n < 2; ++n) acc[a][b][m][n] = (f32x4){0.f, 0.f, 0.f, 0.f};
    bf16x8 At[4][2], B0[2][2], B1[2][2];
    const char* cA = (const char*)g.A + (size_t)cur.pm * tstep; const char* cB = (const char*)g.Bt + (size_t)cur.pn * tstep;
    S.a_ready(cur);
    if constexpr (SP2) {
        PG8_STAGE(PG8_SB(0, 0), cB, voffB); PG8_STAGE(PG8_SB(0, 1), cB + hstep, voffB); PG8_STAGE(PG8_SA(0, 0), cA, voffA); PG8_STAGE(PG8_SA(0, 1), cA + hstep, voffA);
        if (wr == 1) PG8_BAR;
        PG8_WAIT_V(2); PG8_BAR;
        PG8_STAGE(PG8_SB(1, 0), cB + kstep, voffB); PG8_STAGE(PG8_SA(1, 0), cA + kstep, voffA); PG8_STAGE(PG8_SB(1, 1), cB + hstep + kstep, voffB);
        PG8_WAIT_V(6); PG8_BAR;
    } else {
        PG8_STAGE(PG8_SB(0, 0), cB, voffB); PG8_STAGE(PG8_SA(0, 0), cA, voffA); PG8_STAGE(PG8_SB(0, 1), cB + hstep, voffB); PG8_STAGE(PG8_SA(0, 1), cA + hstep, voffA);
        if (wr == 1) PG8_BAR;
        PG8_WAIT_V(4); PG8_BAR;
        PG8_STAGE(PG8_SB(1, 0), cB + kstep, voffB); PG8_STAGE(PG8_SA(1, 0), cA + kstep, voffA); PG8_STAGE(PG8_SB(1, 1), cB + hstep + kstep, voffB);
        PG8_WAIT_V(6); PG8_BAR;
    }
    for (;;) {
        const bool has_next = S.next(ui + 1, nxt);
        const char* nA = has_next ? (const char*)g.A + (size_t)nxt.pm * tstep : cA; const char* nB = has_next ? (const char*)g.Bt + (size_t)nxt.pn * tstep : cB;
        for (int t = 0; t < nt; t += 2) {
            const bool last = (t == nt - 2);
            const char* a1 = cA + (size_t)(t + 1) * kstep;
            const char* a2 = last ? nA : cA + (size_t)(t + 2) * kstep; const char* b2 = last ? nB : cB + (size_t)(t + 2) * kstep;
            const char* a3 = a2 + kstep; const char* b3 = b2 + kstep;
            if (last && has_next) S.a_ready(nxt);
            if constexpr (SP2) {
            PG8_LDB(B0, 0, 0); PG8_LDB(B1, 0, 1); PG8_SCHED; PG8_LDA(At, 0, 0); PG8_STAGE(PG8_SA(1, 1), a1 + hstep, voffA);
            PG8_WAIT_V(8); PG8_WAIT_L(0); PG8_BAR; PG8_MMA(0, 0, At, B0); PG8_MMA(0, 1, At, B1); PG8_BAR; PG8_SCHED;
            PG8_LDA(At, 0, 1); PG8_STAGE(PG8_SB(0, 0), b2, voffB); PG8_STAGE(PG8_SB(0, 1), b2 + hstep, voffB); PG8_STAGE(PG8_SA(0, 0), a2, voffA);
            PG8_WAIT_V(8); PG8_WAIT_L(0); PG8_BAR; PG8_MMA(1, 0, At, B0); PG8_MMA(1, 1, At, B1); PG8_BAR; PG8_SCHED;
            PG8_LDB(B0, 1, 0); PG8_LDB(B1, 1, 1); PG8_SCHED; PG8_LDA(At, 1, 0); PG8_STAGE(PG8_SA(0, 1), a2 + hstep, voffA);
            PG8_WAIT_V(8); PG8_WAIT_L(0); PG8_BAR; PG8_MMA(0, 0, At, B0); PG8_MMA(0, 1, At, B1); PG8_BAR; PG8_SCHED;
            PG8_LDA(At, 1, 1); PG8_STAGE(PG8_SB(1, 0), b3, voffB); PG8_STAGE(PG8_SB(1, 1), b3 + hstep, voffB); PG8_STAGE(PG8_SA(1, 0), a3, voffA);
            PG8_WAIT_V(8); PG8_WAIT_L(0); PG8_BAR; PG8_MMA(1, 0, At, B0); PG8_MMA(1, 1, At, B1); PG8_BAR; PG8_SCHED;
            } else {
            PG8_LDB(B0, 0, 0); PG8_SCHED; PG8_LDA(At, 0, 0); PG8_STAGE(PG8_SA(1, 1), a1 + hstep, voffA);
            PG8_WAIT_L(8); PG8_BAR; PG8_WAIT_L(0); PG8_MMA(0, 0, At, B0); PG8_BAR; PG8_SCHED;
            PG8_LDB(B1, 0, 1); PG8_STAGE(PG8_SB(0, 0), b2, voffB);
            PG8_BAR; PG8_WAIT_L(0); PG8_MMA(0, 1, At, B1); PG8_BAR;
            PG8_LDA(At, 0, 1); PG8_STAGE(PG8_SA(0, 0), a2, voffA);
            PG8_BAR; PG8_WAIT_L(0); PG8_MMA(1, 0, At, B0); PG8_BAR; PG8_SCHED;
            PG8_STAGE(PG8_SB(0, 1), b2 + hstep, voffB);
            PG8_WAIT_V(6); PG8_BAR; PG8_MMA(1, 1, At, B1); PG8_BAR;
            PG8_LDB(B0, 1, 0); PG8_SCHED; PG8_LDA(At, 1, 0); PG8_STAGE(PG8_SA(0, 1), a2 + hstep, voffA);
            PG8_WAIT_L(8); PG8_BAR; PG8_WAIT_L(0); PG8_MMA(0, 0, At, B0); PG8_BAR; PG8_SCHED;
            PG8_LDB(B1, 1, 1); PG8_STAGE(PG8_SB(1, 0), b3, voffB);
            PG8_BAR; PG8_WAIT_L(0); PG8_MMA(0, 1, At, B1); PG8_BAR;
            PG8_LDA(At, 1, 1); PG8_STAGE(PG8_SA(1, 0), a3, voffA);
            PG8_BAR; PG8_WAIT_L(0); PG8_MMA(1, 0, At, B0); PG8_BAR; PG8_SCHED;
            PG8_STAGE(PG8_SB(1, 1), b3 + hstep, voffB);
            PG8_WAIT_V(6); PG8_BAR; PG8_MMA(1, 1, At, B1); PG8_BAR;
            }
        }
        if constexpr (ALIGN_EPI) { if (wr == 0) PG8_BAR; }
        if constexpr (!Epi::AFTER_DRAIN) { E(acc, cur, wr, wc, fr, fq); S.done(cur); }
        if (!has_next) break;
#pragma unroll
        for (int a = 0; a < 2; ++a)
#pragma unroll
            for (int b = 0; b < 2; ++b)
#pragma unroll
                for (int m = 0; m < 4; ++m)
#pragma unroll
                    for (int n = 0; n < 2; ++n) acc[a][b][m][n] = (f32x4){0.f, 0.f, 0.f, 0.f};
        cur = nxt; cA = nA; cB = nB; ++ui;
        if constexpr (ALIGN_EPI) { if (wr == 1) PG8_BAR; }
    }
    PG8_WAIT_V(0);
    if constexpr (!ALIGN_EPI) { if (wr == 0) PG8_BAR; }
    PG8_BAR;
    if constexpr (Epi::AFTER_DRAIN) { E.fused(acc, cur, wr, wc, fr, fq, lds, wid, lane); S.done(cur); }
#undef PG8_SA
#undef PG8_SB
#undef PG8_STAGE
#undef PG8_LDA
#undef PG8_LDB
#undef PG8_MMA
#undef PG8_WAIT_V
#undef PG8_WAIT_L
#undef PG8_BAR
#undef PG8_SCHED
}
}

namespace attn {
typedef unsigned short bf16;
using bf16x8 = __attribute__((ext_vector_type(8))) short;
using s16x4  = __attribute__((ext_vector_type(4))) short;
using f32x16 = __attribute__((ext_vector_type(16))) float;
using u32x4  = __attribute__((ext_vector_type(4))) unsigned;
constexpr int D = 128, NW = 8, QBLK = 32, KVBLK = 64;
constexpr float SCALE = 0.088388347648318440f;
constexpr float THR = 8.f;
constexpr int LDQ = 1024, LDK = 256, LDO = 1024;
constexpr size_t SHM_V = KVBLK * D * 2, SHM_K = KVBLK * D * 2, SHM_ATTN = 2 * SHM_V + 2 * SHM_K + NW * 64 * 4;
#define KSWZ(row, colB) ((row) * 256 + ((colB) ^ (((row) & 7) << 4)))
#define SBAR() __builtin_amdgcn_sched_barrier(0)
__device__ __forceinline__ int crow(int r, int hi) { return (r & 3) + 8 * (r >> 2) + 4 * hi; }
__device__ __forceinline__ unsigned cvtpk(float lo, float hi) { unsigned r; asm volatile("v_cvt_pk_bf16_f32 %0, %1, %2" : "=v"(r) : "v"(lo), "v"(hi)); return r; }
__device__ __forceinline__ bf16x8 ld8(const bf16* p) { return *reinterpret_cast<const bf16x8*>(p); }

__device__ __forceinline__ void partialSM(f32x16& p0, f32x16& p1, float& m_reg, float& mn, float& alpha) {
  constexpr float C = SCALE * 1.4426950408889634f;
  float pmax = p0[0]; for (int r = 1; r < 16; ++r) pmax = fmaxf(pmax, p0[r]); for (int r = 0; r < 16; ++r) pmax = fmaxf(pmax, p1[r]);
  { auto rr = __builtin_amdgcn_permlane32_swap(__float_as_uint(pmax), __float_as_uint(pmax), false, false);
    pmax = fmaxf(__uint_as_float(rr[0]), __uint_as_float(rr[1])); }
  if (__builtin_expect(__all(pmax - m_reg <= THR / SCALE), 1)) { mn = m_reg; alpha = 1.f; }
  else { mn = fmaxf(m_reg, pmax); alpha = __builtin_amdgcn_exp2f((m_reg - mn) * C); m_reg = mn; }
  float mnC = -mn * C;
  for (int r = 0; r < 16; ++r) p0[r] = fmaf(p0[r], C, mnC); for (int r = 0; r < 16; ++r) p1[r] = fmaf(p1[r], C, mnC);
  for (int r = 0; r < 16; ++r) p0[r] = __builtin_amdgcn_exp2f(p0[r]);
}
__device__ __forceinline__ void finishSM(f32x16& p0, f32x16& p1, float alpha, float& l_reg, bf16x8& pa0, bf16x8& pa1, bf16x8& pa2, bf16x8& pa3) {
  for (int r = 0; r < 16; ++r) p1[r] = __builtin_amdgcn_exp2f(p1[r]);
  float ps = 0; for (int r = 0; r < 16; ++r) ps += p0[r]; for (int r = 0; r < 16; ++r) ps += p1[r];
  { auto rr = __builtin_amdgcn_permlane32_swap(__float_as_uint(ps), __float_as_uint(ps), false, false);
    ps = __uint_as_float(rr[0]) + __uint_as_float(rr[1]); }
  l_reg = l_reg * alpha + ps;
#define PK4(P, BASE, OUT) do { unsigned a0 = cvtpk(P[BASE + 0], P[BASE + 1]), a1 = cvtpk(P[BASE + 2], P[BASE + 3]);   \
    unsigned b0 = cvtpk(P[BASE + 4], P[BASE + 5]), b1 = cvtpk(P[BASE + 6], P[BASE + 7]);                              \
    auto r0 = __builtin_amdgcn_permlane32_swap(a0, b0, false, false); auto r1 = __builtin_amdgcn_permlane32_swap(a1, b1, false, false); \
    u32x4 w = {r0[0], r1[0], r0[1], r1[1]}; OUT = *reinterpret_cast<bf16x8*>(&w); } while (0)
  PK4(p0, 0, pa0); PK4(p0, 8, pa1); PK4(p1, 0, pa2); PK4(p1, 8, pa3);
#undef PK4
}
__device__ __forceinline__ void qkt(f32x16& p0, f32x16& p1, const bf16* Ks, const bf16x8* qr, int r32, int hi) {
  p0 = f32x16{}; p1 = f32x16{};
  for (int d0 = 0; d0 < 8; ++d0) { int cb = (d0 * 16 + hi * 8) * 2;
    bf16x8 b0 = *reinterpret_cast<const bf16x8*>((const char*)Ks + KSWZ(r32, cb));
    bf16x8 b1 = *reinterpret_cast<const bf16x8*>((const char*)Ks + KSWZ(32 + r32, cb));
    p0 = __builtin_amdgcn_mfma_f32_32x32x16_bf16(b0, qr[d0], p0, 0, 0, 0);
    p1 = __builtin_amdgcn_mfma_f32_32x32x16_bf16(b1, qr[d0], p1, 0, 0, 0); }
}
__device__ __forceinline__ int v_st(int k, int c) { const int kk = (k & ~0xC) | ((k & 4) << 1) | ((k & 8) >> 1); return ((kk >> 3) * 4 + (c >> 5)) * 512 + ((kk & 7) * 32 + (c & 31)) * 2; }
__device__ __forceinline__ int v_rd_base(int lane) { return ((lane & 3) << 3) | (((lane >> 2) & 3) << 6) | (((lane >> 4) & 1) << 5) | (((lane >> 5) & 1) << 8); }
constexpr int v_rd_off(int d0, int ks, int half) { return d0 * 512 + ks * 4096 + half * 2048; }
template <int OFF> __device__ __forceinline__ s16x4 tr_read(int vb) {
  s16x4 r; asm volatile("ds_read_b64_tr_b16 %0, %1 offset:%2" : "=&v"(r) : "v"(vb), "i"(OFF) : "memory"); return r;
}
template <int D0> __device__ __forceinline__ void pv_one(f32x16& od, int vb, bf16x8 pa0, bf16x8 pa1, bf16x8 pa2, bf16x8 pa3) {
  const s16x4 l0 = tr_read<v_rd_off(D0, 0, 0)>(vb), h0 = tr_read<v_rd_off(D0, 0, 1)>(vb), l1 = tr_read<v_rd_off(D0, 1, 0)>(vb), h1 = tr_read<v_rd_off(D0, 1, 1)>(vb);
  const s16x4 l2 = tr_read<v_rd_off(D0, 2, 0)>(vb), h2 = tr_read<v_rd_off(D0, 2, 1)>(vb), l3 = tr_read<v_rd_off(D0, 3, 0)>(vb), h3 = tr_read<v_rd_off(D0, 3, 1)>(vb);
  asm volatile("s_waitcnt lgkmcnt(0)" ::: "memory"); SBAR();
#define PK(L, H) (bf16x8){L[0], L[1], L[2], L[3], H[0], H[1], H[2], H[3]}
  od = __builtin_amdgcn_mfma_f32_32x32x16_bf16(pa0, PK(l0, h0), od, 0, 0, 0);
  od = __builtin_amdgcn_mfma_f32_32x32x16_bf16(pa1, PK(l1, h1), od, 0, 0, 0);
  od = __builtin_amdgcn_mfma_f32_32x32x16_bf16(pa2, PK(l2, h2), od, 0, 0, 0);
  od = __builtin_amdgcn_mfma_f32_32x32x16_bf16(pa3, PK(l3, h3), od, 0, 0, 0);
#undef PK
}
__device__ __forceinline__ void pv_d0(f32x16* o, int vb, bf16x8 pa0, bf16x8 pa1, bf16x8 pa2, bf16x8 pa3) {
  pv_one<0>(o[0], vb, pa0, pa1, pa2, pa3); pv_one<1>(o[1], vb, pa0, pa1, pa2, pa3); pv_one<2>(o[2], vb, pa0, pa1, pa2, pa3); pv_one<3>(o[3], vb, pa0, pa1, pa2, pa3);
}
__device__ __forceinline__ void q_norm_rope(bf16* __restrict__ Qb, const float* __restrict__ qg, int tpos0) {
  int tid = threadIdx.x; asm volatile("" : "+v"(tid));
  const int wid = tid >> 6, lane = tid & 63, sub = lane & 15, rq = lane >> 4;
  const int c0 = 8 * sub;
  float g[8];
#pragma unroll
  for (int j = 0; j < 8; ++j) g[j] = qg[c0 + j];
  float invf[8];
#pragma unroll
  for (int j = 0; j < 8; ++j) invf[j] = exp2f(-(float)(2 * ((c0 & 31) + j)) * (13.287712379549449f / 64.f));
  const bool second = (sub & 4) != 0;
#pragma unroll 2
  for (int s = 0; s < 8; ++s) {
    const int row = wid * 32 + s * 4 + rq;
    bf16* p = Qb + (long)row * LDQ + c0;
    const u32x4 w = *reinterpret_cast<const u32x4*>(p);
    float x[8]; float ss = 0.f;
#pragma unroll
    for (int i = 0; i < 4; ++i) { x[2 * i] = __uint_as_float(w[i] << 16); x[2 * i + 1] = __uint_as_float(w[i] & 0xffff0000u); ss += x[2 * i] * x[2 * i] + x[2 * i + 1] * x[2 * i + 1]; }
    ss += __shfl_xor(ss, 1); ss += __shfl_xor(ss, 2); ss += __shfl_xor(ss, 4); ss += __shfl_xor(ss, 8);
    const float rstd = rsqrtf(ss * (1.f / 128.f) + 1e-6f);
    const int tp = tpos0 + row; const float pos = (sub & 8) ? (float)(tp & 63) : (float)(tp >> 6);
    unsigned o[4];
    float y[8];
#pragma unroll
    for (int j = 0; j < 8; ++j) { const float v = x[j] * rstd * g[j]; const float pv = __shfl_xor(v, 4); const float ang = pos * invf[j]; const float sn = __sinf(ang), cs = __cosf(ang);
      y[j] = second ? v * cs + pv * sn : v * cs - pv * sn; }
#pragma unroll
    for (int i = 0; i < 4; ++i) o[i] = cvtpk(y[2 * i], y[2 * i + 1]);
    *reinterpret_cast<u32x4*>(p) = (u32x4){o[0], o[1], o[2], o[3]};
  }
}
__device__ __forceinline__ void attn_dense_body(const bf16* __restrict__ Qb, const bf16* __restrict__ Kh, const bf16* __restrict__ Vh,
                                                bf16* __restrict__ Ob, int seq, char* lds) {
  constexpr int SDEPTH = 2;
  const int tid = threadIdx.x, wid = tid >> 6, lane = tid & 63, r32 = lane & 31, hi = lane >> 5;
  bf16* V_lds = (bf16*)lds; bf16* K_lds = (bf16*)(lds + 2 * SHM_V);
  float* ws = (float*)(lds + 2 * SHM_V + 2 * SHM_K) + wid * 64; float* li_l = ws; float* al_l = ws + 32;
  float m_reg = -1e30f, l_reg = 0; f32x16 o[4] = {}; bf16x8 qr[8];
  const bf16* Qw = Qb + (long)(wid * QBLK + r32) * LDQ + hi * 8;
#pragma unroll
  for (int d0 = 0; d0 < 8; ++d0) qr[d0] = ld8(Qw + d0 * 16);
  const int sr = tid >> 4, sc = (tid & 15) * 8, vst0 = v_st(sr, sc), vst1 = v_st(32 + sr, sc);
  const int vb0 = (int)(uintptr_t)V_lds + v_rd_base(lane);
  struct { bf16x8 vs0, vs1, ks0, ks1; } sr_[SDEPTH];
#define SLOAD(i, k0) do { sr_[i].vs0 = ld8(&Vh[(long)((k0) + sr) * LDK + sc]); sr_[i].vs1 = ld8(&Vh[(long)((k0) + 32 + sr) * LDK + sc]); \
    sr_[i].ks0 = ld8(&Kh[(long)((k0) + sr) * LDK + sc]); sr_[i].ks1 = ld8(&Kh[(long)((k0) + 32 + sr) * LDK + sc]); } while (0)
#define SWRITE(b, i) do { *(bf16x8*)((char*)V_lds + (b) * SHM_V + vst0) = sr_[i].vs0;          \
    *(bf16x8*)((char*)V_lds + (b) * SHM_V + vst1) = sr_[i].vs1; int kc = sc * 2;               \
    *(bf16x8*)((char*)K_lds + (b) * SHM_K + KSWZ(sr, kc)) = sr_[i].ks0;                       \
    *(bf16x8*)((char*)K_lds + (b) * SHM_K + KSWZ(32 + sr, kc)) = sr_[i].ks1; } while (0)
#define SWAIT() do { asm volatile("s_waitcnt vmcnt(4)" ::: "memory"); } while (0)
#define RESC(a) do { if (__any((a) < 1.f)) { if (hi == 0) al_l[r32] = (a); asm volatile("s_waitcnt lgkmcnt(0)" ::: "memory"); \
    for (int d = 0; d < 4; ++d) for (int r = 0; r < 16; ++r) o[d][r] *= al_l[crow(r, hi)]; } } while (0)
  f32x16 pA0, pA1, pB0, pB1; float mnA, mnB, alA, alB; bf16x8 pa0, pa1, pa2, pa3; const int NT = seq / KVBLK;
  constexpr int SE = 0, SO = SDEPTH - 1;
  SLOAD(SE, 0); asm volatile("s_waitcnt vmcnt(0)" ::: "memory"); SWRITE(0, SE); __syncthreads();
  qkt(pA0, pA1, K_lds, qr, r32, hi); partialSM(pA0, pA1, m_reg, mnA, alA);
  SLOAD(SO, KVBLK); if (2 < NT) SLOAD(SE, 2 * KVBLK);
  SWAIT(); SWRITE(1, SO); __syncthreads();
  for (int j = 1; j + 1 < NT; j += 2) {
    SBAR(); qkt(pB0, pB1, (bf16*)((char*)K_lds + SHM_K), qr, r32, hi);
    finishSM(pA0, pA1, alA, l_reg, pa0, pa1, pa2, pa3); SBAR();
    SLOAD(SO, (j + SDEPTH) * KVBLK); SBAR();
    pv_d0(o, vb0, pa0, pa1, pa2, pa3); partialSM(pB0, pB1, m_reg, mnB, alB);
    __syncthreads(); SWAIT(); SWRITE(0, SE);
    RESC(alB); __syncthreads();
    SBAR(); qkt(pA0, pA1, K_lds, qr, r32, hi);
    finishSM(pB0, pB1, alB, l_reg, pa0, pa1, pa2, pa3); SBAR();
    if (j + 3 < NT) SLOAD(SE, (j + 1 + SDEPTH) * KVBLK); SBAR();
    pv_d0(o, vb0 + (int)SHM_V, pa0, pa1, pa2, pa3); partialSM(pA0, pA1, m_reg, mnA, alA);
    __syncthreads(); SWAIT(); SWRITE(1, SO);
    RESC(alA); __syncthreads();
  }
  SBAR(); qkt(pB0, pB1, (bf16*)((char*)K_lds + SHM_K), qr, r32, hi);
  finishSM(pA0, pA1, alA, l_reg, pa0, pa1, pa2, pa3); SBAR();
  pv_d0(o, vb0, pa0, pa1, pa2, pa3); partialSM(pB0, pB1, m_reg, mnB, alB);
  __syncthreads(); RESC(alB);
  finishSM(pB0, pB1, alB, l_reg, pa0, pa1, pa2, pa3); SBAR();
  pv_d0(o, vb0 + (int)SHM_V, pa0, pa1, pa2, pa3);
  if (hi == 0) li_l[r32] = l_reg; asm volatile("s_waitcnt lgkmcnt(0)" ::: "memory");
  float rli[16];
#pragma unroll
  for (int r = 0; r < 16; ++r) rli[r] = __builtin_amdgcn_rcpf(li_l[crow(r, hi)]);
  bf16* Ow = Ob + (long)(wid * QBLK) * LDO;
#pragma unroll
  for (int r = 0; r < 16; ++r) { int orow = crow(r, hi);
    for (int d0 = 0; d0 < 4; ++d0) { const float v = o[d0][r] * rli[r]; const unsigned u = __float_as_uint(v);
      Ow[(long)orow * LDO + d0 * 32 + r32] = (bf16)((u + 0x7fffu + ((u >> 16) & 1u)) >> 16); } }
#undef SLOAD
#undef SWRITE
#undef SWAIT
#undef RESC
}
#undef KSWZ
#undef SBAR
}

#define LAS __attribute__((address_space(3)))
typedef unsigned short bf16;
typedef unsigned v4u __attribute__((ext_vector_type(4)));
typedef unsigned v2u __attribute__((ext_vector_type(2)));
typedef float f32x4 __attribute__((ext_vector_type(4)));
typedef float f32x2 __attribute__((ext_vector_type(2)));

constexpr size_t HM = 1u << 19;
constexpr size_t WS_MOD = 2 * HM;
constexpr size_t WS_WAB = 4 * HM, WS_WABO = 21 * HM, WS_WFI0 = 25 * HM, WS_WFI1 = 47 * HM, WS_WFO0 = 69 * HM, WS_WFO1 = 80 * HM, WS_WQKV = 91 * HM, WS_WAO = 97 * HM;
constexpr size_t WS_XCTX = 102 * HM;
constexpr size_t WS_H = 110 * HM;
constexpr size_t WS_PROJ = 178 * HM;
constexpr size_t SEG = (size_t)M * 512;
constexpr size_t WS_ACT = 178 * HM;
constexpr size_t WS_Q = 178 * HM, WS_K = 246 * HM, WS_V = 263 * HM;
constexpr size_t WS_OG = 280 * HM;
constexpr size_t WS_Y = 382 * HM;
constexpr size_t WS_BG = 450 * HM;
constexpr size_t WS_SXH = 456 * HM, WS_SXM = 469 * HM, WS_GXH = 476 * HM, WS_NXM = 477 * HM, WS_MXM = 478 * HM;
constexpr size_t WS_TS = 479 * HM;
constexpr size_t WS_END = 512 * HM;
static_assert(WS_BG + (size_t)M * 16 * 4 <= WS_END && WS_Y + (size_t)M * DM * 2 <= WS_BG && WS_PROJ + 8 * SEG * 2 == WS_BG, "ws map");
static_assert(WS_ACT + (size_t)M * DFF * 2 <= WS_Y && WS_V + (size_t)M * 256 * 2 <= WS_OG && WS_OG + (size_t)M * DM * 2 <= WS_Y, "ws map 2");

constexpr int LDS_BYTES = 147456;

__device__ __forceinline__ unsigned f2bf(float f) { unsigned u = __builtin_bit_cast(unsigned, f); return (u + 0x7fffu + ((u >> 16) & 1u)) >> 16; }
__device__ __forceinline__ unsigned pk2(float lo, float hi) { return f2bf(lo) | (f2bf(hi) << 16); }
__device__ __forceinline__ float bf2f(unsigned short h) { return __builtin_bit_cast(float, (unsigned)h << 16); }
__device__ __forceinline__ float bflo(unsigned w) { return __builtin_bit_cast(float, w << 16); }
__device__ __forceinline__ float bfhi(unsigned w) { return __builtin_bit_cast(float, w & 0xffff0000u); }
__device__ __forceinline__ float wave_sum(float v) {
#pragma unroll
    for (int o = 1; o < 64; o <<= 1) v += __shfl_xor(v, o);
    return v;
}
__device__ __forceinline__ float sigmoidf_(float x) { return 1.0f / (1.0f + __expf(-x)); }

typedef __attribute__((address_space(1))) unsigned gu32;
#define RLX_AGENT __ATOMIC_RELAXED, __HIP_MEMORY_SCOPE_AGENT
constexpr int MISC_OFF = 131072 + 320;
constexpr size_t WS_CTL = 0, CTL_ZERO_BYTES = 65536;
constexpr int CW_BAR = 1024;
#define XB_TMO      128
#define XB_XCNT(j)  (256  + 64 * (j))
#define XB_XSUB(j)  (1280 + 64 * (j))
#define XB_XGEN(j)  (2304 + 64 * (j))
#define XB_TOP      3328
#define XB_TOPGEN   3392
#define XCD_BAR_WORDS 3456
#define XB_SPIN_CAP (1u << 18)

__device__ __forceinline__ unsigned xb_ld(unsigned* p)              { return __hip_atomic_load(p, __ATOMIC_RELAXED, __HIP_MEMORY_SCOPE_AGENT); }
__device__ __forceinline__ unsigned xb_add(unsigned* p, unsigned v) { return __hip_atomic_fetch_add(p, v, __ATOMIC_RELAXED, __HIP_MEMORY_SCOPE_AGENT); }
__device__ __forceinline__ unsigned xb_xcc_id() { return (unsigned)__builtin_amdgcn_s_getreg((3 << 11) | 20) & 0xFu; }
#define XB_SPIN(cond, bar) do { unsigned _sp = 0; while (cond) { __builtin_amdgcn_s_sleep(1); \
    if ((++_sp & 255u) == 0u) { if (xb_ld(&(bar)[XB_TMO])) break; if (_sp > XB_SPIN_CAP) { atomicAdd(&(bar)[XB_TMO], 1u); break; } } } } while (0)

struct XcdBarrier {
    unsigned* bar; unsigned x;
    volatile LAS unsigned* st;
};

__device__ __forceinline__ XcdBarrier xcd_barrier_post(unsigned* bar, volatile LAS unsigned* st) {
    XcdBarrier b; b.bar = bar; b.x = xb_xcc_id(); b.st = st;
    if (threadIdx.x == 0) (void)xb_add(&bar[XB_XCNT(b.x)], 1u);
    return b;
}
__device__ __forceinline__ void xcd_barrier_complete(unsigned* bar, unsigned x, unsigned& nloc, unsigned& nx) {
    const unsigned G = gridDim.x * gridDim.y * gridDim.z;
    unsigned sum, cnt, mine, sp = 0u;
    for (;;) {
        sum = 0u; cnt = 0u; mine = 0u;
#pragma unroll
        for (unsigned j = 0; j < 16; ++j) { const unsigned c = xb_ld(&bar[XB_XCNT(j)]); sum += c; cnt += (c > 0u) ? 1u : 0u; mine = (j == x) ? c : mine; }
        if (sum == G) break;
        __builtin_amdgcn_s_sleep(1);
        if ((++sp & 255u) == 0u) { if (xb_ld(&bar[XB_TMO])) break; if (sp > XB_SPIN_CAP) { atomicAdd(&bar[XB_TMO], 1u); break; } }
    }
    nloc = mine > 0u ? mine : 1u; nx = cnt > 0u ? cnt : 1u;
}

__device__ __forceinline__ void xcd_barrier(const XcdBarrier& b) {
    asm volatile("s_waitcnt vmcnt(0)" ::: "memory");
    __syncthreads();
    if (threadIdx.x == 0) {
        unsigned* bar = b.bar;
        __builtin_amdgcn_s_waitcnt(0);
        unsigned nloc = b.st[0], nx = b.st[1];
        if (nloc == 0u) { xcd_barrier_complete(bar, b.x, nloc, nx); b.st[0] = nloc; b.st[1] = nx; }
        const unsigned old = xb_add(&bar[XB_XSUB(b.x)], 1u);
        const unsigned gen = old / nloc;
        if (old + 1u == (gen + 1u) * nloc) {
            __builtin_amdgcn_fence(__ATOMIC_RELEASE, "agent");
            asm volatile("s_waitcnt vmcnt(0)" ::: "memory");
            const unsigned og = xb_add(&bar[XB_TOP], 1u);
            const unsigned tg = og / nx;
            if (og + 1u == (tg + 1u) * nx) xb_add(&bar[XB_TOPGEN], 1u);
            else XB_SPIN(xb_ld(&bar[XB_TOPGEN]) == tg, bar);
            __builtin_amdgcn_fence(__ATOMIC_ACQUIRE, "agent");
            xb_add(&bar[XB_XGEN(b.x)], 1u);
            asm volatile("s_waitcnt vmcnt(0)" ::: "memory");
        } else {
            XB_SPIN(xb_ld(&bar[XB_XGEN(b.x)]) == gen, bar);
            __builtin_amdgcn_fence(__ATOMIC_ACQUIRE, "agent");
            asm volatile("s_waitcnt vmcnt(0)" ::: "memory");
        }
    }
    __syncthreads();
}

struct Args { const float* in[18]; float* out; unsigned char* ws; int ph_lo, ph_hi, variant, pad; };
struct Frame {
    LAS unsigned char* lds;
    int tid, lane, wave, G;
    float* out; unsigned char* ws;
    __device__ __forceinline__ const float* in(int i) const { return ((const __attribute__((address_space(4))) Args*)__builtin_amdgcn_kernarg_segment_ptr())->in[i]; }
#define FPTR(name, T, off) __device__ __forceinline__ T* name() const { return (T*)(ws + (off)); }
    FPTR(MOD, float, WS_MOD) FPTR(XCTX, float, WS_XCTX) FPTR(H, bf16, WS_H) FPTR(PROJ, bf16, WS_PROJ) FPTR(BG, float, WS_BG) FPTR(OG, bf16, WS_OG) FPTR(Y, bf16, WS_Y) FPTR(ACT, bf16, WS_ACT)
    FPTR(Q, bf16, WS_Q) FPTR(K, bf16, WS_K) FPTR(V, bf16, WS_V)
    FPTR(WAB, bf16, WS_WAB) FPTR(WABO, bf16, WS_WABO) FPTR(WFI0, bf16, WS_WFI0) FPTR(WFI1, bf16, WS_WFI1) FPTR(WFO0, bf16, WS_WFO0) FPTR(WFO1, bf16, WS_WFO1) FPTR(WQKV, bf16, WS_WQKV) FPTR(WAO, bf16, WS_WAO)
#undef FPTR
};
enum { I_X = 0, I_C, I_CTX, I_CCTX, I_ADAW, I_ADAB, I_NORMG, I_FWIN, I_FWOUT, I_ABWIN, I_CONV, I_GATEB, I_LB, I_OUTG, I_ABWOUT, I_WQKV, I_QKG, I_AWOUT };

__device__ __forceinline__ int drow_of(int mode, int n0) { if (mode == 0) return n0; const int j = n0 < DFF ? n0 : n0 - DFF; return (j >> 7) * 256 + (n0 < DFF ? 0 : 128) + (j & 127); }
__device__ __forceinline__ void p0_transpose_item(const float* W, int K, int N, bf16* WT, int mode, LAS float* scr, int item, int lane) {
    const int nblk = (N + 31) / 32, kb = item / nblk, nb = item % nblk, k0 = 64 * kb, n0 = 32 * nb;
    const int n = n0 + (lane & 31); const bool ok = n < N;
    float tv[32];
#pragma unroll
    for (int i = 0; i < 32; ++i) { const int kk = 2 * i + (lane >> 5); tv[i] = ok ? W[(size_t)(k0 + kk) * N + n] : 0.f; }
#pragma unroll
    for (int i = 0; i < 32; ++i) { const int kk = 2 * i + (lane >> 5); scr[kk * 33 + (lane & 31)] = tv[i]; }
    asm volatile("s_waitcnt lgkmcnt(0)" ::: "memory");
    const int c = lane & 7; const int dr = drow_of(mode, n0);
#pragma unroll
    for (int j = 0; j < 4; ++j) { const int nn = (lane >> 3) + 8 * j; const LAS float* s = scr + (8 * c) * 33 + nn;
        v4u o; o.x = pk2(s[0 * 33], s[1 * 33]); o.y = pk2(s[2 * 33], s[3 * 33]); o.z = pk2(s[4 * 33], s[5 * 33]); o.w = pk2(s[6 * 33], s[7 * 33]);
        *(v4u*)(WT + (size_t)(dr + nn) * K + k0 + 8 * c) = o; }
    asm volatile("s_waitcnt lgkmcnt(0)" ::: "memory");
}
__device__ __forceinline__ void p0_prologue(Frame& F) {
    const int tid = F.tid, lane = F.lane, w = F.wave;
    if (blockIdx.x < 96) {
        LAS float* sc = (LAS float*)F.lds; LAS float* part = sc + 5120;
        for (int i = tid; i < 5120; i += 512) { const int j = i >> 10, k = i & 1023; const float v = j < 4 ? F.in(I_C)[j * 1024 + k] : F.in(I_CCTX)[k]; sc[i] = v * sigmoidf_(v); }
        __syncthreads();
        const int l = blockIdx.x / 48, col0 = (blockIdx.x % 48) * 128;
        const float* wp = F.in(I_ADAW) + ((size_t)l * 1024 + 128 * w) * 6144 + col0 + 2 * lane;
        float acc[5][2];
#pragma unroll
        for (int j = 0; j < 5; ++j) { acc[j][0] = 0.f; acc[j][1] = 0.f; }
        for (int k0 = 0; k0 < 128; k0 += 32) { f32x2 wv[32];
#pragma unroll
            for (int kk = 0; kk < 32; ++kk) wv[kk] = *(const f32x2*)(wp + (size_t)(k0 + kk) * 6144);
#pragma unroll
            for (int kk = 0; kk < 32; ++kk) {
#pragma unroll
                for (int j = 0; j < 5; ++j) { const float s = sc[j * 1024 + 128 * w + k0 + kk]; acc[j][0] += s * wv[kk].x; acc[j][1] += s * wv[kk].y; } } }
#pragma unroll
        for (int j = 0; j < 5; ++j) { part[(w * 5 + j) * 128 + 2 * lane] = acc[j][0]; part[(w * 5 + j) * 128 + 2 * lane + 1] = acc[j][1]; }
        __syncthreads();
        for (int i = tid; i < 640; i += 512) { const int j = i >> 7, cc = i & 127; float s = 0.f;
#pragma unroll
            for (int ww = 0; ww < 8; ++ww) s += part[(ww * 5 + j) * 128 + cc];
            F.MOD()[(size_t)(l * 5 + j) * 6144 + col0 + cc] = s + F.in(I_ADAB)[l * 6144 + col0 + cc]; }
        __syncthreads();
    }
    LAS float* scr = (LAS float*)(F.lds + w * 16384);
    const int gw = blockIdx.x * 8 + w, NGW = F.G * 8;
    constexpr int I_AB = 16 * 129, I_ABO = 16 * 32, I_FI = 16 * 176, I_FO = 44 * 32, I_QK = 16 * 48, I_AO = 16 * 32;
    constexpr int NITEMS = I_AB + I_ABO + 2 * I_FI + 2 * I_FO + I_QK + I_AO;
    for (int it = gw; it < NITEMS; it += NGW) {
        int r = it;
        if (r < I_AB) { p0_transpose_item(F.in(I_ABWIN), 1024, NAB, F.WAB(), 0, scr, r, lane); continue; } r -= I_AB;
        if (r < I_ABO) { p0_transpose_item(F.in(I_ABWOUT), 1024, 1024, F.WABO(), 0, scr, r, lane); continue; } r -= I_ABO;
        if (r < I_FI) { p0_transpose_item(F.in(I_FWIN), 1024, 2 * DFF, F.WFI0(), 1, scr, r, lane); continue; } r -= I_FI;
        if (r < I_FI) { p0_transpose_item(F.in(I_FWIN) + (size_t)1024 * 2 * DFF, 1024, 2 * DFF, F.WFI1(), 1, scr, r, lane); continue; } r -= I_FI;
        if (r < I_FO) { p0_transpose_item(F.in(I_FWOUT), DFF, 1024, F.WFO0(), 0, scr, r, lane); continue; } r -= I_FO;
        if (r < I_FO) { p0_transpose_item(F.in(I_FWOUT) + (size_t)DFF * 1024, DFF, 1024, F.WFO1(), 0, scr, r, lane); continue; } r -= I_FO;
        if (r < I_QK) { p0_transpose_item(F.in(I_WQKV), 1024, NQKV, F.WQKV(), 0, scr, r, lane); continue; } r -= I_QK;
        p0_transpose_item(F.in(I_AWOUT), 1024, 1024, F.WAO(), 0, scr, r, lane);
    }
    { const int gt = blockIdx.x * 512 + tid, NT_ = F.G * 512; const int n16 = (NABP - 4128) * 1024 * 2 / 16; v4u z = {0u, 0u, 0u, 0u};
      for (int i = gt; i < n16; i += NT_) *((v4u*)(F.WAB() + (size_t)4128 * 1024) + i) = z; }
}

constexpr int RB = 4;
template <bool HAS_Y, bool WRITE_X, bool HAS_NEXT, bool LAT_ONLY>
__device__ __forceinline__ void rowpass(const Frame& F, const float* xs_lat, const float* xs_ctx, float* xd_lat, float* xd_ctx,
                                        const float* mod_y, int gate_off, const float* gn_y, const float* mod_n, int sh_off, int sc_off, const float* gn_n) {
    const int lane = F.lane, gw = blockIdx.x * 8 + F.wave, NGW = F.G * 8;
    constexpr int NR = LAT_ONLY ? NB * SEQ : M;
    for (int r0 = gw; r0 < NR; r0 += RB * NGW) {
        f32x4 x[RB][4]; v2u yw[RB][4]; int rr[RB], jv[RB]; size_t xo[RB]; bool ok[RB], ic[RB];
#pragma unroll
        for (int q = 0; q < RB; ++q) { const int li = r0 + q * NGW; ok[q] = li < NR; const int lr = ok[q] ? li : r0;
            const int r = LAT_ONLY ? lr + (lr >> 12) * CTX + CTX : lr; const int b = r / TT, tt = r - b * TT; ic[q] = tt < CTX; rr[q] = r; jv[q] = ic[q] ? 4 : b;
            xo[q] = ic[q] ? (size_t)(b * CTX + tt) * DM : (size_t)(b * SEQ + tt - CTX) * DM;
            const float* xs = (ic[q] ? xs_ctx : xs_lat) + xo[q];
            if (ok[q]) {
#pragma unroll
                for (int jj = 0; jj < 4; ++jj) x[q][jj] = *(const f32x4*)(xs + 4 * lane + 256 * jj);
                if (HAS_Y) {
#pragma unroll
                    for (int jj = 0; jj < 4; ++jj) yw[q][jj] = *(const v2u*)(F.Y() + (size_t)r * DM + 4 * lane + 256 * jj); } } }
#pragma unroll
        for (int q = 0; q < RB; ++q) { if (!ok[q]) continue;
            const int r = rr[q], j = jv[q];
            if (HAS_Y) {
                f32x4 y[4]; float ss = 0.f;
#pragma unroll
                for (int jj = 0; jj < 4; ++jj) { const v2u w = yw[q][jj];
                    y[jj] = (f32x4){bflo(w.x), bfhi(w.x), bflo(w.y), bfhi(w.y)}; ss += (y[jj][0] * y[jj][0] + y[jj][1] * y[jj][1]) + (y[jj][2] * y[jj][2] + y[jj][3] * y[jj][3]); }
                const float rstd = rsqrtf(wave_sum(ss) * (1.f / DM) + EPS);
#pragma unroll
                for (int jj = 0; jj < 4; ++jj) { const int c = 4 * lane + 256 * jj;
                    const f32x4 g = *(const f32x4*)(mod_y + (size_t)j * 6144 + gate_off + c), gn = *(const f32x4*)(gn_y + c);
                    x[q][jj] = x[q][jj] + g * (y[jj] * rstd * gn); }
            }
            if (WRITE_X) { float* xd = (ic[q] ? xd_ctx : xd_lat) + xo[q];
#pragma unroll
                for (int jj = 0; jj < 4; ++jj) *(f32x4*)(xd + 4 * lane + 256 * jj) = x[q][jj]; }
            if (HAS_NEXT) {
                float ss = 0.f;
#pragma unroll
                for (int jj = 0; jj < 4; ++jj) ss += (x[q][jj][0] * x[q][jj][0] + x[q][jj][1] * x[q][jj][1]) + (x[q][jj][2] * x[q][jj][2] + x[q][jj][3] * x[q][jj][3]);
                const float rstd = rsqrtf(wave_sum(ss) * (1.f / DM) + EPS);
#pragma unroll
                for (int jj = 0; jj < 4; ++jj) { const int c = 4 * lane + 256 * jj;
                    const f32x4 sh = *(const f32x4*)(mod_n + (size_t)j * 6144 + sh_off + c), sc = *(const f32x4*)(mod_n + (size_t)j * 6144 + sc_off + c), gn = *(const f32x4*)(gn_n + c);
                    const f32x4 hv = (x[q][jj] * rstd * gn) * (sc + 1.0f) + sh;
                    v2u o; o.x = pk2(hv[0], hv[1]); o.y = pk2(hv[2], hv[3]);
                    *(v2u*)(F.H() + (size_t)r * DM + c) = o; }
            }
        }
    }
}

__device__ __forceinline__ void og_pass(const Frame& F, const bf16* OF, const bf16* OB) {
    const int lane = F.lane, gw = blockIdx.x * 8 + F.wave, NGW = F.G * 8;
    const bf16* GA = F.PROJ() + 2 * SEG; const bf16* GB = F.PROJ() + 7 * SEG;
    const int c0 = 16 * lane;
    float ogv[16];
#pragma unroll
    for (int i = 0; i < 16; ++i) ogv[i] = F.in(I_OUTG)[c0 + i];
    for (int r0 = gw; r0 < M; r0 += RB * NGW) {
        v4u a0[RB], a1[RB], b0[RB], b1[RB], g0[RB], g1[RB]; bool ok[RB];
#pragma unroll
        for (int q = 0; q < RB; ++q) { const int r = r0 + q * NGW; ok[q] = r < M;
            if (ok[q]) { a0[q] = *(const v4u*)(OF + (size_t)r * DM + c0); a1[q] = *(const v4u*)(OF + (size_t)r * DM + c0 + 8);
                b0[q] = *(const v4u*)(OB + (size_t)r * DM + c0); b1[q] = *(const v4u*)(OB + (size_t)r * DM + c0 + 8);
                const bf16* gp = c0 < 512 ? GA + (size_t)r * 512 + c0 : GB + (size_t)r * 512 + (c0 - 512);
                g0[q] = *(const v4u*)gp; g1[q] = *(const v4u*)(gp + 8); } }
#pragma unroll
        for (int q = 0; q < RB; ++q) { if (!ok[q]) continue; const int r = r0 + q * NGW;
            float v[16], gt[16];
#pragma unroll
            for (int i = 0; i < 4; ++i) { v[2 * i] = bflo(a0[q][i]) + bflo(b0[q][i]); v[2 * i + 1] = bfhi(a0[q][i]) + bfhi(b0[q][i]); v[8 + 2 * i] = bflo(a1[q][i]) + bflo(b1[q][i]); v[8 + 2 * i + 1] = bfhi(a1[q][i]) + bfhi(b1[q][i]);
                gt[2 * i] = bflo(g0[q][i]); gt[2 * i + 1] = bfhi(g0[q][i]); gt[8 + 2 * i] = bflo(g1[q][i]); gt[8 + 2 * i + 1] = bfhi(g1[q][i]); }
            float ss = 0.f;
#pragma unroll
            for (int i = 0; i < 16; ++i) ss += v[i] * v[i];
            ss += __shfl_xor(ss, 1); ss += __shfl_xor(ss, 2); ss += __shfl_xor(ss, 4);
            const float rstd = rsqrtf(ss * (1.f / 128.f) + EPS);
            unsigned o[8];
#pragma unroll
            for (int i = 0; i < 8; ++i) o[i] = pk2(v[2 * i] * rstd * ogv[2 * i] * gt[2 * i], v[2 * i + 1] * rstd * ogv[2 * i + 1] * gt[2 * i + 1]);
            *(v4u*)(F.OG() + (size_t)r * DM + c0) = (v4u){o[0], o[1], o[2], o[3]}; *(v4u*)(F.OG() + (size_t)r * DM + c0 + 8) = (v4u){o[4], o[5], o[6], o[7]};
        }
    }
}

__device__ __forceinline__ void qknorm_pass(const Frame& F) {
    const int lane = F.lane, gw = blockIdx.x * 8 + F.wave, NGW = F.G * 8;
    const float inv = exp2f(-(float)(2 * (lane & 31)) * (13.287712379549449f / 64.f));
    bf16* Kp = F.K();
    const float* g = F.in(I_QKG) + 128;
    const float ga = g[(lane >> 5) * 64 + (lane & 31)], gb = g[(lane >> 5) * 64 + 32 + (lane & 31)];
    for (int r0 = gw; r0 < M; r0 += RB * NGW) {
        unsigned short v[RB][4]; bool ok[RB];
#pragma unroll
        for (int q = 0; q < RB; ++q) { const int r = r0 + q * NGW; ok[q] = r < M;
            if (ok[q]) { const bf16* p = Kp + (size_t)r * 256 + (lane >> 5) * 128 + (lane & 31);
                v[q][0] = p[0]; v[q][1] = p[32]; v[q][2] = p[64]; v[q][3] = p[96]; } }
#pragma unroll
        for (int q = 0; q < RB; ++q) { if (!ok[q]) continue; const int r = r0 + q * NGW;
            const int b = r / TT, tt = r - b * TT; const bool isctx = tt < CTX;
            float x0 = bf2f(v[q][0]), x1 = bf2f(v[q][1]), x2 = bf2f(v[q][2]), x3 = bf2f(v[q][3]);
            float ss = (x0 * x0 + x1 * x1) + (x2 * x2 + x3 * x3);
#pragma unroll
            for (int o = 1; o < 32; o <<= 1) ss += __shfl_xor(ss, o);
            const float rstd = rsqrtf(ss * (1.f / 128.f) + EPS);
            x0 *= rstd * ga; x1 *= rstd * gb; x2 *= rstd * ga; x3 *= rstd * gb;
            if (!isctx) { const int t = tt - CTX; const float a0 = (float)(t >> 6) * inv, a1 = (float)(t & 63) * inv; const float s0 = __sinf(a0), c0 = __cosf(a0), s1 = __sinf(a1), c1 = __cosf(a1);
                const float y0 = x0 * c0 - x1 * s0, y1 = x1 * c0 + x0 * s0, y2 = x2 * c1 - x3 * s1, y3 = x3 * c1 + x2 * s1; x0 = y0; x1 = y1; x2 = y2; x3 = y3; }
            bf16* p = Kp + (size_t)r * 256 + (lane >> 5) * 128 + (lane & 31);
            p[0] = (bf16)f2bf(x0); p[32] = (bf16)f2bf(x1); p[64] = (bf16)f2bf(x2); p[96] = (bf16)f2bf(x3);
        }
    }
}

namespace scan {
typedef short bf16x8 __attribute__((ext_vector_type(8)));
typedef float f32x16 __attribute__((ext_vector_type(16)));
typedef float f32x4 __attribute__((ext_vector_type(4)));
typedef unsigned u32x4 __attribute__((ext_vector_type(4)));
typedef unsigned u32x2 __attribute__((ext_vector_type(2)));
constexpr int NCH = TT / 32;
constexpr int TS = 80;
__device__ __forceinline__ int crow(int r, int hi) { return (r & 3) + 8 * (r >> 2) + 4 * hi; }
__device__ __forceinline__ int kpos(int x) { return (x & ~12) | ((x & 4) << 1) | ((x & 8) >> 1); }
__device__ __forceinline__ unsigned cvtpk(float lo, float hi) { unsigned r; asm volatile("v_cvt_pk_bf16_f32 %0, %1, %2" : "=v"(r) : "v"(lo), "v"(hi)); return r; }
__device__ __forceinline__ bf16x8 pack8(const f32x16& v, int base) {
    u32x4 w; w.x = cvtpk(v[base + 0], v[base + 1]); w.y = cvtpk(v[base + 2], v[base + 3]); w.z = cvtpk(v[base + 4], v[base + 5]); w.w = cvtpk(v[base + 6], v[base + 7]);
    return __builtin_bit_cast(bf16x8, w); }
__device__ __forceinline__ float lo16(unsigned w) { return __builtin_bit_cast(float, w << 16); }
__device__ __forceinline__ float hi16(unsigned w) { return __builtin_bit_cast(float, w & 0xffff0000u); }
__device__ __forceinline__ float xhalf_sum(float v) { auto rr = __builtin_amdgcn_permlane32_swap(__float_as_uint(v), __float_as_uint(v), false, false); return __uint_as_float(rr[0]) + __uint_as_float(rr[1]); }
__device__ __forceinline__ int chunk_row0(int b, int dir, int c) {
    if (c < CTX / 32) return b * TT + (dir ? CTX - 1 - 32 * c : 32 * c);
    const int cc = c - CTX / 32; return b * TT + CTX + (dir ? SEQ - 1 - 32 * cc : 32 * cc);
}
template <int DK> struct Lay {
    static constexpr int RS = DK * 2 + 16;
    static constexpr int Q1 = 0, K1 = 32 * RS, Q2 = 64 * RS, K2T = 96 * RS, VT = K2T + DK * TS, SC = VT + 128 * TS, BYTES = SC + 1024;
};

template <int DK, bool ML, bool STATE_ONLY>
__device__ __forceinline__ void consume(const LAS unsigned char* buf, f32x16 (&S)[DK / 32], LAS float* wpriv, int w, int r32, int hi,
                                        unsigned short* O, int row0, int rstep, int colbase, int variant = 0) {
    using L = Lay<DK>; constexpr int DT = DK / 32, NK = DK / 16;
    const LAS unsigned char* q1 = buf + L::Q1 + r32 * L::RS + hi * 16;
    const LAS unsigned char* k1 = buf + L::K1 + r32 * L::RS + hi * 16;
    const LAS unsigned char* q2 = buf + L::Q2 + r32 * L::RS + hi * 16;
    const LAS float* sc = (const LAS float*)(buf + L::SC);
    f32x16 X = {}, o = {};
    float rden[16];
    if (!STATE_ONLY) {
    bf16x8 q2f[NK];
#pragma unroll
    for (int ks = 0; ks < NK; ++ks) { const bf16x8 a = *(const LAS bf16x8*)(k1 + ks * 32), bq = *(const LAS bf16x8*)(q1 + ks * 32);
        X = __builtin_amdgcn_mfma_f32_32x32x16_bf16(a, bq, X, 0, 0, 0); }
#pragma unroll
    for (int ks = 0; ks < NK; ++ks) { q2f[ks] = *(const LAS bf16x8*)(q2 + ks * 32);
        o = __builtin_amdgcn_mfma_f32_32x32x16_bf16(q2f[ks], pack8(S[ks >> 1], (ks & 1) * 8), o, 0, 0, 0); }
    if (ML) {
        const float ct = sc[32 + r32];
        float colsum = 0.f;
#pragma unroll
        for (int g = 0; g < 4; ++g) { const f32x4 av = *(const LAS f32x4*)(sc + 8 * g + 4 * hi);
#pragma unroll
            for (int i = 0; i < 4; ++i) { const int r = 4 * g + i, s = 8 * g + 4 * hi + i; const float p = (s <= r32) ? __expf(av[i] - ct) : 0.f; X[r] *= p; colsum += X[r]; } }
        float qn = 0.f;
#pragma unroll
        for (int ks = 0; ks < NK; ++ks) { const u32x4 qa = __builtin_bit_cast(u32x4, q2f[ks]);
            const f32x4 n0 = *(const LAS f32x4*)(wpriv + 16 * ks + 4 * hi), n1 = *(const LAS f32x4*)(wpriv + 16 * ks + 8 + 4 * hi);
            qn += lo16(qa.x) * n0[0] + hi16(qa.x) * n0[1] + lo16(qa.y) * n0[2] + hi16(qa.y) * n0[3] + lo16(qa.z) * n1[0] + hi16(qa.z) * n1[1] + lo16(qa.w) * n1[2] + hi16(qa.w) * n1[3]; }
        const float den = xhalf_sum(colsum + qn);
        const float rd = 1.0f / fmaxf(fabsf(den), sc[64 + r32]);
        if (hi == 0) wpriv[64 + r32] = rd;
#pragma unroll
        for (int g = 0; g < 4; ++g) { const f32x4 dv = *(const LAS f32x4*)(wpriv + 64 + 8 * g + 4 * hi);
#pragma unroll
            for (int i = 0; i < 4; ++i) rden[4 * g + i] = dv[i]; }
    } else {
#pragma unroll
        for (int r = 0; r < 16; ++r) { if (crow(r, hi) > r32) X[r] = 0.f; }
    }
    }
    const LAS unsigned char* vt = buf + L::VT + (32 * w + r32) * TS + hi * 16;
    const bf16x8 v0 = *(const LAS bf16x8*)(vt), v1 = *(const LAS bf16x8*)(vt + 32);
    if (!STATE_ONLY) {
    o = __builtin_amdgcn_mfma_f32_32x32x16_bf16(pack8(X, 0), v0, o, 0, 0, 0);
    o = __builtin_amdgcn_mfma_f32_32x32x16_bf16(pack8(X, 8), v1, o, 0, 0, 0); }
    const LAS unsigned char* k2 = buf + L::K2T + r32 * TS + hi * 16;
    const float decay = ML ? sc[96] : 1.f;
#pragma unroll
    for (int dt = 0; dt < DT; ++dt) {
        if (ML) { S[dt] = S[dt] * decay; }
        else {
#pragma unroll
            for (int g = 0; g < 4; ++g) { const f32x4 gv = *(const LAS f32x4*)(sc + 32 * dt + 8 * g + 4 * hi);
#pragma unroll
                for (int i = 0; i < 4; ++i) S[dt][4 * g + i] *= gv[i]; } }
        const bf16x8 a0 = *(const LAS bf16x8*)(k2 + dt * 32 * TS), a1 = *(const LAS bf16x8*)(k2 + dt * 32 * TS + 32);
        S[dt] = __builtin_amdgcn_mfma_f32_32x32x16_bf16(a0, v0, S[dt], 0, 0, 0);
        S[dt] = __builtin_amdgcn_mfma_f32_32x32x16_bf16(a1, v1, S[dt], 0, 0, 0);
        if (ML) {
            const u32x4 ua = __builtin_bit_cast(u32x4, a0), ub = __builtin_bit_cast(u32x4, a1);
            float ksum = (lo16(ua.x) + hi16(ua.x)) + (lo16(ua.y) + hi16(ua.y)) + (lo16(ua.z) + hi16(ua.z)) + (lo16(ua.w) + hi16(ua.w))
                       + (lo16(ub.x) + hi16(ub.x)) + (lo16(ub.y) + hi16(ub.y)) + (lo16(ub.z) + hi16(ub.z)) + (lo16(ub.w) + hi16(ub.w));
            ksum = xhalf_sum(ksum);
            if (hi == 0) wpriv[32 * dt + r32] = decay * wpriv[32 * dt + r32] + ksum;
        }
    }
    if (STATE_ONLY) return;
    if (variant & 16) { float keep = 0.f;
#pragma unroll
        for (int r = 0; r < 16; ++r) keep += ML ? o[r] * rden[r] : o[r];
        asm volatile("" :: "v"(keep)); return; }
    unsigned short* op = O + colbase + 32 * w + r32;
#pragma unroll
    for (int r = 0; r < 16; ++r) { const float v = ML ? o[r] * rden[r] : o[r]; const unsigned u = __float_as_uint(v);
        op[(long)(row0 + rstep * crow(r, hi)) * DM] = (unsigned short)((u + 0x7fffu + ((u >> 16) & 1u)) >> 16); }
}

struct HgPre { unsigned z[8], q[8], v[8]; };
template <bool LIGHT> __device__ __forceinline__ void hg_load(HgPre& P, const unsigned short* Z, const unsigned short* QA, const unsigned short* VA, int row0, int rstep, int colg, int qd) {
#pragma unroll
    for (int ii = 0; ii < 8; ++ii) { const size_t off = (size_t)(row0 + rstep * (8 * qd + ii)) * 512 + colg;
        P.z[ii] = *(const unsigned*)(Z + off); P.q[ii] = LIGHT ? 0u : *(const unsigned*)(QA + off); P.v[ii] = *(const unsigned*)(VA + off); }
}
template <bool LIGHT> __device__ __forceinline__ void hg_produce(LAS unsigned char* buf, const HgPre& P, float lb0, float lb1, int pw, int cp, int qd, float& gam0, float& gam1) {
    using L = Lay<128>;
    const int d0 = 32 * pw + 2 * cp;
    float q[2][8], k[2][8], Pc[2][8], RP[2][8];
#pragma unroll
    for (int x = 0; x < 2; ++x) { const float lb = x ? lb1 : lb0; float p = 1.f, rp = 1.f;
#pragma unroll
        for (int ii = 0; ii < 8; ++ii) { const float z = x ? hi16(P.z[ii]) : lo16(P.z[ii]); q[x][ii] = x ? hi16(P.q[ii]) : lo16(P.q[ii]);
            const float sg = __builtin_amdgcn_rcpf(1.f + __expf(-z)); const float f = lb + (1.f - lb) * sg; k[x][ii] = (1.f - lb) * (1.f - sg);
            p *= f; rp *= __builtin_amdgcn_rcpf(f); Pc[x][ii] = p; RP[x][ii] = rp; } }
    const int lane = cp + 16 * qd;
    unsigned k2lo[2][2], k2hi[2][2];
#pragma unroll
    for (int x = 0; x < 2; ++x) {
        const float T = Pc[x][7];
        const float T0 = __shfl(T, cp), T1 = __shfl(T, cp + 16), T2 = __shfl(T, cp + 32), T3 = __shfl(T, cp + 48);
        const float emid = T0 * T1, elast = T2 * T3;
        const float scale = qd == 0 ? __builtin_amdgcn_rcpf(emid) : (qd == 1 ? __builtin_amdgcn_rcpf(T1) : (qd == 2 ? 1.f : T2));
        const float rscale = qd == 0 ? emid : (qd == 1 ? T1 : (qd == 2 ? 1.f : __builtin_amdgcn_rcpf(T2)));
#pragma unroll
        for (int ii = 0; ii < 8; ++ii) { const float qt = q[x][ii] * (Pc[x][ii] * scale), kt = k[x][ii] * (RP[x][ii] * rscale);
            q[x][ii] = qt; k[x][ii] = kt; Pc[x][ii] = qt * emid; RP[x][ii] = kt * elast; }
        k2lo[x][0] = cvtpk(RP[x][0], RP[x][1]); k2lo[x][1] = cvtpk(RP[x][2], RP[x][3]); k2hi[x][0] = cvtpk(RP[x][4], RP[x][5]); k2hi[x][1] = cvtpk(RP[x][6], RP[x][7]);
        if (qd == 0) ((LAS float*)(buf + L::SC))[d0 + x] = emid * elast;
        if (x == 0) gam0 *= emid * elast; else gam1 *= emid * elast;
    }
    (void)lane;
    const int pd = ((d0 & ~15) | kpos(d0 & 15)) * 2;
    if (!LIGHT) {
#pragma unroll
    for (int ii = 0; ii < 8; ++ii) { const int i = 8 * qd + ii;
        *(LAS unsigned*)(buf + L::Q1 + i * L::RS + pd) = cvtpk(q[0][ii], q[1][ii]);
        *(LAS unsigned*)(buf + L::K1 + i * L::RS + pd) = cvtpk(k[0][ii], k[1][ii]);
        *(LAS unsigned*)(buf + L::Q2 + i * L::RS + pd) = cvtpk(Pc[0][ii], Pc[1][ii]); } }
    const int ps = (16 * (qd >> 1) + 4 * (qd & 1)) * 2;
#pragma unroll
    for (int x = 0; x < 2; ++x) {
        *(LAS u32x2*)(buf + L::K2T + (d0 + x) * TS + ps) = (u32x2){k2lo[x][0], k2lo[x][1]};
        *(LAS u32x2*)(buf + L::K2T + (d0 + x) * TS + ps + 16) = (u32x2){k2hi[x][0], k2hi[x][1]};
        unsigned a, b2, c2, d2;
        if (x == 0) { a = (P.v[0] & 0xffffu) | (P.v[1] << 16); b2 = (P.v[2] & 0xffffu) | (P.v[3] << 16); c2 = (P.v[4] & 0xffffu) | (P.v[5] << 16); d2 = (P.v[6] & 0xffffu) | (P.v[7] << 16); }
        else { a = (P.v[0] >> 16) | (P.v[1] & 0xffff0000u); b2 = (P.v[2] >> 16) | (P.v[3] & 0xffff0000u); c2 = (P.v[4] >> 16) | (P.v[5] & 0xffff0000u); d2 = (P.v[6] >> 16) | (P.v[7] & 0xffff0000u); }
        *(LAS u32x2*)(buf + L::VT + (d0 + x) * TS + ps) = (u32x2){a, b2};
        *(LAS u32x2*)(buf + L::VT + (d0 + x) * TS + ps + 16) = (u32x2){c2, d2};
    }
}

struct MlPre { unsigned x[10], v[8]; float ig, fg; };
__device__ __forceinline__ void ml_load(MlPre& P, const unsigned short* BQK, const unsigned short* VB, const float* BG, int segrow0, int L, int tq0, int colq, int colv,
                                        int row0, int rstep, int qd, int i32, int gi_i, int gi_f, float gb_i, float gb_f) {
#pragma unroll
    for (int jj = 0; jj < 10; ++jj) { const int t = tq0 - 1 + jj; P.x[jj] = (t >= 0 && t < L) ? *(const unsigned*)(BQK + (size_t)(segrow0 + t) * 512 + colq) : 0u; }
#pragma unroll
    for (int ii = 0; ii < 8; ++ii) P.v[ii] = *(const unsigned*)(VB + (size_t)(row0 + rstep * (8 * qd + ii)) * 512 + colv);
    const size_t gr = (size_t)(row0 + rstep * i32) * 16;
    P.ig = BG[gr + gi_i] + gb_i; P.fg = BG[gr + gi_f] + gb_f;
}
template <bool LIGHT> __device__ __forceinline__ void ml_produce(LAS unsigned char* buf, const MlPre& P, LAS float* ppriv, float& m, float& Bacc, int dir, int pw, int cp, int qd, int lane,
                                           float w00, float w01, float w02, float w10, float w11, float w12) {
    using L = Lay<64>;
    const int i32 = lane & 31;
    const float logf = fminf(P.fg, 0.f) - log1pf(__expf(-fabsf(P.fg)));
    float bh = logf;
#pragma unroll
    for (int o = 1; o < 32; o <<= 1) { const float t = __shfl_up(bh, o, 32); if (i32 >= o) bh += t; }
    const float a = P.ig - bh;
    float pm = a;
#pragma unroll
    for (int o = 1; o < 32; o <<= 1) { const float t = __shfl_up(pm, o, 32); if (i32 >= o) pm = fmaxf(pm, t); }
    const float c = fmaxf(pm, m);
    const float c31 = __shfl(c, 31, 32), bh31 = __shfl(bh, 31, 32);
    const float winter = __expf(m - c), wk = __expf(a - c31), decay = __expf(m - c31), flo = __expf(-(bh + c));
    if (lane < 32) { ppriv[i32] = winter; ppriv[32 + i32] = wk; }
    if (pw == 0 && lane < 32) { LAS float* sc = (LAS float*)(buf + L::SC); sc[i32] = a; sc[32 + i32] = c; sc[64 + i32] = flo; if (i32 == 0) sc[96] = decay; }
    m = bh31 + c31; Bacc += bh31;
    const bool isk = pw >= 2;
    float y[2][8];
    if (!LIGHT || isk) {
#pragma unroll
    for (int mm = 0; mm < 8; ++mm) {
        const float c0v = w00 * lo16(P.x[mm]) + w01 * lo16(P.x[mm + 1]) + w02 * lo16(P.x[mm + 2]);
        const float c1v = w10 * hi16(P.x[mm]) + w11 * hi16(P.x[mm + 1]) + w12 * hi16(P.x[mm + 2]);
        const float s0 = c0v * __builtin_amdgcn_rcpf(1.f + __expf(-c0v)), s1 = c1v * __builtin_amdgcn_rcpf(1.f + __expf(-c1v));
        const int ii = dir ? 7 - mm : mm;
        y[0][ii] = isk ? s0 : s0 * 0.125f; y[1][ii] = isk ? s1 : s1 * 0.125f; } }
    const LAS float* wp = ppriv + (isk ? 32 : 0) + 8 * qd;
    const f32x4 wa = *(const LAS f32x4*)wp, wb = *(const LAS f32x4*)(wp + 4);
    float ws[8] = {wa[0], wa[1], wa[2], wa[3], wb[0], wb[1], wb[2], wb[3]};
    const int cc = (32 * pw + 2 * cp) & 63;
    const int ps = (16 * (qd >> 1) + 4 * (qd & 1)) * 2;
    if (!isk) {
      if (!LIGHT) {
        const int pd = ((cc & ~15) | kpos(cc & 15)) * 2;
#pragma unroll
        for (int ii = 0; ii < 8; ++ii) { const int i = 8 * qd + ii;
            *(LAS unsigned*)(buf + L::Q1 + i * L::RS + pd) = cvtpk(y[0][ii], y[1][ii]);
            *(LAS unsigned*)(buf + L::Q2 + i * L::RS + pd) = cvtpk(y[0][ii] * ws[ii], y[1][ii] * ws[ii]); } }
    } else {
        const int pd = ((cc & ~15) | kpos(cc & 15)) * 2;
#pragma unroll
        for (int ii = 0; ii < 8; ++ii) { const int i = 8 * qd + ii; if (!LIGHT) *(LAS unsigned*)(buf + L::K1 + i * L::RS + pd) = cvtpk(y[0][ii], y[1][ii]); }
#pragma unroll
        for (int x = 0; x < 2; ++x) {
            *(LAS u32x2*)(buf + L::K2T + (cc + x) * TS + ps) = (u32x2){cvtpk(y[x][0] * ws[0], y[x][1] * ws[1]), cvtpk(y[x][2] * ws[2], y[x][3] * ws[3])};
            *(LAS u32x2*)(buf + L::K2T + (cc + x) * TS + ps + 16) = (u32x2){cvtpk(y[x][4] * ws[4], y[x][5] * ws[5]), cvtpk(y[x][6] * ws[6], y[x][7] * ws[7])}; }
    }
    const int e0 = 32 * pw + 2 * cp;
#pragma unroll
    for (int x = 0; x < 2; ++x) {
        unsigned a2, b2, c2, d2;
        if (x == 0) { a2 = (P.v[0] & 0xffffu) | (P.v[1] << 16); b2 = (P.v[2] & 0xffffu) | (P.v[3] << 16); c2 = (P.v[4] & 0xffffu) | (P.v[5] << 16); d2 = (P.v[6] & 0xffffu) | (P.v[7] << 16); }
        else { a2 = (P.v[0] >> 16) | (P.v[1] & 0xffff0000u); b2 = (P.v[2] >> 16) | (P.v[3] & 0xffff0000u); c2 = (P.v[4] >> 16) | (P.v[5] & 0xffff0000u); d2 = (P.v[6] >> 16) | (P.v[7] & 0xffff0000u); }
        *(LAS u32x2*)(buf + L::VT + (e0 + x) * TS + ps) = (u32x2){a2, b2};
        *(LAS u32x2*)(buf + L::VT + (e0 + x) * TS + ps + 16) = (u32x2){c2, d2};
    }
}

#define SCAN_BAR() do { asm volatile("s_waitcnt lgkmcnt(0)" ::: "memory"); __builtin_amdgcn_s_barrier(); asm volatile("" ::: "memory"); } while (0)

constexpr int NSEG = 4, CPS = NCH / NSEG;
static_assert(NCH % NSEG == 0 && (CPS - 1) % 3 == 0 && CPS % 2 == 0, "segment geometry");
struct Xch { float* SXH; float* GXH; float* SXM; float* NXM; float* MXM; };
template <int PASS>
__device__ __forceinline__ void run_hgrn(LAS unsigned char* lds, int ch, int seg, const unsigned short* PROJ, const float* hgrn_lb, unsigned short* OF, unsigned short* OB, const Xch X, int variant) {
    using L = Lay<128>;
    if (PASS == 0 && seg == NSEG - 1) return;
    const int tid = threadIdx.x, wave = __builtin_amdgcn_readfirstlane(tid >> 6), lane = tid & 63;
    const int b = ch >> 3, h = (ch >> 1) & 3, dir = ch & 1, rstep = dir ? -1 : 1;
    const int c0 = seg * CPS;
    const unsigned short* QA = PROJ; const unsigned short* VA = PROJ + SEG; const unsigned short* Z = PROJ + (3 + dir) * SEG;
    unsigned short* O = dir ? OB : OF;
    if (wave < 4) {
        f32x16 S[4] = {};
        const int r32 = lane & 31, hi = lane >> 5;
        if (PASS == 1 && seg > 0) {
            const float* sx = X.SXH + ((size_t)(ch * 3) * 4 + wave) * 4096 + lane;
#pragma unroll
            for (int dt = 0; dt < 4; ++dt)
#pragma unroll
                for (int r = 0; r < 16; ++r) S[dt][r] = sx[(dt * 16 + r) * 64];
            for (int i = 1; i < seg; ++i) { const float* gam = X.GXH + (size_t)(ch * 3 + i) * 128;
#pragma unroll
                for (int dt = 0; dt < 4; ++dt)
#pragma unroll
                    for (int r = 0; r < 16; ++r) S[dt][r] = S[dt][r] * gam[32 * dt + crow(r, hi)] + sx[(size_t)i * 16384 + (dt * 16 + r) * 64]; }
        }
        SCAN_BAR();
        for (int c = c0; c < c0 + CPS; ++c) {
            consume<128, false, PASS == 0>(lds + (c & 1) * L::BYTES, S, nullptr, wave, r32, hi, O, chunk_row0(b, dir, c), rstep, h * 128, variant);
            SCAN_BAR();
        }
        if (PASS == 0) { float* sx = X.SXH + ((size_t)(ch * 3 + seg) * 4 + wave) * 4096 + lane;
#pragma unroll
            for (int dt = 0; dt < 4; ++dt)
#pragma unroll
                for (int r = 0; r < 16; ++r) sx[(dt * 16 + r) * 64] = S[dt][r]; }
    } else {
        const int pw = wave - 4, cp = lane & 15, qd = lane >> 4, d0 = 32 * pw + 2 * cp, colg = h * 128 + d0;
        float lbv[2];
#pragma unroll
        for (int x = 0; x < 2; ++x) { const float* p = hgrn_lb + (size_t)dir * 3 * 512 + h * 128 + d0 + x; const float a0 = p[0], a1 = p[512], a2 = p[1024];
            const float mx = fmaxf(a0, fmaxf(a1, a2)); const float e0 = __expf(a0 - mx), e1 = __expf(a1 - mx), e2 = __expf(a2 - mx); lbv[x] = e0 / (e0 + e1 + e2); }
        float gam0 = 1.f, gam1 = 1.f;
        HgPre P0, P1, P2;
#define HG_LD(P_, j_) hg_load<PASS == 0>(P_, Z, QA, VA, chunk_row0(b, dir, c0 + (j_)), rstep, colg, qd)
#define HG_STEP(j_, LS, PS) do { if ((j_) + 3 < CPS && !(variant & 32)) HG_LD(LS, (j_) + 3); if ((j_) + 1 < CPS) hg_produce<PASS == 0>(lds + (((j_) + 1) & 1) * L::BYTES, PS, lbv[0], lbv[1], pw, cp, qd, gam0, gam1); SCAN_BAR(); } while (0)
        HG_LD(P0, 0); HG_LD(P1, 1); HG_LD(P2, 2);
        hg_produce<PASS == 0>(lds, P0, lbv[0], lbv[1], pw, cp, qd, gam0, gam1);
        SCAN_BAR();
        for (int j = 0; j < CPS - 1; j += 3) { HG_STEP(j, P0, P1); HG_STEP(j + 1, P1, P2); HG_STEP(j + 2, P2, P0); }
        SCAN_BAR();
#undef HG_LD
#undef HG_STEP
        if (PASS == 0 && qd == 0) { float* g = X.GXH + (size_t)(ch * 3 + seg) * 128 + d0; g[0] = gam0; g[1] = gam1; }
    }
}
template <int PASS>
__device__ __forceinline__ void run_mlstm(LAS unsigned char* lds, int ch, int seg, const unsigned short* PROJ, const float* BG, const float* conv, const float* gate_b, unsigned short* OF, unsigned short* OB, const Xch X, int variant) {
    using L = Lay<64>;
    if (PASS == 0 && seg == NSEG - 1) return;
    const int tid = threadIdx.x, wave = __builtin_amdgcn_readfirstlane(tid >> 6), lane = tid & 63;
    const int b = ch >> 3, h = (ch >> 1) & 3, dir = ch & 1, rstep = dir ? -1 : 1;
    const int c0 = seg * CPS;
    const unsigned short* BQK = PROJ + 5 * SEG; const unsigned short* VB = PROJ + 6 * SEG;
    unsigned short* O = dir ? OB : OF;
    LAS float* priv = (LAS float*)(lds + 2 * L::BYTES) + wave * 128;
    float mstart = (PASS == 0) ? (seg == 0 ? 0.f : -1e30f) : 0.f;
    float fa1 = 0.f, fb1 = 0.f, fa2 = 0.f, fb2 = 0.f;
    if (PASS == 1 && seg > 0) { const float* mx = X.MXM + (size_t)(ch * 3) * 2;
        float m = mx[0];
        if (seg > 1) { const float ml = mx[2], B = mx[3]; const float mn = fmaxf(B + m, ml); fa1 = __expf(B + m - mn); fb1 = __expf(ml - mn); m = mn; }
        if (seg > 2) { const float ml = mx[4], B = mx[5]; const float mn = fmaxf(B + m, ml); fa2 = __expf(B + m - mn); fb2 = __expf(ml - mn); m = mn; }
        mstart = m; }
    if (wave < 4) {
        f32x16 S[2] = {};
        const int r32 = lane & 31, hi = lane >> 5;
        float nv = 0.f;
        if (PASS == 1 && seg > 0) {
            const float* sx = X.SXM + ((size_t)(ch * 3) * 4 + wave) * 2048 + lane;
            const float* nx = X.NXM + (size_t)(ch * 3) * 64 + lane;
#pragma unroll
            for (int dt = 0; dt < 2; ++dt)
#pragma unroll
                for (int r = 0; r < 16; ++r) S[dt][r] = sx[(dt * 16 + r) * 64];
            nv = nx[0];
            if (seg > 1) {
#pragma unroll
                for (int dt = 0; dt < 2; ++dt)
#pragma unroll
                    for (int r = 0; r < 16; ++r) S[dt][r] = fa1 * S[dt][r] + fb1 * sx[8192 + (dt * 16 + r) * 64];
                nv = fa1 * nv + fb1 * nx[64]; }
            if (seg > 2) {
#pragma unroll
                for (int dt = 0; dt < 2; ++dt)
#pragma unroll
                    for (int r = 0; r < 16; ++r) S[dt][r] = fa2 * S[dt][r] + fb2 * sx[16384 + (dt * 16 + r) * 64];
                nv = fa2 * nv + fb2 * nx[128]; }
        }
        priv[lane] = nv;
        SCAN_BAR();
        for (int c = c0; c < c0 + CPS; ++c) {
            consume<64, true, PASS == 0>(lds + (c & 1) * L::BYTES, S, priv, wave, r32, hi, O, chunk_row0(b, dir, c), rstep, 512 + h * 128, variant);
            SCAN_BAR();
        }
        if (PASS == 0) { float* sx = X.SXM + ((size_t)(ch * 3 + seg) * 4 + wave) * 2048 + lane;
#pragma unroll
            for (int dt = 0; dt < 2; ++dt)
#pragma unroll
                for (int r = 0; r < 16; ++r) sx[(dt * 16 + r) * 64] = S[dt][r];
            if (wave == 0) X.NXM[(size_t)(ch * 3 + seg) * 64 + lane] = priv[lane]; }
    } else {
        const int pw = wave - 4, cp = lane & 15, qd = lane >> 4, i32 = lane & 31;
        const int cc = 32 * pw + 2 * cp;
        const int colq = cc < 64 ? h * 64 + cc : 256 + h * 64 + (cc - 64);
        const int colv = h * 128 + cc;
        const float w00 = conv[colq], w01 = conv[512 + colq], w02 = conv[1024 + colq], w10 = conv[colq + 1], w11 = conv[512 + colq + 1], w12 = conv[1024 + colq + 1];
        const int gi_i = 4 * (2 * dir) + h, gi_f = 4 * (2 * dir + 1) + h; const float gb_i = gate_b[gi_i], gb_f = gate_b[gi_f];
        float m = mstart, Bacc = 0.f;
        MlPre P0, P1, P2;
#define ML_LOADC(P, j_) do { const int c__ = c0 + (j_); const bool lat = c__ >= CTX / 32; const int Lg = lat ? SEQ : CTX; const int segrow0 = b * TT + (lat ? CTX : 0); \
        const int i0 = 32 * (lat ? c__ - CTX / 32 : c__) + 8 * qd; const int tq0 = dir ? Lg - 1 - (i0 + 7) : i0; \
        ml_load(P, BQK, VB, BG, segrow0, Lg, tq0, colq, colv, chunk_row0(b, dir, c__), rstep, qd, i32, gi_i, gi_f, gb_i, gb_f); } while (0)
#define ML_STEP(j_, LS, PS) do { if ((j_) + 3 < CPS && !(variant & 32)) ML_LOADC(LS, (j_) + 3); if ((j_) + 1 < CPS) ml_produce<PASS == 0>(lds + (((j_) + 1) & 1) * L::BYTES, PS, priv, m, Bacc, dir, pw, cp, qd, lane, w00, w01, w02, w10, w11, w12); SCAN_BAR(); } while (0)
        ML_LOADC(P0, 0); ML_LOADC(P1, 1); ML_LOADC(P2, 2);
        ml_produce<PASS == 0>(lds, P0, priv, m, Bacc, dir, pw, cp, qd, lane, w00, w01, w02, w10, w11, w12);
        SCAN_BAR();
        for (int j = 0; j < CPS - 1; j += 3) { ML_STEP(j, P0, P1); ML_STEP(j + 1, P1, P2); ML_STEP(j + 2, P2, P0); }
        SCAN_BAR();
#undef ML_STEP
#undef ML_LOADC
        if (PASS == 0 && pw == 0 && lane == 0) { float* mx = X.MXM + (size_t)(ch * 3 + seg) * 2; mx[0] = m; mx[1] = Bacc; }
    }
}
#undef SCAN_BAR
}

enum { PH_PRO = 0, PH_MOD0, PH_INPROJ, PH_SCANA, PH_SCAN, PH_OG, PH_OUT0, PH_ROW0A, PH_FFI0, PH_FFO0, PH_ROW0B, PH_QKV, PH_QKN, PH_ATTN, PH_OUT1, PH_ROW1A, PH_FFI1, PH_FFO1, PH_ROW1B, NPH };

template <class FN> __device__ __forceinline__ void run_gemm(Frame& F, const bf16* A, const bf16* Bt, int N, int K, int skipctx, const FN& fn) {
    pg8::Gemm g{A, Bt, M, N, K}; pg8::TileOrder S; S.init(skipctx ? 64 : 68, N, F.G, (int)blockIdx.x, skipctx);
    pg8::Epi8<FN> E{fn};
    pg8::gemm_phase<pg8::Epi8<FN>, pg8::TileOrder, true, true>(F.lds, g, S, E);
}

__global__ void __launch_bounds__(512, 2) mk_fwd(Args args) {
    extern __shared__ __attribute__((aligned(16))) unsigned char lds[];
    cg::grid_group grid = cg::this_grid();
    Frame F;
    F.lds = (LAS unsigned char*)lds;
    F.tid = threadIdx.x; F.lane = F.tid & 63; F.wave = __builtin_amdgcn_readfirstlane(F.tid >> 6); F.G = gridDim.x;
    F.out = args.out; F.ws = args.ws;
    unsigned char* ws = args.ws;
#define OF ((bf16*)F.out)
#define OB (F.H())
#define MOD0 (F.MOD())
#define MOD1 (F.MOD() + 5 * 6144)
#define NG (F.in(I_NORMG))
    const int lo = args.ph_lo, hi = args.ph_hi;
    volatile LAS unsigned* MISC = (volatile LAS unsigned*)(F.lds + MISC_OFF);
    if (F.tid < 32) MISC[F.tid] = 0u;
    __syncthreads();
    XcdBarrier bar; bar.bar = (unsigned*)(ws + WS_CTL) + CW_BAR; bar.x = 0; bar.st = nullptr;
    if (MK_ONE) bar = xcd_barrier_post((unsigned*)(ws + WS_CTL) + CW_BAR, MISC + 8);
    if (PROBE_TS == 0 && blockIdx.x == 0 && F.tid == 0) *(volatile unsigned long long*)(ws + WS_TS + 64) = __builtin_amdgcn_s_memrealtime();
#define IN(k) (lo <= (k) && (k) < hi)
#define SEAM(k) do { if (IN(k) && IN((k) + 1)) { if ((k) == PH_PRO) grid.sync(); else xcd_barrier(bar); } \
    if (PROBE_TS >= 0 && blockIdx.x == 0 && F.tid == 0) { if ((k) + 1 == PROBE_TS) *(volatile unsigned long long*)(ws + WS_TS + 64) = __builtin_amdgcn_s_memrealtime(); \
        if ((k) == PROBE_TS) *(volatile float*)(ws + WS_TS) = (float)(__builtin_amdgcn_s_memrealtime() - *(volatile unsigned long long*)(ws + WS_TS + 64)) * (PROBE_SCALE); } } while (0)
#define NREP(k) 1
#define PH(k) for (int rep_ = 0; IN(k) && rep_ < NREP(k); (++rep_ < NREP(k)) ? grid.sync() : (void)0)

    PH(PH_PRO) p0_prologue(F);
    SEAM(PH_PRO);
    PH(PH_MOD0) rowpass<false, false, true, false>(F, F.in(I_X), F.in(I_CTX), nullptr, nullptr, nullptr, 0, nullptr, MOD0, 0, 1024, NG + 0);
    SEAM(PH_MOD0);
    PH(PH_INPROJ) run_gemm(F, F.H(), F.WAB(), NABP, 1024, 0, pg8::FProj{F.PROJ(), F.BG()});
    SEAM(PH_INPROJ);
    const scan::Xch XC{(float*)(ws + WS_SXH), (float*)(ws + WS_GXH), (float*)(ws + WS_SXM), (float*)(ws + WS_NXM), (float*)(ws + WS_MXM)};
    PH(PH_SCANA) for (int it = blockIdx.x; it < 256; it += F.G) { const int ch = it >> 2, sg = it & 3;
        if (ch < 32) scan::run_hgrn<0>(F.lds, ch, sg, F.PROJ(), F.in(I_LB), OF, OB, XC, args.variant);
        else if (ch < 64) scan::run_mlstm<0>(F.lds, ch - 32, sg, F.PROJ(), F.BG(), F.in(I_CONV), F.in(I_GATEB), OF, OB, XC, args.variant); }
    SEAM(PH_SCANA);
    PH(PH_SCAN) for (int it = blockIdx.x; it < 256; it += F.G) { const int ch = it >> 2, sg = it & 3;
        if (ch < 32) scan::run_hgrn<1>(F.lds, ch, sg, F.PROJ(), F.in(I_LB), OF, OB, XC, args.variant);
        else if (ch < 64) scan::run_mlstm<1>(F.lds, ch - 32, sg, F.PROJ(), F.BG(), F.in(I_CONV), F.in(I_GATEB), OF, OB, XC, args.variant); }
    SEAM(PH_SCAN);
    PH(PH_OG) og_pass(F, OF, OB);
    SEAM(PH_OG);
    PH(PH_OUT0) run_gemm(F, F.OG(), F.WABO(), 1024, 1024, 0, pg8::FStore{F.Y(), 1024});
    SEAM(PH_OUT0);
    PH(PH_ROW0A) rowpass<true, true, true, false>(F, F.in(I_X), F.in(I_CTX), F.out, F.XCTX(), MOD0, 2048, NG + 1024, MOD0, 3072, 4096, NG + 2048);
    SEAM(PH_ROW0A);
    PH(PH_FFI0) run_gemm(F, F.H(), F.WFI0(), 2 * DFF, 1024, 0, pg8::FSwiglu{F.ACT()});
    SEAM(PH_FFI0);
    PH(PH_FFO0) run_gemm(F, F.ACT(), F.WFO0(), 1024, DFF, 0, pg8::FStore{F.Y(), 1024});
    SEAM(PH_FFO0);
    PH(PH_ROW0B) rowpass<true, true, true, false>(F, F.out, F.XCTX(), F.out, F.XCTX(), MOD0, 5120, NG + 3072, MOD1, 0, 1024, NG + 4096);
    SEAM(PH_ROW0B);
    PH(PH_QKV) run_gemm(F, F.H(), F.WQKV(), NQKV, 1024, 0, pg8::FQkv{F.Q(), F.K(), F.V()});
    SEAM(PH_QKV);
    PH(PH_QKN) qknorm_pass(F);
    SEAM(PH_QKN);
    PH(PH_ATTN) {
        const int bx = blockIdx.x, vcu = (F.G % 8 == 0) ? (bx % 8) * (F.G / 8) + bx / 8 : bx;
        for (int u = vcu; u < 512; u += F.G) {
            const int uu = (u % 256) * 2 + u / 256;
            const int g = uu & 3, qb = (uu >> 2) & 15, kvh = (uu >> 6) & 1, b = uu >> 7, head = kvh * 4 + g;
            const size_t qrow = (size_t)b * TT + CTX + qb * 256;
            attn::q_norm_rope(F.Q() + qrow * 1024 + head * 128, F.in(I_QKG), qb * 256);
            __syncthreads();
            attn::attn_dense_body(F.Q() + qrow * 1024 + head * 128, F.K() + (size_t)b * TT * 256 + kvh * 128, F.V() + (size_t)b * TT * 256 + kvh * 128,
                                  F.OG() + qrow * 1024 + head * 128, TT, (char*)lds);
            __syncthreads();
        }
    }
    SEAM(PH_ATTN);
    PH(PH_OUT1) run_gemm(F, F.OG(), F.WAO(), 1024, 1024, 1, pg8::FStore{F.Y(), 1024});
    SEAM(PH_OUT1);
    PH(PH_ROW1A) rowpass<true, true, true, true>(F, F.out, F.XCTX(), F.out, F.XCTX(), MOD1, 2048, NG + 5120, MOD1, 3072, 4096, NG + 6144);
    SEAM(PH_ROW1A);
    PH(PH_FFI1) run_gemm(F, F.H(), F.WFI1(), 2 * DFF, 1024, 1, pg8::FSwiglu{F.ACT()});
    SEAM(PH_FFI1);
    PH(PH_FFO1) run_gemm(F, F.ACT(), F.WFO1(), 1024, DFF, 1, pg8::FStore{F.Y(), 1024});
    SEAM(PH_FFO1);
    PH(PH_ROW1B) rowpass<true, true, false, true>(F, F.out, F.XCTX(), F.out, F.XCTX(), MOD1, 5120, NG + 7168, nullptr, 0, 0, nullptr);
#undef IN
#undef SEAM
#undef MOD0
#undef MOD1
#undef NG
#undef OB
#undef OF
#undef PH
#undef NREP
}

__global__ void __launch_bounds__(256) probe_scale(float* out, const unsigned char* ws) {
    const float sc1 = 1.0f + *(const float*)(ws + WS_TS);
    for (size_t i = (size_t)blockIdx.x * 256 + threadIdx.x; i < (size_t)NB * SEQ * DM; i += (size_t)gridDim.x * 256) out[i] *= sc1;
}
extern "C" void kernel_launch(void* const* d_in, const int* in_sizes, int n_in, void* d_out, int out_size, void* d_ws, size_t ws_size, hipStream_t stream) {
    static int grid = 0;
    if (grid == 0) {
        if (n_in != 18 || in_sizes[0] != NB * SEQ * DM || out_size != NB * SEQ * DM || ws_size < WS_END) {
            fprintf(stderr, "kernel_launch: unexpected shapes (n_in %d, in0 %d, out %d, ws %zu)\n", n_in, n_in > 0 ? in_sizes[0] : -1, out_size, ws_size); grid = -1; return; }
        int dev = 0, cus = 0, per_cu = 0;
        if (hipGetDevice(&dev) != hipSuccess || hipDeviceGetAttribute(&cus, hipDeviceAttributeMultiprocessorCount, dev) != hipSuccess) { grid = -1; return; }
        if (hipFuncSetAttribute((const void*)mk_fwd, hipFuncAttributeMaxDynamicSharedMemorySize, LDS_BYTES) != hipSuccess) { fprintf(stderr, "kernel_launch: hipFuncSetAttribute failed\n"); grid = -1; return; }
        if (hipOccupancyMaxActiveBlocksPerMultiprocessor(&per_cu, (const void*)mk_fwd, 512, LDS_BYTES) != hipSuccess || per_cu < 1) { fprintf(stderr, "kernel_launch: occupancy query says %d blocks per CU\n", per_cu); per_cu = 1; }
        (void)hipGetLastError();
        grid = cus;
        fprintf(stderr, "kernel_launch: grid %d (occupancy query %d per CU)\n", grid, per_cu);
    }
    if (grid < 0) return;
    if (MK_ONE) { if (hipMemsetAsync((char*)d_ws + WS_CTL, 0, CTL_ZERO_BYTES, stream) != hipSuccess) { fprintf(stderr, "kernel_launch: memset failed\n"); return; } }
    Args a{};
    for (int i = 0; i < 18; ++i) a.in[i] = (const float*)d_in[i];
    a.out = (float*)d_out; a.ws = (unsigned char*)d_ws;
#if MK_ONE
    a.ph_lo = 0; a.ph_hi = NPH;
    void* kargs[] = {&a};
    hipError_t e = hipLaunchCooperativeKernel((const void*)mk_fwd, dim3(grid), dim3(512), kargs, LDS_BYTES, stream);
    if (e != hipSuccess) fprintf(stderr, "kernel_launch: cooperative launch failed: %s (grid %d)\n", hipGetErrorString(e), grid);
    if (PROBE_TS >= 0) hipLaunchKernelGGL(probe_scale, dim3(1024), dim3(256), 0, stream, (float*)d_out, (const unsigned char*)d_ws);
#else
    for (int p = 0; p < NPH; ++p) for (int rep = 0; rep < ((((PROBE_REP) >> p) & 1) ? 2 : 1); ++rep) { a.ph_lo = p; a.ph_hi = p + 1; a.variant = rep ? (PROBE_VAR) : 0; hipLaunchKernelGGL(mk_fwd, dim3(grid), dim3(512), LDS_BYTES, stream, a); }
    const hipError_t le = hipPeekAtLastError();
    if (le != hipSuccess) fprintf(stderr, "kernel_launch: launch failed: %s\n", hipGetErrorName(le));
#endif
}
```

```cpp
#include <hip/hip_runtime.h>
#include <hip/hip_cooperative_groups.h>
#include <cstdio>
#include <cstdint>
namespace cg = cooperative_groups;

constexpr int DM = 1024, NB = 4, SEQ = 4096, CTX = 256, TT = SEQ + CTX, M = NB * TT;
constexpr int DFF = 2816, NAB = 4112, NABP = 4352, NQKV = 1536;
constexpr float EPS = 1e-6f;
#ifndef MK_ONE
#define MK_ONE 1
#endif
#ifndef PROBE_REP
#define PROBE_REP 0
#endif
#ifndef PROBE_VAR
#define PROBE_VAR 0
#endif
#ifndef PROBE_TS
#define PROBE_TS -1
#endif
#ifndef PROBE_SCALE
#define PROBE_SCALE 1e-5f
#endif
#ifndef SCAN_NAIVE
#define SCAN_NAIVE 0
#endif

namespace pg8 {
#define PG8_LAS __attribute__((address_space(3)))
typedef unsigned short bf16_t;
typedef short bf16x8 __attribute__((ext_vector_type(8)));
typedef float f32x4 __attribute__((ext_vector_type(4)));
typedef unsigned u32x4 __attribute__((ext_vector_type(4)));
constexpr int BM = 256, BK = 64, HALF = 128, HTB = HALF * BK * 2  , STAGE_BYTES = 8 * HTB, NXCD = 8, WGM = 8;

__host__ __device__ __forceinline__ int lds_byte(int r, int c) { const int st = (r >> 4) * 2 + (c >> 5), rr = r & 15, cc = c & 31, ob = rr * 64 + cc * 2; return st * 1024 + (ob ^ (((ob >> 9) & 1) << 5)); }
__host__ __device__ __forceinline__ void stage_rc(int b, int& R, int& C) { const int st = b / 1024, sb = b % 1024, swz = sb ^ (((sb >> 9) & 1) << 5); R = (st >> 1) * 16 + swz / 64; C = (st & 1) * 32 + (swz % 64) / 2; }
__host__ __device__ __forceinline__ int perm32(int rho) { const int n = rho >> 4, i = rho & 15; return 8 * (i >> 2) + 4 * n + (i & 3); }

struct Unit { int pm, pn; };
struct Gemm { const bf16_t* A; const bf16_t* Bt; int M, N, K; };

struct TileOrder {
    int nM, nN, nwg, G, c, skip;
    __device__ void init(int nM_, int N, int G_, int c_, int skip_) { nM = nM_; nN = N / BM; nwg = nM * nN; G = G_; c = c_; skip = skip_; }
    __device__ bool next(int i, Unit& u) const {
        const long L = (long)i * G + c; if (L >= nwg) return false;
        int wgid = (int)L; { const int q = nwg / NXCD, r = nwg % NXCD, xcd = wgid % NXCD, off = wgid / NXCD; wgid = (xcd < r ? xcd * (q + 1) : r * (q + 1) + (xcd - r) * q) + off; }
        const int nig = WGM * nN, gid = wgid / nig, fm = gid * WGM, gsz = (nM - fm) < WGM ? (nM - fm) : WGM;
        int pm = fm + ((wgid % nig) % gsz); u.pn = (wgid % nig) / gsz;
        if (skip) pm = pm + (pm >> 4) + 1;
        u.pm = pm; return true;
    }
    __device__ __forceinline__ void a_ready(const Unit&) const {}
    __device__ __forceinline__ void done(const Unit&) const {}
};

__device__ __forceinline__ unsigned cvt_pk_bf16(float lo, float hi) { unsigned r; asm volatile("v_cvt_pk_bf16_f32 %0, %1, %2" : "=v"(r) : "v"(lo), "v"(hi)); return r; }
__device__ __forceinline__ u32x4 pack8(const f32x4 a, const f32x4 b) { u32x4 w; w.x = cvt_pk_bf16(a[0], a[1]); w.y = cvt_pk_bf16(a[2], a[3]); w.z = cvt_pk_bf16(b[0], b[1]); w.w = cvt_pk_bf16(b[2], b[3]); return w; }
__device__ __forceinline__ float fsigmoid(float x) { return __builtin_amdgcn_rcpf(1.0f + __expf(-x)); }
__device__ __forceinline__ f32x4 silu4(f32x4 v) { f32x4 o; o[0] = v[0] * fsigmoid(v[0]); o[1] = v[1] * fsigmoid(v[1]); o[2] = v[2] * fsigmoid(v[2]); o[3] = v[3] * fsigmoid(v[3]); return o; }
__device__ __forceinline__ f32x4 sigm4(f32x4 v) { f32x4 o; o[0] = fsigmoid(v[0]); o[1] = fsigmoid(v[1]); o[2] = fsigmoid(v[2]); o[3] = fsigmoid(v[3]); return o; }

template <class F> struct Epi8 {
    static constexpr bool PERM = true, AFTER_DRAIN = false;
    F f;
    __device__ __forceinline__ void operator()(const f32x4 (&acc)[2][2][4][2], const Unit& u, int wr, int wc, int fr, int fq) const {
        const int col = u.pn * BM + wc * 32 + 8 * fq;
#pragma unroll
        for (int ai = 0; ai < 2; ++ai)
#pragma unroll
            for (int m = 0; m < 4; ++m) { const int row = u.pm * BM + ai * HALF + wr * 64 + m * 16 + fr;
                f.apply(row, col, acc[ai][0][m][0], acc[ai][0][m][1], acc[ai][1][m][0], acc[ai][1][m][1]); }
    }
};
struct FProj {
    bf16_t* proj; float* bg;
    __device__ __forceinline__ void one(int row, int c, f32x4 v0, f32x4 v1) const {
        if (c >= 4096) { if (c < 4112) { float* p = bg + (size_t)row * 16 + (c - 4096); *(f32x4*)p = v0; *(f32x4*)(p + 4) = v1; } return; }
        const int seg = c >> 9, cs = c & 511;
        if (seg == 2) { v0 = silu4(v0); v1 = silu4(v1); }
        if (seg == 7) { v0 = sigm4(v0); v1 = sigm4(v1); }
        *(u32x4*)(proj + (size_t)seg * ((size_t)M * 512) + (size_t)row * 512 + cs) = pack8(v0, v1);
    }
    __device__ __forceinline__ void apply(int row, int col, f32x4 a0, f32x4 a1, f32x4 b0, f32x4 b1) const { one(row, col, a0, a1); one(row, col + 128, b0, b1); }
};
struct FStore {
    bf16_t* O; int ld;
    __device__ __forceinline__ void apply(int row, int col, f32x4 a0, f32x4 a1, f32x4 b0, f32x4 b1) const {
        bf16_t* p = O + (size_t)row * ld + col; *(u32x4*)p = pack8(a0, a1); *(u32x4*)(p + 128) = pack8(b0, b1); }
};
struct FSwiglu {
    bf16_t* act;
    __device__ __forceinline__ void apply(int row, int col, f32x4 a0, f32x4 a1, f32x4 b0, f32x4 b1) const {
        const int hc = (col >> 8) * 128 + (col & 255);
        *(u32x4*)(act + (size_t)row * DFF + hc) = pack8(silu4(a0) * b0, silu4(a1) * b1); }
};
struct FQkv {
    bf16_t *q, *k, *v;
    __device__ __forceinline__ void one(int row, int c, f32x4 v0, f32x4 v1) const {
        bf16_t* p = c < 1024 ? q + (size_t)row * 1024 + c : (c < 1280 ? k + (size_t)row * 256 + (c - 1024) : v + (size_t)row * 256 + (c - 1280));
        *(u32x4*)p = pack8(v0, v1); }
    __device__ __forceinline__ void apply(int row, int col, f32x4 a0, f32x4 a1, f32x4 b0, f32x4 b1) const { one(row, col, a0, a1); one(row, col + 128, b0, b1); }
};

template <class Epi, class Sched, bool ALIGN_EPI = false, bool SP2 = false>
__device__ __forceinline__ void gemm_phase(PG8_LAS unsigned char* lds, const Gemm g, const Sched& S, const Epi& E) {
    const int tid = threadIdx.x, wid = __builtin_amdgcn_readfirstlane(tid >> 6), lane = tid & 63, wr = wid >> 2, wc = wid & 3, fr = lane & 15, fq = lane >> 4;
    const int K = g.K, nt = K / BK;
    unsigned voffA[2], voffB[2];
#pragma unroll
    for (int i = 0; i < 2; ++i) { int R, C; stage_rc(tid * 16 + i * 8192, R, C); const int Rb = Epi::PERM ? ((R & ~31) + perm32(R & 31)) : R;
        voffA[i] = (unsigned)(R * K + C) * 2u; voffB[i] = (unsigned)(Rb * K + C) * 2u; }
    const size_t kstep = (size_t)(BK * 2);
    const size_t hstep = (size_t)HALF * K * 2;
    const size_t tstep = 2 * hstep;
    const unsigned ldsw = (unsigned)wid * 1024u;
    const int aoff = lds_byte(wr * 64 + fr, fq * 8), boff = lds_byte(wc * 32 + fr, fq * 8);
#define PG8_SA(b, h) (((b) * 2 + (h)) * HTB)
#define PG8_SB(b, h) ((4 + (b) * 2 + (h)) * HTB)
#define PG8_STAGE(bufoff, gbase, voff) do { _Pragma("unroll") for (int _i = 0; _i < 2; ++_i) \
        __builtin_amdgcn_global_load_lds((const unsigned*)((const char*)(gbase) + (voff)[_i]), (PG8_LAS unsigned*)(lds + (bufoff) + ldsw + _i * 8192), 16, 0, 0); } while (0)
#define PG8_LDA(dst, b, h) do { _Pragma("unroll") for (int m = 0; m < 4; ++m) _Pragma("unroll") for (int k = 0; k < 2; ++k) dst[m][k] = *(const PG8_LAS bf16x8*)(lds + PG8_SA(b, h) + aoff + m * 2048 + k * 1024); } while (0)
#define PG8_LDB(dst, b, h) do { _Pragma("unroll") for (int n = 0; n < 2; ++n) _Pragma("unroll") for (int k = 0; k < 2; ++k) dst[n][k] = *(const PG8_LAS bf16x8*)(lds + PG8_SB(b, h) + boff + n * 2048 + k * 1024); } while (0)
#define PG8_MMA(ai, bj, At, Bt) do { __builtin_amdgcn_s_setprio(1); _Pragma("unroll") for (int m = 0; m < 4; ++m) _Pragma("unroll") for (int n = 0; n < 2; ++n) _Pragma("unroll") for (int k = 0; k < 2; ++k) \
        acc[ai][bj][m][n] = __builtin_amdgcn_mfma_f32_16x16x32_bf16(Bt[n][k], At[m][k], acc[ai][bj][m][n], 0, 0, 0); __builtin_amdgcn_s_setprio(0); } while (0)
#define PG8_WAIT_V(n) asm volatile("s_waitcnt vmcnt(" #n ")" ::: "memory")
#define PG8_WAIT_L(n) asm volatile("s_waitcnt lgkmcnt(" #n ")" ::: "memory")
#define PG8_BAR __builtin_amdgcn_s_barrier()
#define PG8_SCHED __builtin_amdgcn_sched_barrier(0)
    Unit cur, nxt; int ui = 0;
    if (!S.next(0, cur)) return;
    f32x4 acc[2][2][4][2];
#pragma unroll
    for (int a = 0; a < 2; ++a)
#pragma unroll
        for (int b = 0; b < 2; ++b)
#pragma unroll
            for (int m = 0; m < 4; ++m)
#pragma unroll
                for (int n = 0; n < 2; ++n) acc[a][b][m][n] = (f32x4){0.f, 0.f, 0.f, 0.f};
    bf16x8 At[4][2], B0[2][2], B1[2][2];
    const char* cA = (const char*)g.A + (size_t)cur.pm * tstep; const char* cB = (const char*)g.Bt + (size_t)cur.pn * tstep;
    S.a_ready(cur);
    if constexpr (SP2) {
        PG8_STAGE(PG8_SB(0, 0), cB, voffB); PG8_STAGE(PG8_SB(0, 1), cB + hstep, voffB); PG8_STAGE(PG8_SA(0, 0), cA, voffA); PG8_STAGE(PG8_SA(0, 1), cA + hstep, voffA);
        if (wr == 1) PG8_BAR;
        PG8_WAIT_V(2); PG8_BAR;
        PG8_STAGE(PG8_SB(1, 0), cB + kstep, voffB); PG8_STAGE(PG8_SA(1, 0), cA + kstep, voffA); PG8_STAGE(PG8_SB(1, 1), cB + hstep + kstep, voffB);
        PG8_WAIT_V(6); PG8_BAR;
    } else {
        PG8_STAGE(PG8_SB(0, 0), cB, voffB); PG8_STAGE(PG8_SA(0, 0), cA, voffA); PG8_STAGE(PG8_SB(0, 1), cB + hstep, voffB); PG8_STAGE(PG8_SA(0, 1), cA + hstep, voffA);
        if (wr == 1) PG8_BAR;
        PG8_WAIT_V(4); PG8_BAR;
        PG8_STAGE(PG8_SB(1, 0), cB + kstep, voffB); PG8_STAGE(PG8_SA(1, 0), cA + kstep, voffA); PG8_STAGE(PG8_SB(1, 1), cB + hstep + kstep, voffB);
        PG8_WAIT_V(6); PG8_BAR;
    }
    for (;;) {
        const bool has_next = S.next(ui + 1, nxt);
        const char* nA = has_next ? (const char*)g.A + (size_t)nxt.pm * tstep : cA; const char* nB = has_next ? (const char*)g.Bt + (size_t)nxt.pn * tstep : cB;
        for (int t = 0; t < nt; t += 2) {
            const bool last = (t == nt - 2);
            const char* a1 = cA + (size_t)(t + 1) * kstep;
            const char* a2 = last ? nA : cA + (size_t)(t + 2) * kstep; const char* b2 = last ? nB : cB + (size_t)(t + 2) * kstep;
            const char* a3 = a2 + kstep; const char* b3 = b2 + kstep;
            if (last && has_next) S.a_ready(nxt);
            if constexpr (SP2) {
            PG8_LDB(B0, 0, 0); PG8_LDB(B1, 0, 1); PG8_SCHED; PG8_LDA(At, 0, 0); PG8_STAGE(PG8_SA(1, 1), a1 + hstep, voffA);
            PG8_WAIT_V(8); PG8_WAIT_L(0); PG8_BAR; PG8_MMA(0, 0, At, B0); PG8_MMA(0, 1, At, B1); PG8_BAR; PG8_SCHED;
            PG8_LDA(At, 0, 1); PG8_STAGE(PG8_SB(0, 0), b2, voffB); PG8_STAGE(PG8_SB(0, 1), b2 + hstep, voffB); PG8_STAGE(PG8_SA(0, 0), a2, voffA);
            PG8_WAIT_V(8); PG8_WAIT_L(0); PG8_BAR; PG8_MMA(1, 0, At, B0); PG8_MMA(1, 1, At, B1); PG8_BAR; PG8_SCHED;
            PG8_LDB(B0, 1, 0); PG8_LDB(B1, 1, 1); PG8_SCHED; PG8_LDA(At, 1, 0); PG8_STAGE(PG8_SA(0, 1), a2 + hstep, voffA);
            PG8_WAIT_V(8); PG8_WAIT_L(0); PG8_BAR; PG8_MMA(0, 0, At, B0); PG8_MMA(0, 1, At, B1); PG8_BAR; PG8_SCHED;
            PG8_LDA(At, 1, 1); PG8_STAGE(PG8_SB(1, 0), b3, voffB); PG8_STAGE(PG8_SB(1, 1), b3 + hstep, voffB); PG8_STAGE(PG8_SA(1, 0), a3, voffA);
            PG8_WAIT_V(8); PG8_WAIT_L(0); PG8_BAR; PG8_MMA(1, 0, At, B0); PG8_MMA(1, 1, At, B1); PG8_BAR; PG8_SCHED;
            } else {
            PG8_LDB(B0, 0, 0); PG8_SCHED; PG8_LDA(At, 0, 0); PG8_STAGE(PG8_SA(1, 1), a1 + hstep, voffA);
            PG8_WAIT_L(8); PG8_BAR; PG8_WAIT_L(0); PG8_MMA(0, 0, At, B0); PG8_BAR; PG8_SCHED;
            PG8_LDB(B1, 0, 1); PG8_STAGE(PG8_SB(0, 0), b2, voffB);
            PG8_BAR; PG8_WAIT_L(0); PG8_MMA(0, 1, At, B1); PG8_BAR;
            PG8_LDA(At, 0, 1); PG8_STAGE(PG8_SA(0, 0), a2, voffA);
            PG8_BAR; PG8_WAIT_L(0); PG8_MMA(1, 0, At, B0); PG8_BAR; PG8_SCHED;
            PG8_STAGE(PG8_SB(0, 1), b2 + hstep, voffB);
            PG8_WAIT_V(6); PG8_BAR; PG8_MMA(1, 1, At, B1); PG8_BAR;
            PG8_LDB(B0, 1, 0); PG8_SCHED; PG8_LDA(At, 1, 0); PG8_STAGE(PG8_SA(0, 1), a2 + hstep, voffA);
            PG8_WAIT_L(8); PG8_BAR; PG8_WAIT_L(0); PG8_MMA(0, 0, At, B0); PG8_BAR; PG8_SCHED;
            PG8_LDB(B1, 1, 1); PG8_STAGE(PG8_SB(1, 0), b3, voffB);
            PG8_BAR; PG8_WAIT_L(0); PG8_MMA(0, 1, At, B1); PG8_BAR;
            PG8_LDA(At, 1, 1); PG8_STAGE(PG8_SA(1, 0), a3, voffA);
            PG8_BAR; PG8_WAIT_L(0); PG8_MMA(1, 0, At, B0); PG8_BAR; PG8_SCHED;
            PG8_STAGE(PG8_SB(1, 1), b3 + hstep, voffB);
            PG8_WAIT_V(6); PG8_BAR; PG8_MMA(1, 1, At, B1); PG8_BAR;
            }
        }
        if constexpr (ALIGN_EPI) { if (wr == 0) PG8_BAR; }
        if constexpr (!Epi::AFTER_DRAIN) { E(acc, cur, wr, wc, fr, fq); S.done(cur); }
        if (!has_next) break;
#pragma unroll
        for (int a = 0; a < 2; ++a)
#pragma unroll
            for (int b = 0; b < 2; ++b)
#pragma unroll
                for (int m = 0; m < 4; ++m)
#pragma unroll
                    for (int n = 0; n < 2; ++n) acc[a][b][m][n] = (f32x4){0.f, 0.f, 0.f, 0.f};
        cur = nxt; cA = nA; cB = nB; ++ui;
        if constexpr (ALIGN_EPI) { if (wr == 1) PG8_BAR; }
    }
    PG8_WAIT_V(0);
    if constexpr (!ALIGN_EPI) { if (wr == 0) PG8_BAR; }
    PG8_BAR;
    if constexpr (Epi::AFTER_DRAIN) { E.fused(acc, cur, wr, wc, fr, fq, lds, wid, lane); S.done(cur); }
#undef PG8_SA
#undef PG8_SB
#undef PG8_STAGE
#undef PG8_LDA
#undef PG8_LDB
#undef PG8_MMA
#undef PG8_WAIT_V
#undef PG8_WAIT_L
#undef PG8_BAR
#undef PG8_SCHED
}
}

namespace attn {
typedef unsigned short bf16;
using bf16x8 = __attribute__((ext_vector_type(8))) short;
using s16x4  = __attribute__((ext_vector_type(4))) short;
using f32x16 = __attribute__((ext_vector_type(16))) float;
using u32x4  = __attribute__((ext_vector_type(4))) unsigned;
constexpr int D = 128, NW = 8, QBLK = 32, KVBLK = 64;
constexpr float SCALE = 0.088388347648318440f;
constexpr float THR = 8.f;
constexpr int LDQ = 1024, LDK = 256, LDO = 1024;
constexpr size_t SHM_V = KVBLK * D * 2, SHM_K = KVBLK * D * 2, SHM_ATTN = 2 * SHM_V + 2 * SHM_K + NW * 64 * 4;
#define KSWZ(row, colB) ((row) * 256 + ((colB) ^ (((row) & 7) << 4)))
#define SBAR() __builtin_amdgcn_sched_barrier(0)
__device__ __forceinline__ int crow(int r, int hi) { return (r & 3) + 8 * (r >> 2) + 4 * hi; }
__device__ __forceinline__ unsigned cvtpk(float lo, float hi) { unsigned r; asm volatile("v_cvt_pk_bf16_f32 %0, %1, %2" : "=v"(r) : "v"(lo), "v"(hi)); return r; }
__device__ __forceinline__ bf16x8 ld8(const bf16* p) { return *reinterpret_cast<const bf16x8*>(p); }

__device__ __forceinline__ void partialSM(f32x16& p0, f32x16& p1, float& m_reg, float& mn, float& alpha) {
  constexpr float C = SCALE * 1.4426950408889634f;
  float pmax = p0[0]; for (int r = 1; r < 16; ++r) pmax = fmaxf(pmax, p0[r]); for (int r = 0; r < 16; ++r) pmax = fmaxf(pmax, p1[r]);
  { auto rr = __builtin_amdgcn_permlane32_swap(__float_as_uint(pmax), __float_as_uint(pmax), false, false);
    pmax = fmaxf(__uint_as_float(rr[0]), __uint_as_float(rr[1])); }
  if (__builtin_expect(__all(pmax - m_reg <= THR / SCALE), 1)) { mn = m_reg; alpha = 1.f; }
  else { mn = fmaxf(m_reg, pmax); alpha = __builtin_amdgcn_exp2f((m_reg - mn) * C); m_reg = mn; }
  float mnC = -mn * C;
  for (int r = 0; r < 16; ++r) p0[r] = fmaf(p0[r], C, mnC); for (int r = 0; r < 16; ++r) p1[r] = fmaf(p1[r], C, mnC);
  for (int r = 0; r < 16; ++r) p0[r] = __builtin_amdgcn_exp2f(p0[r]);
}
__device__ __forceinline__ void finishSM(f32x16& p0, f32x16& p1, float alpha, float& l_reg, bf16x8& pa0, bf16x8& pa1, bf16x8& pa2, bf16x8& pa3) {
  for (int r = 0; r < 16; ++r) p1[r] = __builtin_amdgcn_exp2f(p1[r]);
  float ps = 0; for (int r = 0; r < 16; ++r) ps += p0[r]; for (int r = 0; r < 16; ++r) ps += p1[r];
  { auto rr = __builtin_amdgcn_permlane32_swap(__float_as_uint(ps), __float_as_uint(ps), false, false);
    ps = __uint_as_float(rr[0]) + __uint_as_float(rr[1]); }
  l_reg = l_reg * alpha + ps;
#define PK4(P, BASE, OUT) do { unsigned a0 = cvtpk(P[BASE + 0], P[BASE + 1]), a1 = cvtpk(P[BASE + 2], P[BASE + 3]);   \
    unsigned b0 = cvtpk(P[BASE + 4], P[BASE + 5]), b1 = cvtpk(P[BASE + 6], P[BASE + 7]);                              \
    auto r0 = __builtin_amdgcn_permlane32_swap(a0, b0, false, false); auto r1 = __builtin_amdgcn_permlane32_swap(a1, b1, false, false); \
    u32x4 w = {r0[0], r1[0], r0[1], r1[1]}; OUT = *reinterpret_cast<bf16x8*>(&w); } while (0)
  PK4(p0, 0, pa0); PK4(p0, 8, pa1); PK4(p1, 0, pa2); PK4(p1, 8, pa3);
#undef PK4
}
__device__ __forceinline__ void qkt(f32x16& p0, f32x16& p1, const bf16* Ks, const bf16x8* qr, int r32, int hi) {
  p0 = f32x16{}; p1 = f32x16{};
  for (int d0 = 0; d0 < 8; ++d0) { int cb = (d0 * 16 + hi * 8) * 2;
    bf16x8 b0 = *reinterpret_cast<const bf16x8*>((const char*)Ks + KSWZ(r32, cb));
    bf16x8 b1 = *reinterpret_cast<const bf16x8*>((const char*)Ks + KSWZ(32 + r32, cb));
    p0 = __builtin_amdgcn_mfma_f32_32x32x16_bf16(b0, qr[d0], p0, 0, 0, 0);
    p1 = __builtin_amdgcn_mfma_f32_32x32x16_bf16(b1, qr[d0], p1, 0, 0, 0); }
}
__device__ __forceinline__ int v_st(int k, int c) { const int kk = (k & ~0xC) | ((k & 4) << 1) | ((k & 8) >> 1); return ((kk >> 3) * 4 + (c >> 5)) * 512 + ((kk & 7) * 32 + (c & 31)) * 2; }
__device__ __forceinline__ int v_rd_base(int lane) { return ((lane & 3) << 3) | (((lane >> 2) & 3) << 6) | (((lane >> 4) & 1) << 5) | (((lane >> 5) & 1) << 8); }
constexpr int v_rd_off(int d0, int ks, int half) { return d0 * 512 + ks * 4096 + half * 2048; }
template <int OFF> __device__ __forceinline__ s16x4 tr_read(int vb) {
  s16x4 r; asm volatile("ds_read_b64_tr_b16 %0, %1 offset:%2" : "=&v"(r) : "v"(vb), "i"(OFF) : "memory"); return r;
}
template <int D0> __device__ __forceinline__ void pv_one(f32x16& od, int vb, bf16x8 pa0, bf16x8 pa1, bf16x8 pa2, bf16x8 pa3) {
  const s16x4 l0 = tr_read<v_rd_off(D0, 0, 0)>(vb), h0 = tr_read<v_rd_off(D0, 0, 1)>(vb), l1 = tr_read<v_rd_off(D0, 1, 0)>(vb), h1 = tr_read<v_rd_off(D0, 1, 1)>(vb);
  const s16x4 l2 = tr_read<v_rd_off(D0, 2, 0)>(vb), h2 = tr_read<v_rd_off(D0, 2, 1)>(vb), l3 = tr_read<v_rd_off(D0, 3, 0)>(vb), h3 = tr_read<v_rd_off(D0, 3, 1)>(vb);
  asm volatile("s_waitcnt lgkmcnt(0)" ::: "memory"); SBAR();
#define PK(L, H) (bf16x8){L[0], L[1], L[2], L[3], H[0], H[1], H[2], H[3]}
  od = __builtin_amdgcn_mfma_f32_32x32x16_bf16(pa0, PK(l0, h0), od, 0, 0, 0);
  od = __builtin_amdgcn_mfma_f32_32x32x16_bf16(pa1, PK(l1, h1), od, 0, 0, 0);
  od = __builtin_amdgcn_mfma_f32_32x32x16_bf16(pa2, PK(l2, h2), od, 0, 0, 0);
  od = __builtin_amdgcn_mfma_f32_32x32x16_bf16(pa3, PK(l3, h3), od, 0, 0, 0);
#undef PK
}
__device__ __forceinline__ void pv_d0(f32x16* o, int vb, bf16x8 pa0, bf16x8 pa1, bf16x8 pa2, bf16x8 pa3) {
  pv_one<0>(o[0], vb, pa0, pa1, pa2, pa3); pv_one<1>(o[1], vb, pa0, pa1, pa2, pa3); pv_one<2>(o[2], vb, pa0, pa1, pa2, pa3); pv_one<3>(o[3], vb, pa0, pa1, pa2, pa3);
}
__device__ __forceinline__ void q_norm_rope(bf16* __restrict__ Qb, const float* __restrict__ qg, int tpos0) {
  int tid = threadIdx.x; asm volatile("" : "+v"(tid));
  const int wid = tid >> 6, lane = tid & 63, sub = lane & 15, rq = lane >> 4;
  const int c0 = 8 * sub;
  float g[8];
#pragma unroll
  for (int j = 0; j < 8; ++j) g[j] = qg[c0 + j];
  float invf[8];
#pragma unroll
  for (int j = 0; j < 8; ++j) invf[j] = exp2f(-(float)(2 * ((c0 & 31) + j)) * (13.287712379549449f / 64.f));
  const bool second = (sub & 4) != 0;
#pragma unroll 2
  for (int s = 0; s < 8; ++s) {
    const int row = wid * 32 + s * 4 + rq;
    bf16* p = Qb + (long)row * LDQ + c0;
    const u32x4 w = *reinterpret_cast<const u32x4*>(p);
    float x[8]; float ss = 0.f;
#pragma unroll
    for (int i = 0; i < 4; ++i) { x[2 * i] = __uint_as_float(w[i] << 16); x[2 * i + 1] = __uint_as_float(w[i] & 0xffff0000u); ss += x[2 * i] * x[2 * i] + x[2 * i + 1] * x[2 * i + 1]; }
    ss += __shfl_xor(ss, 1); ss += __shfl_xor(ss, 2); ss += __shfl_xor(ss, 4); ss += __shfl_xor(ss, 8);
    const float rstd = rsqrtf(ss * (1.f / 128.f) + 1e-6f);
    const int tp = tpos0 + row; const float pos = (sub & 8) ? (float)(tp & 63) : (float)(tp >> 6);
    unsigned o[4];
    float y[8];
#pragma unroll
    for (int j = 0; j < 8; ++j) { const float v = x[j] * rstd * g[j]; const float pv = __shfl_xor(v, 4); const float ang = pos * invf[j]; const float sn = __sinf(ang), cs = __cosf(ang);
      y[j] = second ? v * cs + pv * sn : v * cs - pv * sn; }
#pragma unroll
    for (int i = 0; i < 4; ++i) o[i] = cvtpk(y[2 * i], y[2 * i + 1]);
    *reinterpret_cast<u32x4*>(p) = (u32x4){o[0], o[1], o[2], o[3]};
  }
}
__device__ __forceinline__ void attn_dense_body(const bf16* __restrict__ Qb, const bf16* __restrict__ Kh, const bf16* __restrict__ Vh,
                                                bf16* __restrict__ Ob, int seq, char* lds) {
  constexpr int SDEPTH = 2;
  const int tid = threadIdx.x, wid = tid >> 6, lane = tid & 63, r32 = lane & 31, hi = lane >> 5;
  bf16* V_lds = (bf16*)lds; bf16* K_lds = (bf16*)(lds + 2 * SHM_V);
  float* ws = (float*)(lds + 2 * SHM_V + 2 * SHM_K) + wid * 64; float* li_l = ws; float* al_l = ws + 32;
  float m_reg = -1e30f, l_reg = 0; f32x16 o[4] = {}; bf16x8 qr[8];
  const bf16* Qw = Qb + (long)(wid * QBLK + r32) * LDQ + hi * 8;
#pragma unroll
  for (int d0 = 0; d0 < 8; ++d0) qr[d0] = ld8(Qw + d0 * 16);
  const int sr = tid >> 4, sc = (tid & 15) * 8, vst0 = v_st(sr, sc), vst1 = v_st(32 + sr, sc);
  const int vb0 = (int)(uintptr_t)V_lds + v_rd_base(lane);
  struct { bf16x8 vs0, vs1, ks0, ks1; } sr_[SDEPTH];
#define SLOAD(i, k0) do { sr_[i].vs0 = ld8(&Vh[(long)((k0) + sr) * LDK + sc]); sr_[i].vs1 = ld8(&Vh[(long)((k0) + 32 + sr) * LDK + sc]); \
    sr_[i].ks0 = ld8(&Kh[(long)((k0) + sr) * LDK + sc]); sr_[i].ks1 = ld8(&Kh[(long)((k0) + 32 + sr) * LDK + sc]); } while (0)
#define SWRITE(b, i) do { *(bf16x8*)((char*)V_lds + (b) * SHM_V + vst0) = sr_[i].vs0;          \
    *(bf16x8*)((char*)V_lds + (b) * SHM_V + vst1) = sr_[i].vs1; int kc = sc * 2;               \
    *(bf16x8*)((char*)K_lds + (b) * SHM_K + KSWZ(sr, kc)) = sr_[i].ks0;                       \
    *(bf16x8*)((char*)K_lds + (b) * SHM_K + KSWZ(32 + sr, kc)) = sr_[i].ks1; } while (0)
#define SWAIT() do { asm volatile("s_waitcnt vmcnt(4)" ::: "memory"); } while (0)
#define RESC(a) do { if (__any((a) < 1.f)) { if (hi == 0) al_l[r32] = (a); asm volatile("s_waitcnt lgkmcnt(0)" ::: "memory"); \
    for (int d = 0; d < 4; ++d) for (int r = 0; r < 16; ++r) o[d][r] *= al_l[crow(r, hi)]; } } while (0)
  f32x16 pA0, pA1, pB0, pB1; float mnA, mnB, alA, alB; bf16x8 pa0, pa1, pa2, pa3; const int NT = seq / KVBLK;
  constexpr int SE = 0, SO = SDEPTH - 1;
  SLOAD(SE, 0); asm volatile("s_waitcnt vmcnt(0)" ::: "memory"); SWRITE(0, SE); __syncthreads();
  qkt(pA0, pA1, K_lds, qr, r32, hi); partialSM(pA0, pA1, m_reg, mnA, alA);
  SLOAD(SO, KVBLK); if (2 < NT) SLOAD(SE, 2 * KVBLK);
  SWAIT(); SWRITE(1, SO); __syncthreads();
  for (int j = 1; j + 1 < NT; j += 2) {
    SBAR(); qkt(pB0, pB1, (bf16*)((char*)K_lds + SHM_K), qr, r32, hi);
    finishSM(pA0, pA1, alA, l_reg, pa0, pa1, pa2, pa3); SBAR();
    SLOAD(SO, (j + SDEPTH) * KVBLK); SBAR();
    pv_d0(o, vb0, pa0, pa1, pa2, pa3); partialSM(pB0, pB1, m_reg, mnB, alB);
    __syncthreads(); SWAIT(); SWRITE(0, SE);
    RESC(alB); __syncthreads();
    SBAR(); qkt(pA0, pA1, K_lds, qr, r32, hi);
    finishSM(pB0, pB1, alB, l_reg, pa0, pa1, pa2, pa3); SBAR();
    if (j + 3 < NT) SLOAD(SE, (j + 1 + SDEPTH) * KVBLK); SBAR();
    pv_d0(o, vb0 + (int)SHM_V, pa0, pa1, pa2, pa3); partialSM(pA0, pA1, m_reg, mnA, alA);
    __syncthreads(); SWAIT(); SWRITE(1, SO);
    RESC(alA); __syncthreads();
  }
  SBAR(); qkt(pB0, pB1, (bf16*)((char*)K_lds + SHM_K), qr, r32, hi);
  finishSM(pA0, pA1, alA, l_reg, pa0, pa1, pa2, pa3); SBAR();
  pv_d0(o, vb0, pa0, pa1, pa2, pa3); partialSM(pB0, pB1, m_reg, mnB, alB);
  __syncthreads(); RESC(alB);
  finishSM(pB0, pB1, alB, l_reg, pa0, pa1, pa2, pa3); SBAR();
  pv_d0(o, vb0 + (int)SHM_V, pa0, pa1, pa2, pa3);
  if (hi == 0) li_l[r32] = l_reg; asm volatile("s_waitcnt lgkmcnt(0)" ::: "memory");
  float rli[16];
#pragma unroll
  for (int r = 0; r < 16; ++r) rli[r] = __builtin_amdgcn_rcpf(li_l[crow(r, hi)]);
  bf16* Ow = Ob + (long)(wid * QBLK) * LDO;
#pragma unroll
  for (int r = 0; r < 16; ++r) { int orow = crow(r, hi);
    for (int d0 = 0; d0 < 4; ++d0) { const float v = o[d0][r] * rli[r]; const unsigned u = __float_as_uint(v);
      Ow[(long)orow * LDO + d0 * 32 + r32] = (bf16)((u + 0x7fffu + ((u >> 16) & 1u)) >> 16); } }
#undef SLOAD
#undef SWRITE
#undef SWAIT
#undef RESC
}
#undef KSWZ
#undef SBAR
}

#define LAS __attribute__((address_space(3)))
typedef unsigned short bf16;
typedef unsigned v4u __attribute__((ext_vector_type(4)));
typedef unsigned v2u __attribute__((ext_vector_type(2)));
typedef float f32x4 __attribute__((ext_vector_type(4)));
typedef float f32x2 __attribute__((ext_vector_type(2)));

constexpr size_t HM = 1u << 19;
constexpr size_t WS_MOD = 2 * HM;
constexpr size_t WS_WAB = 4 * HM, WS_WABO = 21 * HM, WS_WFI0 = 25 * HM, WS_WFI1 = 47 * HM, WS_WFO0 = 69 * HM, WS_WFO1 = 80 * HM, WS_WQKV = 91 * HM, WS_WAO = 97 * HM;
constexpr size_t WS_XCTX = 102 * HM;
constexpr size_t WS_H = 110 * HM;
constexpr size_t WS_PROJ = 178 * HM;
constexpr size_t SEG = (size_t)M * 512;
constexpr size_t WS_ACT = 178 * HM;
constexpr size_t WS_Q = 178 * HM, WS_K = 246 * HM, WS_V = 263 * HM;
constexpr size_t WS_OG = 280 * HM;
constexpr size_t WS_Y = 382 * HM;
constexpr size_t WS_BG = 450 * HM;
constexpr size_t WS_SXH = 456 * HM, WS_SXM = 469 * HM, WS_GXH = 476 * HM, WS_NXM = 477 * HM, WS_MXM = 478 * HM;
constexpr size_t WS_TS = 479 * HM;
constexpr size_t WS_END = 512 * HM;
static_assert(WS_BG + (size_t)M * 16 * 4 <= WS_END && WS_Y + (size_t)M * DM * 2 <= WS_BG && WS_PROJ + 8 * SEG * 2 == WS_BG, "ws map");
static_assert(WS_ACT + (size_t)M * DFF * 2 <= WS_Y && WS_V + (size_t)M * 256 * 2 <= WS_OG && WS_OG + (size_t)M * DM * 2 <= WS_Y, "ws map 2");

constexpr int LDS_BYTES = 147456;

__device__ __forceinline__ unsigned f2bf(float f) { unsigned u = __builtin_bit_cast(unsigned, f); return (u + 0x7fffu + ((u >> 16) & 1u)) >> 16; }
__device__ __forceinline__ unsigned pk2(float lo, float hi) { return f2bf(lo) | (f2bf(hi) << 16); }
__device__ __forceinline__ float bf2f(unsigned short h) { return __builtin_bit_cast(float, (unsigned)h << 16); }
__device__ __forceinline__ float bflo(unsigned w) { return __builtin_bit_cast(float, w << 16); }
__device__ __forceinline__ float bfhi(unsigned w) { return __builtin_bit_cast(float, w & 0xffff0000u); }
__device__ __forceinline__ float wave_sum(float v) {
#pragma unroll
    for (int o = 1; o < 64; o <<= 1) v += __shfl_xor(v, o);
    return v;
}
__device__ __forceinline__ float sigmoidf_(float x) { return 1.0f / (1.0f + __expf(-x)); }

typedef __attribute__((address_space(1))) unsigned gu32;
#define RLX_AGENT __ATOMIC_RELAXED, __HIP_MEMORY_SCOPE_AGENT
constexpr int MISC_OFF = 131072 + 320;
constexpr size_t WS_CTL = 0, CTL_ZERO_BYTES = 65536;
constexpr int CW_BAR = 1024;
#define XB_TMO      128
#define XB_XCNT(j)  (256  + 64 * (j))
#define XB_XSUB(j)  (1280 + 64 * (j))
#define XB_XGEN(j)  (2304 + 64 * (j))
#define XB_TOP      3328
#define XB_TOPGEN   3392
#define XCD_BAR_WORDS 3456
#define XB_SPIN_CAP (1u << 18)

__device__ __forceinline__ unsigned xb_ld(unsigned* p)              { return __hip_atomic_load(p, __ATOMIC_RELAXED, __HIP_MEMORY_SCOPE_AGENT); }
__device__ __forceinline__ unsigned xb_add(unsigned* p, unsigned v) { return __hip_atomic_fetch_add(p, v, __ATOMIC_RELAXED, __HIP_MEMORY_SCOPE_AGENT); }
__device__ __forceinline__ unsigned xb_xcc_id() { return (unsigned)__builtin_amdgcn_s_getreg((3 << 11) | 20) & 0xFu; }
#define XB_SPIN(cond, bar) do { unsigned _sp = 0; while (cond) { __builtin_amdgcn_s_sleep(1); \
    if ((++_sp & 255u) == 0u) { if (xb_ld(&(bar)[XB_TMO])) break; if (_sp > XB_SPIN_CAP) { atomicAdd(&(bar)[XB_TMO], 1u); break; } } } } while (0)

struct XcdBarrier {
    unsigned* bar; unsigned x;
    volatile LAS unsigned* st;
};

__device__ __forceinline__ XcdBarrier xcd_barrier_post(unsigned* bar, volatile LAS unsigned* st) {
    XcdBarrier b; b.bar = bar; b.x = xb_xcc_id(); b.st = st;
    if (threadIdx.x == 0) (void)xb_add(&bar[XB_XCNT(b.x)], 1u);
    return b;
}
__device__ __forceinline__ void xcd_barrier_complete(unsigned* bar, unsigned x, unsigned& nloc, unsigned& nx) {
    const unsigned G = gridDim.x * gridDim.y * gridDim.z;
    unsigned sum, cnt, mine, sp = 0u;
    for (;;) {
        sum = 0u; cnt = 0u; mine = 0u;
#pragma unroll
        for (unsigned j = 0; j < 16; ++j) { const unsigned c = xb_ld(&bar[XB_XCNT(j)]); sum += c; cnt += (c > 0u) ? 1u : 0u; mine = (j == x) ? c : mine; }
        if (sum == G) break;
        __builtin_amdgcn_s_sleep(1);
        if ((++sp & 255u) == 0u) { if (xb_ld(&bar[XB_TMO])) break; if (sp > XB_SPIN_CAP) { atomicAdd(&bar[XB_TMO], 1u); break; } }
    }
    nloc = mine > 0u ? mine : 1u; nx = cnt > 0u ? cnt : 1u;
}

__device__ __forceinline__ void xcd_barrier(const XcdBarrier& b) {
    asm volatile("s_waitcnt vmcnt(0)" ::: "memory");
    __syncthreads();
    if (threadIdx.x == 0) {
        unsigned* bar = b.bar;
        __builtin_amdgcn_s_waitcnt(0);
        unsigned nloc = b.st[0], nx = b.st[1];
        if (nloc == 0u) { xcd_barrier_complete(bar, b.x, nloc, nx); b.st[0] = nloc; b.st[1] = nx; }
        const unsigned old = xb_add(&bar[XB_XSUB(b.x)], 1u);
        const unsigned gen = old / nloc;
        if (old + 1u == (gen + 1u) * nloc) {
            __builtin_amdgcn_fence(__ATOMIC_RELEASE, "agent");
            asm volatile("s_waitcnt vmcnt(0)" ::: "memory");
            const unsigned og = xb_add(&bar[XB_TOP], 1u);
            const unsigned tg = og / nx;
            if (og + 1u == (tg + 1u) * nx) xb_add(&bar[XB_TOPGEN], 1u);
            else XB_SPIN(xb_ld(&bar[XB_TOPGEN]) == tg, bar);
            __builtin_amdgcn_fence(__ATOMIC_ACQUIRE, "agent");
            xb_add(&bar[XB_XGEN(b.x)], 1u);
            asm volatile("s_waitcnt vmcnt(0)" ::: "memory");
        } else {
            XB_SPIN(xb_ld(&bar[XB_XGEN(b.x)]) == gen, bar);
            __builtin_amdgcn_fence(__ATOMIC_ACQUIRE, "agent");
            asm volatile("s_waitcnt vmcnt(0)" ::: "memory");
        }
    }
    __syncthreads();
}

struct Args { const float* in[18]; float* out; unsigned char* ws; int ph_lo, ph_hi, variant, pad; };
struct Frame {
    LAS unsigned char* lds;
    int tid, lane, wave, G;
    float* out; unsigned char* ws;
    __device__ __forceinline__ const float* in(int i) const { return ((const __attribute__((address_space(4))) Args*)__builtin_amdgcn_kernarg_segment_ptr())->in[i]; }
#define FPTR(name, T, off) __device__ __forceinline__ T* name() const { return (T*)(ws + (off)); }
    FPTR(MOD, float, WS_MOD) FPTR(XCTX, float, WS_XCTX) FPTR(H, bf16, WS_H) FPTR(PROJ, bf16, WS_PROJ) FPTR(BG, float, WS_BG) FPTR(OG, bf16, WS_OG) FPTR(Y, bf16, WS_Y) FPTR(ACT, bf16, WS_ACT)
    FPTR(Q, bf16, WS_Q) FPTR(K, bf16, WS_K) FPTR(V, bf16, WS_V)
    FPTR(WAB, bf16, WS_WAB) FPTR(WABO, bf16, WS_WABO) FPTR(WFI0, bf16, WS_WFI0) FPTR(WFI1, bf16, WS_WFI1) FPTR(WFO0, bf16, WS_WFO0) FPTR(WFO1, bf16, WS_WFO1) FPTR(WQKV, bf16, WS_WQKV) FPTR(WAO, bf16, WS_WAO)
#undef FPTR
};
enum { I_X = 0, I_C, I_CTX, I_CCTX, I_ADAW, I_ADAB, I_NORMG, I_FWIN, I_FWOUT, I_ABWIN, I_CONV, I_GATEB, I_LB, I_OUTG, I_ABWOUT, I_WQKV, I_QKG, I_AWOUT };

__device__ __forceinline__ int drow_of(int mode, int n0) { if (mode == 0) return n0; const int j = n0 < DFF ? n0 : n0 - DFF; return (j >> 7) * 256 + (n0 < DFF ? 0 : 128) + (j & 127); }
__device__ __forceinline__ void p0_transpose_item(const float* W, int K, int N, bf16* WT, int mode, LAS float* scr, int item, int lane) {
    const int nblk = (N + 31) / 32, kb = item / nblk, nb = item % nblk, k0 = 64 * kb, n0 = 32 * nb;
    const int n = n0 + (lane & 31); const bool ok = n < N;
    float tv[32];
#pragma unroll
    for (int i = 0; i < 32; ++i) { const int kk = 2 * i + (lane >> 5); tv[i] = ok ? W[(size_t)(k0 + kk) * N + n] : 0.f; }
#pragma unroll
    for (int i = 0; i < 32; ++i) { const int kk = 2 * i + (lane >> 5); scr[kk * 33 + (lane & 31)] = tv[i]; }
    asm volatile("s_waitcnt lgkmcnt(0)" ::: "memory");
    const int c = lane & 7; const int dr = drow_of(mode, n0);
#pragma unroll
    for (int j = 0; j < 4; ++j) { const int nn = (lane >> 3) + 8 * j; const LAS float* s = scr + (8 * c) * 33 + nn;
        v4u o; o.x = pk2(s[0 * 33], s[1 * 33]); o.y = pk2(s[2 * 33], s[3 * 33]); o.z = pk2(s[4 * 33], s[5 * 33]); o.w = pk2(s[6 * 33], s[7 * 33]);
        *(v4u*)(WT + (size_t)(dr + nn) * K + k0 + 8 * c) = o; }
    asm volatile("s_waitcnt lgkmcnt(0)" ::: "memory");
}
__device__ __forceinline__ void p0_prologue(Frame& F) {
    const int tid = F.tid, lane = F.lane, w = F.wave;
    if (blockIdx.x < 96) {
        LAS float* sc = (LAS float*)F.lds; LAS float* part = sc + 5120;
        for (int i = tid; i < 5120; i += 512) { const int j = i >> 10, k = i & 1023; const float v = j < 4 ? F.in(I_C)[j * 1024 + k] : F.in(I_CCTX)[k]; sc[i] = v * sigmoidf_(v); }
        __syncthreads();
        const int l = blockIdx.x / 48, col0 = (blockIdx.x % 48) * 128;
        const float* wp = F.in(I_ADAW) + ((size_t)l * 1024 + 128 * w) * 6144 + col0 + 2 * lane;
        float acc[5][2];
#pragma unroll
        for (int j = 0; j < 5; ++j) { acc[j][0] = 0.f; acc[j][1] = 0.f; }
        for (int k0 = 0; k0 < 128; k0 += 32) { f32x2 wv[32];
#pragma unroll
            for (int kk = 0; kk < 32; ++kk) wv[kk] = *(const f32x2*)(wp + (size_t)(k0 + kk) * 6144);
#pragma unroll
            for (int kk = 0; kk < 32; ++kk) {
#pragma unroll
                for (int j = 0; j < 5; ++j) { const float s = sc[j * 1024 + 128 * w + k0 + kk]; acc[j][0] += s * wv[kk].x; acc[j][1] += s * wv[kk].y; } } }
#pragma unroll
        for (int j = 0; j < 5; ++j) { part[(w * 5 + j) * 128 + 2 * lane] = acc[j][0]; part[(w * 5 + j) * 128 + 2 * lane + 1] = acc[j][1]; }
        __syncthreads();
        for (int i = tid; i < 640; i += 512) { const int j = i >> 7, cc = i & 127; float s = 0.f;
#pragma unroll
            for (int ww = 0; ww < 8; ++ww) s += part[(ww * 5 + j) * 128 + cc];
            F.MOD()[(size_t)(l * 5 + j) * 6144 + col0 + cc] = s + F.in(I_ADAB)[l * 6144 + col0 + cc]; }
        __syncthreads();
    }
    LAS float* scr = (LAS float*)(F.lds + w * 16384);
    const int gw = blockIdx.x * 8 + w, NGW = F.G * 8;
    constexpr int I_AB = 16 * 129, I_ABO = 16 * 32;
    for (int it = gw; it < I_AB + I_ABO; it += NGW) {
        if (it < I_AB) p0_transpose_item(F.in(I_ABWIN), 1024, NAB, F.WAB(), 0, scr, it, lane);
        else p0_transpose_item(F.in(I_ABWOUT), 1024, 1024, F.WABO(), 0, scr, it - I_AB, lane);
    }
    { const int gt = blockIdx.x * 512 + tid, NT_ = F.G * 512; const int n16 = (NABP - 4128) * 1024 * 2 / 16; v4u z = {0u, 0u, 0u, 0u};
      for (int i = gt; i < n16; i += NT_) *((v4u*)(F.WAB() + (size_t)4128 * 1024) + i) = z; }
}

__device__ __forceinline__ void p0_deferred(Frame& F, int widx, int nw) {
    const int lane = F.lane, w = F.wave;
    LAS float* scr = (LAS float*)(F.lds + w * 16384);
    const int gw = widx * 8 + w, NGW = nw * 8;
    constexpr int I_FI = 16 * 176, I_FO = 44 * 32, I_QK = 16 * 48, I_AO = 16 * 32;
    constexpr int NITEMS = 2 * I_FI + 2 * I_FO + I_QK + I_AO;
    for (int it = gw; it < NITEMS; it += NGW) {
        int r = it;
        if (r < I_FI) { p0_transpose_item(F.in(I_FWIN), 1024, 2 * DFF, F.WFI0(), 1, scr, r, lane); continue; } r -= I_FI;
        if (r < I_FO) { p0_transpose_item(F.in(I_FWOUT), DFF, 1024, F.WFO0(), 0, scr, r, lane); continue; } r -= I_FO;
        if (r < I_QK) { p0_transpose_item(F.in(I_WQKV), 1024, NQKV, F.WQKV(), 0, scr, r, lane); continue; } r -= I_QK;
        if (r < I_AO) { p0_transpose_item(F.in(I_AWOUT), 1024, 1024, F.WAO(), 0, scr, r, lane); continue; } r -= I_AO;
        if (r < I_FI) { p0_transpose_item(F.in(I_FWIN) + (size_t)1024 * 2 * DFF, 1024, 2 * DFF, F.WFI1(), 1, scr, r, lane); continue; } r -= I_FI;
        p0_transpose_item(F.in(I_FWOUT) + (size_t)DFF * 1024, DFF, 1024, F.WFO1(), 0, scr, r, lane);
    }
}

constexpr int RB = 4;
template <bool HAS_Y, bool WRITE_X, bool HAS_NEXT, bool LAT_ONLY>
__device__ __forceinline__ void rowpass(const Frame& F, const float* xs_lat, const float* xs_ctx, float* xd_lat, float* xd_ctx,
                                        const float* mod_y, int gate_off, const float* gn_y, const float* mod_n, int sh_off, int sc_off, const float* gn_n) {
    const int lane = F.lane, gw = blockIdx.x * 8 + F.wave, NGW = F.G * 8;
    constexpr int NR = LAT_ONLY ? NB * SEQ : M;
    for (int r0 = gw; r0 < NR; r0 += RB * NGW) {
        f32x4 x[RB][4]; v2u yw[RB][4]; int rr[RB], jv[RB]; size_t xo[RB]; bool ok[RB], ic[RB];
#pragma unroll
        for (int q = 0; q < RB; ++q) { const int li = r0 + q * NGW; ok[q] = li < NR; const int lr = ok[q] ? li : r0;
            const int r = LAT_ONLY ? lr + (lr >> 12) * CTX + CTX : lr; const int b = r / TT, tt = r - b * TT; ic[q] = tt < CTX; rr[q] = r; jv[q] = ic[q] ? 4 : b;
            xo[q] = ic[q] ? (size_t)(b * CTX + tt) * DM : (size_t)(b * SEQ + tt - CTX) * DM;
            const float* xs = (ic[q] ? xs_ctx : xs_lat) + xo[q];
            if (ok[q]) {
#pragma unroll
                for (int jj = 0; jj < 4; ++jj) x[q][jj] = *(const f32x4*)(xs + 4 * lane + 256 * jj);
                if (HAS_Y) {
#pragma unroll
                    for (int jj = 0; jj < 4; ++jj) yw[q][jj] = *(const v2u*)(F.Y() + (size_t)r * DM + 4 * lane + 256 * jj); } } }
#pragma unroll
        for (int q = 0; q < RB; ++q) { if (!ok[q]) continue;
            const int r = rr[q], j = jv[q];
            if (HAS_Y) {
                f32x4 y[4]; float ss = 0.f;
#pragma unroll
                for (int jj = 0; jj < 4; ++jj) { const v2u w = yw[q][jj];
                    y[jj] = (f32x4){bflo(w.x), bfhi(w.x), bflo(w.y), bfhi(w.y)}; ss += (y[jj][0] * y[jj][0] + y[jj][1] * y[jj][1]) + (y[jj][2] * y[jj][2] + y[jj][3] * y[jj][3]); }
                const float rstd = rsqrtf(wave_sum(ss) * (1.f / DM) + EPS);
#pragma unroll
                for (int jj = 0; jj < 4; ++jj) { const int c = 4 * lane + 256 * jj;
                    const f32x4 g = *(const f32x4*)(mod_y + (size_t)j * 6144 + gate_off + c), gn = *(const f32x4*)(gn_y + c);
                    x[q][jj] = x[q][jj] + g * (y[jj] * rstd * gn); }
            }
            if (WRITE_X) { float* xd = (ic[q] ? xd_ctx : xd_lat) + xo[q];
#pragma unroll
                for (int jj = 0; jj < 4; ++jj) *(f32x4*)(xd + 4 * lane + 256 * jj) = x[q][jj]; }
            if (HAS_NEXT) {
                float ss = 0.f;
#pragma unroll
                for (int jj = 0; jj < 4; ++jj) ss += (x[q][jj][0] * x[q][jj][0] + x[q][jj][1] * x[q][jj][1]) + (x[q][jj][2] * x[q][jj][2] + x[q][jj][3] * x[q][jj][3]);
                const float rstd = rsqrtf(wave_sum(ss) * (1.f / DM) + EPS);
#pragma unroll
                for (int jj = 0; jj < 4; ++jj) { const int c = 4 * lane + 256 * jj;
                    const f32x4 sh = *(const f32x4*)(mod_n + (size_t)j * 6144 + sh_off + c), sc = *(const f32x4*)(mod_n + (size_t)j * 6144 + sc_off + c), gn = *(const f32x4*)(gn_n + c);
                    const f32x4 hv = (x[q][jj] * rstd * gn) * (sc + 1.0f) + sh;
                    v2u o; o.x = pk2(hv[0], hv[1]); o.y = pk2(hv[2], hv[3]);
                    *(v2u*)(F.H() + (size_t)r * DM + c) = o; }
            }
        }
    }
}

__device__ __forceinline__ void og_pass(const Frame& F, const bf16* OF, const bf16* OB) {
    const int lane = F.lane, gw = blockIdx.x * 8 + F.wave, NGW = F.G * 8;
    const bf16* GA = F.PROJ() + 2 * SEG; const bf16* GB = F.PROJ() + 7 * SEG;
    const int c0 = 16 * lane;
    float ogv[16];
#pragma unroll
    for (int i = 0; i < 16; ++i) ogv[i] = F.in(I_OUTG)[c0 + i];
    for (int r0 = gw; r0 < M; r0 += RB * NGW) {
        v4u a0[RB], a1[RB], b0[RB], b1[RB], g0[RB], g1[RB]; bool ok[RB];
#pragma unroll
        for (int q = 0; q < RB; ++q) { const int r = r0 + q * NGW; ok[q] = r < M;
            if (ok[q]) { a0[q] = *(const v4u*)(OF + (size_t)r * DM + c0); a1[q] = *(const v4u*)(OF + (size_t)r * DM + c0 + 8);
                b0[q] = *(const v4u*)(OB + (size_t)r * DM + c0); b1[q] = *(const v4u*)(OB + (size_t)r * DM + c0 + 8);
                const bf16* gp = c0 < 512 ? GA + (size_t)r * 512 + c0 : GB + (size_t)r * 512 + (c0 - 512);
                g0[q] = *(const v4u*)gp; g1[q] = *(const v4u*)(gp + 8); } }
#pragma unroll
        for (int q = 0; q < RB; ++q) { if (!ok[q]) continue; const int r = r0 + q * NGW;
            float v[16], gt[16];
#pragma unroll
            for (int i = 0; i < 4; ++i) { v[2 * i] = bflo(a0[q][i]) + bflo(b0[q][i]); v[2 * i + 1] = bfhi(a0[q][i]) + bfhi(b0[q][i]); v[8 + 2 * i] = bflo(a1[q][i]) + bflo(b1[q][i]); v[8 + 2 * i + 1] = bfhi(a1[q][i]) + bfhi(b1[q][i]);
                gt[2 * i] = bflo(g0[q][i]); gt[2 * i + 1] = bfhi(g0[q][i]); gt[8 + 2 * i] = bflo(g1[q][i]); gt[8 + 2 * i + 1] = bfhi(g1[q][i]); }
            float ss = 0.f;
#pragma unroll
            for (int i = 0; i < 16; ++i) ss += v[i] * v[i];
            ss += __shfl_xor(ss, 1); ss += __shfl_xor(ss, 2); ss += __shfl_xor(ss, 4);
            const float rstd = rsqrtf(ss * (1.f / 128.f) + EPS);
            unsigned o[8];
#pragma unroll
            for (int i = 0; i < 8; ++i) o[i] = pk2(v[2 * i] * rstd * ogv[2 * i] * gt[2 * i], v[2 * i + 1] * rstd * ogv[2 * i + 1] * gt[2 * i + 1]);
            *(v4u*)(F.OG() + (size_t)r * DM + c0) = (v4u){o[0], o[1], o[2], o[3]}; *(v4u*)(F.OG() + (size_t)r * DM + c0 + 8) = (v4u){o[4], o[5], o[6], o[7]};
        }
    }
}

__device__ __forceinline__ void qknorm_pass(const Frame& F) {
    const int lane = F.lane, gw = blockIdx.x * 8 + F.wave, NGW = F.G * 8;
    const float inv = exp2f(-(float)(2 * (lane & 31)) * (13.287712379549449f / 64.f));
    bf16* Kp = F.K();
    const float* g = F.in(I_QKG) + 128;
    const float ga = g[(lane >> 5) * 64 + (lane & 31)], gb = g[(lane >> 5) * 64 + 32 + (lane & 31)];
    for (int r0 = gw; r0 < M; r0 += RB * NGW) {
        unsigned short v[RB][4]; bool ok[RB];
#pragma unroll
        for (int q = 0; q < RB; ++q) { const int r = r0 + q * NGW; ok[q] = r < M;
            if (ok[q]) { const bf16* p = Kp + (size_t)r * 256 + (lane >> 5) * 128 + (lane & 31);
                v[q][0] = p[0]; v[q][1] = p[32]; v[q][2] = p[64]; v[q][3] = p[96]; } }
#pragma unroll
        for (int q = 0; q < RB; ++q) { if (!ok[q]) continue; const int r = r0 + q * NGW;
            const int b = r / TT, tt = r - b * TT; const bool isctx = tt < CTX;
            float x0 = bf2f(v[q][0]), x1 = bf2f(v[q][1]), x2 = bf2f(v[q][2]), x3 = bf2f(v[q][3]);
            float ss = (x0 * x0 + x1 * x1) + (x2 * x2 + x3 * x3);
#pragma unroll
            for (int o = 1; o < 32; o <<= 1) ss += __shfl_xor(ss, o);
            const float rstd = rsqrtf(ss * (1.f / 128.f) + EPS);
            x0 *= rstd * ga; x1 *= rstd * gb; x2 *= rstd * ga; x3 *= rstd * gb;
            if (!isctx) { const int t = tt - CTX; const float a0 = (float)(t >> 6) * inv, a1 = (float)(t & 63) * inv; const float s0 = __sinf(a0), c0 = __cosf(a0), s1 = __sinf(a1), c1 = __cosf(a1);
                const float y0 = x0 * c0 - x1 * s0, y1 = x1 * c0 + x0 * s0, y2 = x2 * c1 - x3 * s1, y3 = x3 * c1 + x2 * s1; x0 = y0; x1 = y1; x2 = y2; x3 = y3; }
            bf16* p = Kp + (size_t)r * 256 + (lane >> 5) * 128 + (lane & 31);
            p[0] = (bf16)f2bf(x0); p[32] = (bf16)f2bf(x1); p[64] = (bf16)f2bf(x2); p[96] = (bf16)f2bf(x3);
        }
    }
}

namespace scan {
typedef short bf16x8 __attribute__((ext_vector_type(8)));
typedef float f32x16 __attribute__((ext_vector_type(16)));
typedef float f32x4 __attribute__((ext_vector_type(4)));
typedef unsigned u32x4 __attribute__((ext_vector_type(4)));
typedef unsigned u32x2 __attribute__((ext_vector_type(2)));
constexpr int NCH = TT / 32;
constexpr int TS = 80;
__device__ __forceinline__ int crow(int r, int hi) { return (r & 3) + 8 * (r >> 2) + 4 * hi; }
__device__ __forceinline__ int kpos(int x) { return (x & ~12) | ((x & 4) << 1) | ((x & 8) >> 1); }
__device__ __forceinline__ unsigned cvtpk(float lo, float hi) { unsigned r; asm volatile("v_cvt_pk_bf16_f32 %0, %1, %2" : "=v"(r) : "v"(lo), "v"(hi)); return r; }
__device__ __forceinline__ bf16x8 pack8(const f32x16& v, int base) {
    u32x4 w; w.x = cvtpk(v[base + 0], v[base + 1]); w.y = cvtpk(v[base + 2], v[base + 3]); w.z = cvtpk(v[base + 4], v[base + 5]); w.w = cvtpk(v[base + 6], v[base + 7]);
    return __builtin_bit_cast(bf16x8, w); }
__device__ __forceinline__ float lo16(unsigned w) { return __builtin_bit_cast(float, w << 16); }
__device__ __forceinline__ float hi16(unsigned w) { return __builtin_bit_cast(float, w & 0xffff0000u); }
__device__ __forceinline__ float xhalf_sum(float v) { auto rr = __builtin_amdgcn_permlane32_swap(__float_as_uint(v), __float_as_uint(v), false, false); return __uint_as_float(rr[0]) + __uint_as_float(rr[1]); }
template <int N> __device__ __forceinline__ float row_shr(float x, float fill) { return __int_as_float(__builtin_amdgcn_update_dpp(__float_as_int(fill), __float_as_int(x), 0x110 + N, 0xf, 0xf, false)); }
__device__ __forceinline__ float lane_bcast(float x, int l) { return __int_as_float(__builtin_amdgcn_readlane(__float_as_int(x), l)); }
__device__ __forceinline__ float prefix_sum32(float x, int lane) {
    x += row_shr<1>(x, 0.f); x += row_shr<2>(x, 0.f); x += row_shr<4>(x, 0.f); x += row_shr<8>(x, 0.f);
    const float s15 = lane_bcast(x, 15); return (lane & 16) ? x + s15 : x; }
__device__ __forceinline__ float prefix_max32(float x, int lane) {
    const float ninf = -__builtin_inff();
    x = fmaxf(x, row_shr<1>(x, ninf)); x = fmaxf(x, row_shr<2>(x, ninf)); x = fmaxf(x, row_shr<4>(x, ninf)); x = fmaxf(x, row_shr<8>(x, ninf));
    const float s15 = lane_bcast(x, 15); return (lane & 16) ? fmaxf(x, s15) : x; }
__device__ __forceinline__ int chunk_row0(int b, int dir, int c) {
    if (c < CTX / 32) return b * TT + (dir ? CTX - 1 - 32 * c : 32 * c);
    const int cc = c - CTX / 32; return b * TT + CTX + (dir ? SEQ - 1 - 32 * cc : 32 * cc);
}
template <int DK> struct Lay {
    static constexpr int RS = DK * 2 + 16;
    static constexpr int Q1 = 0, K1 = 32 * RS, Q2 = 64 * RS, K2T = 96 * RS, VT = K2T + DK * TS, SC = VT + 128 * TS, BYTES = SC + 1024;
};

template <int DK, bool ML, bool STATE_ONLY>
__device__ __forceinline__ void consume(const LAS unsigned char* buf, f32x16 (&S)[DK / 32], LAS float* wpriv, int w, int r32, int hi,
                                        unsigned short* O, int row0, int rstep, int colbase, int variant = 0) {
    using L = Lay<DK>; constexpr int DT = DK / 32, NK = DK / 16;
    const LAS unsigned char* q1 = buf + L::Q1 + r32 * L::RS + hi * 16;
    const LAS unsigned char* k1 = buf + L::K1 + r32 * L::RS + hi * 16;
    const LAS unsigned char* q2 = buf + L::Q2 + r32 * L::RS + hi * 16;
    const LAS float* sc = (const LAS float*)(buf + L::SC);
    f32x16 X = {}, o = {};
    float rden[16];
    if (!STATE_ONLY) {
    bf16x8 q2f[NK];
#pragma unroll
    for (int ks = 0; ks < NK; ++ks) { const bf16x8 a = *(const LAS bf16x8*)(k1 + ks * 32), bq = *(const LAS bf16x8*)(q1 + ks * 32);
        X = __builtin_amdgcn_mfma_f32_32x32x16_bf16(a, bq, X, 0, 0, 0); }
#pragma unroll
    for (int ks = 0; ks < NK; ++ks) { q2f[ks] = *(const LAS bf16x8*)(q2 + ks * 32);
        o = __builtin_amdgcn_mfma_f32_32x32x16_bf16(q2f[ks], pack8(S[ks >> 1], (ks & 1) * 8), o, 0, 0, 0); }
    if (ML) {
        const float ct = sc[32 + r32];
        float colsum = 0.f;
#pragma unroll
        for (int g = 0; g < 4; ++g) { const f32x4 av = *(const LAS f32x4*)(sc + 8 * g + 4 * hi);
#pragma unroll
            for (int i = 0; i < 4; ++i) { const int r = 4 * g + i, s = 8 * g + 4 * hi + i; const float p = (s <= r32) ? __expf(av[i] - ct) : 0.f; X[r] *= p; colsum += X[r]; } }
        float qn = 0.f;
#pragma unroll
        for (int ks = 0; ks < NK; ++ks) { const u32x4 qa = __builtin_bit_cast(u32x4, q2f[ks]);
            const f32x4 n0 = *(const LAS f32x4*)(wpriv + 16 * ks + 4 * hi), n1 = *(const LAS f32x4*)(wpriv + 16 * ks + 8 + 4 * hi);
            qn += lo16(qa.x) * n0[0] + hi16(qa.x) * n0[1] + lo16(qa.y) * n0[2] + hi16(qa.y) * n0[3] + lo16(qa.z) * n1[0] + hi16(qa.z) * n1[1] + lo16(qa.w) * n1[2] + hi16(qa.w) * n1[3]; }
        const float den = xhalf_sum(colsum + qn);
        const float rd = 1.0f / fmaxf(fabsf(den), sc[64 + r32]);
        if (hi == 0) wpriv[64 + r32] = rd;
#pragma unroll
        for (int g = 0; g < 4; ++g) { const f32x4 dv = *(const LAS f32x4*)(wpriv + 64 + 8 * g + 4 * hi);
#pragma unroll
            for (int i = 0; i < 4; ++i) rden[4 * g + i] = dv[i]; }
    } else {
#pragma unroll
        for (int r = 0; r < 16; ++r) { if (crow(r, hi) > r32) X[r] = 0.f; }
    }
    }
    const LAS unsigned char* vt = buf + L::VT + (32 * w + r32) * TS + hi * 16;
    const bf16x8 v0 = *(const LAS bf16x8*)(vt), v1 = *(const LAS bf16x8*)(vt + 32);
    if (!STATE_ONLY) {
    o = __builtin_amdgcn_mfma_f32_32x32x16_bf16(pack8(X, 0), v0, o, 0, 0, 0);
    o = __builtin_amdgcn_mfma_f32_32x32x16_bf16(pack8(X, 8), v1, o, 0, 0, 0); }
    const LAS unsigned char* k2 = buf + L::K2T + r32 * TS + hi * 16;
    const float decay = ML ? sc[96] : 1.f;
#pragma unroll
    for (int dt = 0; dt < DT; ++dt) {
        if (ML) { S[dt] = S[dt] * decay; }
        else {
#pragma unroll
            for (int g = 0; g < 4; ++g) { const f32x4 gv = *(const LAS f32x4*)(sc + 32 * dt + 8 * g + 4 * hi);
#pragma unroll
                for (int i = 0; i < 4; ++i) S[dt][4 * g + i] *= gv[i]; } }
        const bf16x8 a0 = *(const LAS bf16x8*)(k2 + dt * 32 * TS), a1 = *(const LAS bf16x8*)(k2 + dt * 32 * TS + 32);
        S[dt] = __builtin_amdgcn_mfma_f32_32x32x16_bf16(a0, v0, S[dt], 0, 0, 0);
        S[dt] = __builtin_amdgcn_mfma_f32_32x32x16_bf16(a1, v1, S[dt], 0, 0, 0);
        if (ML) {
            const u32x4 ua = __builtin_bit_cast(u32x4, a0), ub = __builtin_bit_cast(u32x4, a1);
            float ksum = (lo16(ua.x) + hi16(ua.x)) + (lo16(ua.y) + hi16(ua.y)) + (lo16(ua.z) + hi16(ua.z)) + (lo16(ua.w) + hi16(ua.w))
                       + (lo16(ub.x) + hi16(ub.x)) + (lo16(ub.y) + hi16(ub.y)) + (lo16(ub.z) + hi16(ub.z)) + (lo16(ub.w) + hi16(ub.w));
            ksum = xhalf_sum(ksum);
            if (hi == 0) wpriv[32 * dt + r32] = decay * wpriv[32 * dt + r32] + ksum;
        }
    }
    if (STATE_ONLY) return;
    if (variant & 16) { float keep = 0.f;
#pragma unroll
        for (int r = 0; r < 16; ++r) keep += ML ? o[r] * rden[r] : o[r];
        asm volatile("" :: "v"(keep)); return; }
    unsigned short* op = O + colbase + 32 * w + r32;
#pragma unroll
    for (int r = 0; r < 16; ++r) { const float v = ML ? o[r] * rden[r] : o[r]; const unsigned u = __float_as_uint(v);
        op[(long)(row0 + rstep * crow(r, hi)) * DM] = (unsigned short)((u + 0x7fffu + ((u >> 16) & 1u)) >> 16); }
}

struct HgPre { unsigned z[8], q[8], v[8]; };
template <bool LIGHT> __device__ __forceinline__ void hg_load(HgPre& P, const unsigned short* Z, const unsigned short* QA, const unsigned short* VA, int row0, int rstep, int colg, int qd) {
    const int rlow = rstep < 0 ? row0 - 31 : row0;
    const unsigned loff = (unsigned)(((rstep < 0 ? 24 - 8 * qd : 8 * qd) * 512 + colg) * 2);
    const char* zb = (const char*)(Z + (size_t)rlow * 512); const char* qb = (const char*)(QA + (size_t)rlow * 512); const char* vb = (const char*)(VA + (size_t)rlow * 512);
#pragma unroll
    for (int ii = 0; ii < 8; ++ii) { const int k = rstep < 0 ? 7 - ii : ii;
        P.z[ii] = *(const unsigned*)(zb + k * 1024 + loff); P.q[ii] = LIGHT ? 0u : *(const unsigned*)(qb + k * 1024 + loff); P.v[ii] = *(const unsigned*)(vb + k * 1024 + loff); }
}
template <bool LIGHT> __device__ __forceinline__ void hg_produce(LAS unsigned char* buf, const HgPre& P, float lb0, float lb1, int pw, int cp, int qd, float& gam0, float& gam1) {
    using L = Lay<128>;
    const int d0 = 32 * pw + 2 * cp;
    float q[2][8], k[2][8], Pc[2][8], RP[2][8];
#pragma unroll
    for (int x = 0; x < 2; ++x) { const float lb = x ? lb1 : lb0; float p = 1.f;
#pragma unroll
        for (int ii = 0; ii < 8; ++ii) { const float z = x ? hi16(P.z[ii]) : lo16(P.z[ii]); q[x][ii] = x ? hi16(P.q[ii]) : lo16(P.q[ii]);
            const float sg = __builtin_amdgcn_rcpf(1.f + __expf(-z)); const float f = lb + (1.f - lb) * sg; k[x][ii] = (1.f - lb) * (1.f - sg);
            p *= f; Pc[x][ii] = p; } }
    const int lane = cp + 16 * qd;
    unsigned k2lo[2][2], k2hi[2][2];
#pragma unroll
    for (int x = 0; x < 2; ++x) {
        const float T = Pc[x][7];
        const float T0 = __shfl(T, cp), T1 = __shfl(T, cp + 16), T2 = __shfl(T, cp + 32), T3 = __shfl(T, cp + 48);
        const float emid = T0 * T1, elast = T2 * T3;
        const float scale = qd == 0 ? __builtin_amdgcn_rcpf(emid) : (qd == 1 ? __builtin_amdgcn_rcpf(T1) : (qd == 2 ? 1.f : T2));
#pragma unroll
        for (int ii = 0; ii < 8; ++ii) { const float E = Pc[x][ii] * scale; const float qt = q[x][ii] * E, kt = k[x][ii] * __builtin_amdgcn_rcpf(E);
            q[x][ii] = qt; k[x][ii] = kt; Pc[x][ii] = qt * emid; RP[x][ii] = kt * elast; }
        k2lo[x][0] = cvtpk(RP[x][0], RP[x][1]); k2lo[x][1] = cvtpk(RP[x][2], RP[x][3]); k2hi[x][0] = cvtpk(RP[x][4], RP[x][5]); k2hi[x][1] = cvtpk(RP[x][6], RP[x][7]);
        if (qd == 0) ((LAS float*)(buf + L::SC))[d0 + x] = emid * elast;
        if (x == 0) gam0 *= emid * elast; else gam1 *= emid * elast;
    }
    (void)lane;
    const int pd = ((d0 & ~15) | kpos(d0 & 15)) * 2;
    if (!LIGHT) {
#pragma unroll
    for (int ii = 0; ii < 8; ++ii) { const int i = 8 * qd + ii;
        *(LAS unsigned*)(buf + L::Q1 + i * L::RS + pd) = cvtpk(q[0][ii], q[1][ii]);
        *(LAS unsigned*)(buf + L::K1 + i * L::RS + pd) = cvtpk(k[0][ii], k[1][ii]);
        *(LAS unsigned*)(buf + L::Q2 + i * L::RS + pd) = cvtpk(Pc[0][ii], Pc[1][ii]); } }
    const int ps = (16 * (qd >> 1) + 4 * (qd & 1)) * 2;
#pragma unroll
    for (int x = 0; x < 2; ++x) {
        *(LAS u32x2*)(buf + L::K2T + (d0 + x) * TS + ps) = (u32x2){k2lo[x][0], k2lo[x][1]};
        *(LAS u32x2*)(buf + L::K2T + (d0 + x) * TS + ps + 16) = (u32x2){k2hi[x][0], k2hi[x][1]};
        unsigned a, b2, c2, d2;
        if (x == 0) { a = (P.v[0] & 0xffffu) | (P.v[1] << 16); b2 = (P.v[2] & 0xffffu) | (P.v[3] << 16); c2 = (P.v[4] & 0xffffu) | (P.v[5] << 16); d2 = (P.v[6] & 0xffffu) | (P.v[7] << 16); }
        else { a = (P.v[0] >> 16) | (P.v[1] & 0xffff0000u); b2 = (P.v[2] >> 16) | (P.v[3] & 0xffff0000u); c2 = (P.v[4] >> 16) | (P.v[5] & 0xffff0000u); d2 = (P.v[6] >> 16) | (P.v[7] & 0xffff0000u); }
        *(LAS u32x2*)(buf + L::VT + (d0 + x) * TS + ps) = (u32x2){a, b2};
        *(LAS u32x2*)(buf + L::VT + (d0 + x) * TS + ps + 16) = (u32x2){c2, d2};
    }
}

struct MlPre { unsigned x[10], v[8]; float ig, fg; };
__device__ __forceinline__ void ml_load(MlPre& P, const unsigned short* BQK, const unsigned short* VB, const float* BG, int segrow0, int L, int tc0, int colq, int colv,
                                        int row0, int rstep, int qd, int i32, int gi_i, int gi_f, float gb_i, float gb_f) {
    const int kq = rstep < 0 ? 24 - 8 * qd : 8 * qd; const int tq0 = tc0 + kq;
    const char* xb = (const char*)(BQK + (size_t)(segrow0 + tc0) * 512);
    const unsigned xoff = (unsigned)((kq * 512 + colq) * 2);
#pragma unroll
    for (int jj = 0; jj < 10; ++jj) { const int t = tq0 - 1 + jj; P.x[jj] = (t >= 0 && t < L) ? *(const unsigned*)(xb + (jj - 1) * 1024 + xoff) : 0u; }
    const int rlow = rstep < 0 ? row0 - 31 : row0;
    const char* vb = (const char*)(VB + (size_t)rlow * 512);
    const unsigned voff = (unsigned)((kq * 512 + colv) * 2);
#pragma unroll
    for (int ii = 0; ii < 8; ++ii) { const int k = rstep < 0 ? 7 - ii : ii; P.v[ii] = *(const unsigned*)(vb + k * 1024 + voff); }
    const size_t gr = (size_t)(row0 + rstep * i32) * 16;
    P.ig = BG[gr + gi_i] + gb_i; P.fg = BG[gr + gi_f] + gb_f;
}
template <bool LIGHT, bool DIR> __device__ __forceinline__ void ml_produce(LAS unsigned char* buf, const MlPre& P, LAS float* ppriv, float& m, float& Bacc, int pw, int cp, int qd, int lane,
                                           float w00, float w01, float w02, float w10, float w11, float w12) {
    using L = Lay<64>;
    const int i32 = lane & 31;
    const float logf = fminf(P.fg, 0.f) - __logf(1.f + __expf(-fabsf(P.fg)));
    const float bh = prefix_sum32(logf, lane);
    const float a = P.ig - bh;
    const float pm = prefix_max32(a, lane);
    const float c = fmaxf(pm, m);
    const float c31 = lane_bcast(c, 31), bh31 = lane_bcast(bh, 31);
    const float winter = __expf(m - c), wk = __expf(a - c31), decay = __expf(m - c31), flo = __expf(-(bh + c));
    if (lane < 32) { ppriv[i32] = winter; ppriv[32 + i32] = wk; }
    if (pw == 0 && lane < 32) { LAS float* sc = (LAS float*)(buf + L::SC); sc[i32] = a; sc[32 + i32] = c; sc[64 + i32] = flo; if (i32 == 0) sc[96] = decay; }
    m = bh31 + c31; Bacc += bh31;
    const bool isk = pw >= 2;
    float y[2][8];
    if (!LIGHT || isk) {
#pragma unroll
    for (int mm = 0; mm < 8; ++mm) {
        const float c0v = w00 * lo16(P.x[mm]) + w01 * lo16(P.x[mm + 1]) + w02 * lo16(P.x[mm + 2]);
        const float c1v = w10 * hi16(P.x[mm]) + w11 * hi16(P.x[mm + 1]) + w12 * hi16(P.x[mm + 2]);
        const float s0 = c0v * __builtin_amdgcn_rcpf(1.f + __expf(-c0v)), s1 = c1v * __builtin_amdgcn_rcpf(1.f + __expf(-c1v));
        constexpr int dummy = 0; (void)dummy;
        y[0][DIR ? 7 - mm : mm] = isk ? s0 : s0 * 0.125f; y[1][DIR ? 7 - mm : mm] = isk ? s1 : s1 * 0.125f; } }
    const LAS float* wp = ppriv + (isk ? 32 : 0) + 8 * qd;
    const f32x4 wa = *(const LAS f32x4*)wp, wb = *(const LAS f32x4*)(wp + 4);
    float ws[8] = {wa[0], wa[1], wa[2], wa[3], wb[0], wb[1], wb[2], wb[3]};
    const int cc = (32 * pw + 2 * cp) & 63;
    const int ps = (16 * (qd >> 1) + 4 * (qd & 1)) * 2;
    if (!isk) {
      if (!LIGHT) {
        const int pd = ((cc & ~15) | kpos(cc & 15)) * 2;
#pragma unroll
        for (int ii = 0; ii < 8; ++ii) { const int i = 8 * qd + ii;
            *(LAS unsigned*)(buf + L::Q1 + i * L::RS + pd) = cvtpk(y[0][ii], y[1][ii]);
            *(LAS unsigned*)(buf + L::Q2 + i * L::RS + pd) = cvtpk(y[0][ii] * ws[ii], y[1][ii] * ws[ii]); } }
    } else {
        const int pd = ((cc & ~15) | kpos(cc & 15)) * 2;
#pragma unroll
        for (int ii = 0; ii < 8; ++ii) { const int i = 8 * qd + ii; if (!LIGHT) *(LAS unsigned*)(buf + L::K1 + i * L::RS + pd) = cvtpk(y[0][ii], y[1][ii]); }
#pragma unroll
        for (int x = 0; x < 2; ++x) {
            *(LAS u32x2*)(buf + L::K2T + (cc + x) * TS + ps) = (u32x2){cvtpk(y[x][0] * ws[0], y[x][1] * ws[1]), cvtpk(y[x][2] * ws[2], y[x][3] * ws[3])};
            *(LAS u32x2*)(buf + L::K2T + (cc + x) * TS + ps + 16) = (u32x2){cvtpk(y[x][4] * ws[4], y[x][5] * ws[5]), cvtpk(y[x][6] * ws[6], y[x][7] * ws[7])}; }
    }
    const int e0 = 32 * pw + 2 * cp;
#pragma unroll
    for (int x = 0; x < 2; ++x) {
        unsigned a2, b2, c2, d2;
        if (x == 0) { a2 = (P.v[0] & 0xffffu) | (P.v[1] << 16); b2 = (P.v[2] & 0xffffu) | (P.v[3] << 16); c2 = (P.v[4] & 0xffffu) | (P.v[5] << 16); d2 = (P.v[6] & 0xffffu) | (P.v[7] << 16); }
        else { a2 = (P.v[0] >> 16) | (P.v[1] & 0xffff0000u); b2 = (P.v[2] >> 16) | (P.v[3] & 0xffff0000u); c2 = (P.v[4] >> 16) | (P.v[5] & 0xffff0000u); d2 = (P.v[6] >> 16) | (P.v[7] & 0xffff0000u); }
        *(LAS u32x2*)(buf + L::VT + (e0 + x) * TS + ps) = (u32x2){a2, b2};
        *(LAS u32x2*)(buf + L::VT + (e0 + x) * TS + ps + 16) = (u32x2){c2, d2};
    }
}

#define SCAN_BAR() do { asm volatile("s_waitcnt lgkmcnt(0)" ::: "memory"); __builtin_amdgcn_s_barrier(); asm volatile("" ::: "memory"); } while (0)

constexpr int NSEG = 4, CPS = NCH / NSEG;
static_assert(NCH % NSEG == 0 && (CPS - 1) % 3 == 0 && CPS % 2 == 0, "segment geometry");
struct Xch { float* SXH; float* GXH; float* SXM; float* NXM; float* MXM; };
template <int PASS>
__device__ __forceinline__ void run_hgrn(LAS unsigned char* lds, int ch, int seg, const unsigned short* PROJ, const float* hgrn_lb, unsigned short* OF, unsigned short* OB, const Xch X, int variant) {
    using L = Lay<128>;
    if (PASS == 0 && seg == NSEG - 1) return;
    const int tid = threadIdx.x, wave = __builtin_amdgcn_readfirstlane(tid >> 6), lane = tid & 63;
    const int b = ch >> 3, h = (ch >> 1) & 3, dir = ch & 1, rstep = dir ? -1 : 1;
    const int c0 = seg * CPS;
    const unsigned short* QA = PROJ; const unsigned short* VA = PROJ + SEG; const unsigned short* Z = PROJ + (3 + dir) * SEG;
    unsigned short* O = dir ? OB : OF;
    if (wave < 4) {
        f32x16 S[4] = {};
        const int r32 = lane & 31, hi = lane >> 5;
        if (PASS == 1 && seg > 0) {
            const float* sx = X.SXH + ((size_t)(ch * 3) * 4 + wave) * 4096 + lane;
#pragma unroll
            for (int dt = 0; dt < 4; ++dt)
#pragma unroll
                for (int r = 0; r < 16; ++r) S[dt][r] = sx[(dt * 16 + r) * 64];
            for (int i = 1; i < seg; ++i) { const float* gam = X.GXH + (size_t)(ch * 3 + i) * 128;
#pragma unroll
                for (int dt = 0; dt < 4; ++dt)
#pragma unroll
                    for (int r = 0; r < 16; ++r) S[dt][r] = S[dt][r] * gam[32 * dt + crow(r, hi)] + sx[(size_t)i * 16384 + (dt * 16 + r) * 64]; }
        }
        SCAN_BAR();
        for (int c = c0; c < c0 + CPS; ++c) {
            consume<128, false, PASS == 0>(lds + (c & 1) * L::BYTES, S, nullptr, wave, r32, hi, O, chunk_row0(b, dir, c), rstep, h * 128, variant);
            SCAN_BAR();
        }
        if (PASS == 0) { float* sx = X.SXH + ((size_t)(ch * 3 + seg) * 4 + wave) * 4096 + lane;
#pragma unroll
            for (int dt = 0; dt < 4; ++dt)
#pragma unroll
                for (int r = 0; r < 16; ++r) sx[(dt * 16 + r) * 64] = S[dt][r]; }
    } else {
        const int pw = wave - 4, cp = lane & 15, qd = lane >> 4, d0 = 32 * pw + 2 * cp, colg = h * 128 + d0;
        float lbv[2];
#pragma unroll
        for (int x = 0; x < 2; ++x) { const float* p = hgrn_lb + (size_t)dir * 3 * 512 + h * 128 + d0 + x; const float a0 = p[0], a1 = p[512], a2 = p[1024];
            const float mx = fmaxf(a0, fmaxf(a1, a2)); const float e0 = __expf(a0 - mx), e1 = __expf(a1 - mx), e2 = __expf(a2 - mx); lbv[x] = e0 / (e0 + e1 + e2); }
        float gam0 = 1.f, gam1 = 1.f;
        HgPre P0, P1, P2;
#define HG_LD(P_, j_) hg_load<PASS == 0>(P_, Z, QA, VA, chunk_row0(b, dir, c0 + (j_)), rstep, colg, qd)
#define HG_STEP(j_, LS, PS) do { if ((j_) + 3 < CPS && !(variant & 32)) HG_LD(LS, (j_) + 3); if ((j_) + 1 < CPS) hg_produce<PASS == 0>(lds + (((j_) + 1) & 1) * L::BYTES, PS, lbv[0], lbv[1], pw, cp, qd, gam0, gam1); SCAN_BAR(); } while (0)
        HG_LD(P0, 0); HG_LD(P1, 1); HG_LD(P2, 2);
        hg_produce<PASS == 0>(lds, P0, lbv[0], lbv[1], pw, cp, qd, gam0, gam1);
        SCAN_BAR();
        for (int j = 0; j < CPS - 1; j += 3) { HG_STEP(j, P0, P1); HG_STEP(j + 1, P1, P2); HG_STEP(j + 2, P2, P0); }
        SCAN_BAR();
#undef HG_LD
#undef HG_STEP
        if (PASS == 0 && qd == 0) { float* g = X.GXH + (size_t)(ch * 3 + seg) * 128 + d0; g[0] = gam0; g[1] = gam1; }
    }
}
template <int PASS>
__device__ __forceinline__ void run_mlstm(LAS unsigned char* lds, int ch, int seg, const unsigned short* PROJ, const float* BG, const float* conv, const float* gate_b, unsigned short* OF, unsigned short* OB, const Xch X, int variant) {
    using L = Lay<64>;
    if (PASS == 0 && seg == NSEG - 1) return;
    const int tid = threadIdx.x, wave = __builtin_amdgcn_readfirstlane(tid >> 6), lane = tid & 63;
    const int b = ch >> 3, h = (ch >> 1) & 3, dir = ch & 1, rstep = dir ? -1 : 1;
    const int c0 = seg * CPS;
    const unsigned short* BQK = PROJ + 5 * SEG; const unsigned short* VB = PROJ + 6 * SEG;
    unsigned short* O = dir ? OB : OF;
    LAS float* priv = (LAS float*)(lds + 2 * L::BYTES) + wave * 128;
    float mstart = (PASS == 0) ? (seg == 0 ? 0.f : -1e30f) : 0.f;
    float fa1 = 0.f, fb1 = 0.f, fa2 = 0.f, fb2 = 0.f;
    if (PASS == 1 && seg > 0) { const float* mx = X.MXM + (size_t)(ch * 3) * 2;
        float m = mx[0];
        if (seg > 1) { const float ml = mx[2], B = mx[3]; const float mn = fmaxf(B + m, ml); fa1 = __expf(B + m - mn); fb1 = __expf(ml - mn); m = mn; }
        if (seg > 2) { const float ml = mx[4], B = mx[5]; const float mn = fmaxf(B + m, ml); fa2 = __expf(B + m - mn); fb2 = __expf(ml - mn); m = mn; }
        mstart = m; }
    if (wave < 4) {
        f32x16 S[2] = {};
        const int r32 = lane & 31, hi = lane >> 5;
        float nv = 0.f;
        if (PASS == 1 && seg > 0) {
            const float* sx = X.SXM + ((size_t)(ch * 3) * 4 + wave) * 2048 + lane;
            const float* nx = X.NXM + (size_t)(ch * 3) * 64 + lane;
#pragma unroll
            for (int dt = 0; dt < 2; ++dt)
#pragma unroll
                for (int r = 0; r < 16; ++r) S[dt][r] = sx[(dt * 16 + r) * 64];
            nv = nx[0];
            if (seg > 1) {
#pragma unroll
                for (int dt = 0; dt < 2; ++dt)
#pragma unroll
                    for (int r = 0; r < 16; ++r) S[dt][r] = fa1 * S[dt][r] + fb1 * sx[8192 + (dt * 16 + r) * 64];
                nv = fa1 * nv + fb1 * nx[64]; }
            if (seg > 2) {
#pragma unroll
                for (int dt = 0; dt < 2; ++dt)
#pragma unroll
                    for (int r = 0; r < 16; ++r) S[dt][r] = fa2 * S[dt][r] + fb2 * sx[16384 + (dt * 16 + r) * 64];
                nv = fa2 * nv + fb2 * nx[128]; }
        }
        priv[lane] = nv;
        SCAN_BAR();
        for (int c = c0; c < c0 + CPS; ++c) {
            consume<64, true, PASS == 0>(lds + (c & 1) * L::BYTES, S, priv, wave, r32, hi, O, chunk_row0(b, dir, c), rstep, 512 + h * 128, variant);
            SCAN_BAR();
        }
        if (PASS == 0) { float* sx = X.SXM + ((size_t)(ch * 3 + seg) * 4 + wave) * 2048 + lane;
#pragma unroll
            for (int dt = 0; dt < 2; ++dt)
#pragma unroll
                for (int r = 0; r < 16; ++r) sx[(dt * 16 + r) * 64] = S[dt][r];
            if (wave == 0) X.NXM[(size_t)(ch * 3 + seg) * 64 + lane] = priv[lane]; }
    } else {
        const int pw = wave - 4, cp = lane & 15, qd = lane >> 4, i32 = lane & 31;
        const int cc = 32 * pw + 2 * cp;
        const int colq = cc < 64 ? h * 64 + cc : 256 + h * 64 + (cc - 64);
        const int colv = h * 128 + cc;
        const float w00 = conv[colq], w01 = conv[512 + colq], w02 = conv[1024 + colq], w10 = conv[colq + 1], w11 = conv[512 + colq + 1], w12 = conv[1024 + colq + 1];
        const int gi_i = 4 * (2 * dir) + h, gi_f = 4 * (2 * dir + 1) + h; const float gb_i = gate_b[gi_i], gb_f = gate_b[gi_f];
        float m = mstart, Bacc = 0.f;
        MlPre P0, P1, P2;
#define ML_LOADC(P, j_) do { const int c__ = c0 + (j_); const bool lat = c__ >= CTX / 32; const int Lg = lat ? SEQ : CTX; const int segrow0 = b * TT + (lat ? CTX : 0); \
        const int cl = lat ? c__ - CTX / 32 : c__; const int tc0 = dir ? Lg - 32 * (cl + 1) : 32 * cl; \
        ml_load(P, BQK, VB, BG, segrow0, Lg, tc0, colq, colv, chunk_row0(b, dir, c__), rstep, qd, i32, gi_i, gi_f, gb_i, gb_f); } while (0)
#define ML_STEP(j_, LS, PS) do { if ((j_) + 3 < CPS && !(variant & 32)) ML_LOADC(LS, (j_) + 3); if ((j_) + 1 < CPS) { if (dir) ml_produce<PASS == 0, true>(lds + (((j_) + 1) & 1) * L::BYTES, PS, priv, m, Bacc, pw, cp, qd, lane, w00, w01, w02, w10, w11, w12); else ml_produce<PASS == 0, false>(lds + (((j_) + 1) & 1) * L::BYTES, PS, priv, m, Bacc, pw, cp, qd, lane, w00, w01, w02, w10, w11, w12); } SCAN_BAR(); } while (0)
        ML_LOADC(P0, 0); ML_LOADC(P1, 1); ML_LOADC(P2, 2);
        if (dir) ml_produce<PASS == 0, true>(lds, P0, priv, m, Bacc, pw, cp, qd, lane, w00, w01, w02, w10, w11, w12); else ml_produce<PASS == 0, false>(lds, P0, priv, m, Bacc, pw, cp, qd, lane, w00, w01, w02, w10, w11, w12);
        SCAN_BAR();
        for (int j = 0; j < CPS - 1; j += 3) { ML_STEP(j, P0, P1); ML_STEP(j + 1, P1, P2); ML_STEP(j + 2, P2, P0); }
        SCAN_BAR();
#undef ML_STEP
#undef ML_LOADC
        if (PASS == 0 && pw == 0 && lane == 0) { float* mx = X.MXM + (size_t)(ch * 3 + seg) * 2; mx[0] = m; mx[1] = Bacc; }
    }
}
#undef SCAN_BAR
}

enum { PH_PRO = 0, PH_MOD0, PH_INPROJ, PH_SCANA, PH_SCAN, PH_OG, PH_OUT0, PH_ROW0A, PH_FFI0, PH_FFO0, PH_ROW0B, PH_QKV, PH_QKN, PH_ATTN, PH_OUT1, PH_ROW1A, PH_FFI1, PH_FFO1, PH_ROW1B, NPH };

template <class FN> __device__ __forceinline__ void run_gemm(Frame& F, const bf16* A, const bf16* Bt, int N, int K, int skipctx, const FN& fn) {
    pg8::Gemm g{A, Bt, M, N, K}; pg8::TileOrder S; S.init(skipctx ? 64 : 68, N, F.G, (int)blockIdx.x, skipctx);
    pg8::Epi8<FN> E{fn};
    pg8::gemm_phase<pg8::Epi8<FN>, pg8::TileOrder, true, true>(F.lds, g, S, E);
}

__global__ void __launch_bounds__(512, 2) mk_fwd(Args args) {
    extern __shared__ __attribute__((aligned(16))) unsigned char lds[];
    cg::grid_group grid = cg::this_grid();
    Frame F;
    F.lds = (LAS unsigned char*)lds;
    F.tid = threadIdx.x; F.lane = F.tid & 63; F.wave = __builtin_amdgcn_readfirstlane(F.tid >> 6); F.G = gridDim.x;
    F.out = args.out; F.ws = args.ws;
    unsigned char* ws = args.ws;
#define OF ((bf16*)F.out)
#define OB (F.H())
#define MOD0 (F.MOD())
#define MOD1 (F.MOD() + 5 * 6144)
#define NG (F.in(I_NORMG))
    const int lo = args.ph_lo, hi = args.ph_hi;
    volatile LAS unsigned* MISC = (volatile LAS unsigned*)(F.lds + MISC_OFF);
    if (F.tid < 32) MISC[F.tid] = 0u;
    __syncthreads();
    XcdBarrier bar; bar.bar = (unsigned*)(ws + WS_CTL) + CW_BAR; bar.x = 0; bar.st = nullptr;
    if (MK_ONE) bar = xcd_barrier_post((unsigned*)(ws + WS_CTL) + CW_BAR, MISC + 8);
    if (PROBE_TS == 0 && blockIdx.x == 0 && F.tid == 0) *(volatile unsigned long long*)(ws + WS_TS + 64) = __builtin_amdgcn_s_memrealtime();
#define IN(k) (lo <= (k) && (k) < hi)
#define SEAM(k) do { if (IN(k) && IN((k) + 1)) { if ((k) == PH_PRO) grid.sync(); else xcd_barrier(bar); } \
    if (PROBE_TS >= 0 && blockIdx.x == 0 && F.tid == 0) { if ((k) + 1 == PROBE_TS) *(volatile unsigned long long*)(ws + WS_TS + 64) = __builtin_amdgcn_s_memrealtime(); \
        if ((k) == PROBE_TS) *(volatile float*)(ws + WS_TS) = (float)(__builtin_amdgcn_s_memrealtime() - *(volatile unsigned long long*)(ws + WS_TS + 64)) * (PROBE_SCALE); } } while (0)
#define NREP(k) 1
#define PH(k) for (int rep_ = 0; IN(k) && rep_ < NREP(k); (++rep_ < NREP(k)) ? grid.sync() : (void)0)

    PH(PH_PRO) p0_prologue(F);
    SEAM(PH_PRO);
    PH(PH_MOD0) rowpass<false, false, true, false>(F, F.in(I_X), F.in(I_CTX), nullptr, nullptr, nullptr, 0, nullptr, MOD0, 0, 1024, NG + 0);
    SEAM(PH_MOD0);
    PH(PH_INPROJ) run_gemm(F, F.H(), F.WAB(), NABP, 1024, 0, pg8::FProj{F.PROJ(), F.BG()});
    SEAM(PH_INPROJ);
    const scan::Xch XC{(float*)(ws + WS_SXH), (float*)(ws + WS_GXH), (float*)(ws + WS_SXM), (float*)(ws + WS_NXM), (float*)(ws + WS_MXM)};
    PH(PH_SCANA) for (int it = blockIdx.x; it < 256; it += F.G) { const int ch = it >> 2, sg = it & 3;
        if (sg == 3) { p0_deferred(F, ch, 64); continue; }
        if (ch < 32) scan::run_hgrn<0>(F.lds, ch, sg, F.PROJ(), F.in(I_LB), OF, OB, XC, args.variant);
        else if (ch < 64) scan::run_mlstm<0>(F.lds, ch - 32, sg, F.PROJ(), F.BG(), F.in(I_CONV), F.in(I_GATEB), OF, OB, XC, args.variant); }
    SEAM(PH_SCANA);
    PH(PH_SCAN) for (int it = blockIdx.x; it < 256; it += F.G) { const int ch = it >> 2, sg = it & 3;
        if (ch < 32) scan::run_hgrn<1>(F.lds, ch, sg, F.PROJ(), F.in(I_LB), OF, OB, XC, args.variant);
        else if (ch < 64) scan::run_mlstm<1>(F.lds, ch - 32, sg, F.PROJ(), F.BG(), F.in(I_CONV), F.in(I_GATEB), OF, OB, XC, args.variant); }
    SEAM(PH_SCAN);
    PH(PH_OG) og_pass(F, OF, OB);
    SEAM(PH_OG);
    PH(PH_OUT0) run_gemm(F, F.OG(), F.WABO(), 1024, 1024, 0, pg8::FStore{F.Y(), 1024});
    SEAM(PH_OUT0);
    PH(PH_ROW0A) rowpass<true, true, true, false>(F, F.in(I_X), F.in(I_CTX), F.out, F.XCTX(), MOD0, 2048, NG + 1024, MOD0, 3072, 4096, NG + 2048);
    SEAM(PH_ROW0A);
    PH(PH_FFI0) run_gemm(F, F.H(), F.WFI0(), 2 * DFF, 1024, 0, pg8::FSwiglu{F.ACT()});
    SEAM(PH_FFI0);
    PH(PH_FFO0) run_gemm(F, F.ACT(), F.WFO0(), 1024, DFF, 0, pg8::FStore{F.Y(), 1024});
    SEAM(PH_FFO0);
    PH(PH_ROW0B) rowpass<true, true, true, false>(F, F.out, F.XCTX(), F.out, F.XCTX(), MOD0, 5120, NG + 3072, MOD1, 0, 1024, NG + 4096);
    SEAM(PH_ROW0B);
    PH(PH_QKV) run_gemm(F, F.H(), F.WQKV(), NQKV, 1024, 0, pg8::FQkv{F.Q(), F.K(), F.V()});
    SEAM(PH_QKV);
    PH(PH_QKN) qknorm_pass(F);
    SEAM(PH_QKN);
    PH(PH_ATTN) {
        const int bx = blockIdx.x, vcu = (F.G % 8 == 0) ? (bx % 8) * (F.G / 8) + bx / 8 : bx;
        for (int u = vcu; u < 512; u += F.G) {
            const int uu = (u % 256) * 2 + u / 256;
            const int g = uu & 3, qb = (uu >> 2) & 15, kvh = (uu >> 6) & 1, b = uu >> 7, head = kvh * 4 + g;
            const size_t qrow = (size_t)b * TT + CTX + qb * 256;
            attn::q_norm_rope(F.Q() + qrow * 1024 + head * 128, F.in(I_QKG), qb * 256);
            __syncthreads();
            attn::attn_dense_body(F.Q() + qrow * 1024 + head * 128, F.K() + (size_t)b * TT * 256 + kvh * 128, F.V() + (size_t)b * TT * 256 + kvh * 128,
                                  F.OG() + qrow * 1024 + head * 128, TT, (char*)lds);
            __syncthreads();
        }
    }
    SEAM(PH_ATTN);
    PH(PH_OUT1) run_gemm(F, F.OG(), F.WAO(), 1024, 1024, 1, pg8::FStore{F.Y(), 1024});
    SEAM(PH_OUT1);
    PH(PH_ROW1A) rowpass<true, true, true, true>(F, F.out, F.XCTX(), F.out, F.XCTX(), MOD1, 2048, NG + 5120, MOD1, 3072, 4096, NG + 6144);
    SEAM(PH_ROW1A);
    PH(PH_FFI1) run_gemm(F, F.H(), F.WFI1(), 2 * DFF, 1024, 1, pg8::FSwiglu{F.ACT()});
    SEAM(PH_FFI1);
    PH(PH_FFO1) run_gemm(F, F.ACT(), F.WFO1(), 1024, DFF, 1, pg8::FStore{F.Y(), 1024});
    SEAM(PH_FFO1);
    PH(PH_ROW1B) rowpass<true, true, false, true>(F, F.out, F.XCTX(), F.out, F.XCTX(), MOD1, 5120, NG + 7168, nullptr, 0, 0, nullptr);
#undef IN
#undef SEAM
#undef MOD0
#undef MOD1
#undef NG
#undef OB
#undef OF
#undef PH
#undef NREP
}

__global__ void __launch_bounds__(256) probe_scale(float* out, const unsigned char* ws) {
    const float sc1 = 1.0f + *(const float*)(ws + WS_TS);
    for (size_t i = (size_t)blockIdx.x * 256 + threadIdx.x; i < (size_t)NB * SEQ * DM; i += (size_t)gridDim.x * 256) out[i] *= sc1;
}
extern "C" void kernel_launch(void* const* d_in, const int* in_sizes, int n_in, void* d_out, int out_size, void* d_ws, size_t ws_size, hipStream_t stream) {
    static int grid = 0;
    if (grid == 0) {
        if (n_in != 18 || in_sizes[0] != NB * SEQ * DM || out_size != NB * SEQ * DM || ws_size < WS_END) {
            fprintf(stderr, "kernel_launch: unexpected shapes (n_in %d, in0 %d, out %d, ws %zu)\n", n_in, n_in > 0 ? in_sizes[0] : -1, out_size, ws_size); grid = -1; return; }
        int dev = 0, cus = 0, per_cu = 0;
        if (hipGetDevice(&dev) != hipSuccess || hipDeviceGetAttribute(&cus, hipDeviceAttributeMultiprocessorCount, dev) != hipSuccess) { grid = -1; return; }
        if (hipFuncSetAttribute((const void*)mk_fwd, hipFuncAttributeMaxDynamicSharedMemorySize, LDS_BYTES) != hipSuccess) { fprintf(stderr, "kernel_launch: hipFuncSetAttribute failed\n"); grid = -1; return; }
        if (hipOccupancyMaxActiveBlocksPerMultiprocessor(&per_cu, (const void*)mk_fwd, 512, LDS_BYTES) != hipSuccess || per_cu < 1) { fprintf(stderr, "kernel_launch: occupancy query says %d blocks per CU\n", per_cu); per_cu = 1; }
        (void)hipGetLastError();
        grid = cus;
        fprintf(stderr, "kernel_launch: grid %d (occupancy query %d per CU)\n", grid, per_cu);
    }
    if (grid < 0) return;
    if (MK_ONE) { if (hipMemsetAsync((char*)d_ws + WS_CTL, 0, CTL_ZERO_BYTES, stream) != hipSuccess) { fprintf(stderr, "kernel_launch: memset failed\n"); return; } }
    Args a{};
    for (int i = 0; i < 18; ++i) a.in[i] = (const float*)d_in[i];
    a.out = (float*)d_out; a.ws = (unsigned char*)d_ws;
#if MK_ONE
    a.ph_lo = 0; a.ph_hi = NPH;
    void* kargs[] = {&a};
    hipError_t e = hipLaunchCooperativeKernel((const void*)mk_fwd, dim3(grid), dim3(512), kargs, LDS_BYTES, stream);
    if (e != hipSuccess) fprintf(stderr, "kernel_launch: cooperative launch failed: %s (grid %d)\n", hipGetErrorString(e), grid);
    if (PROBE_TS >= 0) hipLaunchKernelGGL(probe_scale, dim3(1024), dim3(256), 0, stream, (float*)d_out, (const unsigned char*)d_ws);
#else
    for (int p = 0; p < NPH; ++p) for (int rep = 0; rep < ((((PROBE_REP) >> p) & 1) ? 2 : 1); ++rep) { a.ph_lo = p; a.ph_hi = p + 1; a.variant = rep ? (PROBE_VAR) : 0; hipLaunchKernelGGL(mk_fwd, dim3(grid), dim3(512), LDS_BYTES, stream, a); }
    const hipError_t le = hipPeekAtLastError();
    if (le != hipSuccess) fprintf(stderr, "kernel_launch: launch failed: %s\n", hipGetErrorName(le));
#endif
}
```
